# Optimizing an MI355X kernel written in HIP

```python
import math, functools
import jax, jax.numpy as jnp
from jax import lax
import numpy as np


D_MODEL = 1024
BATCH = 4
SEQ = 4096
DEPTH = 1
DEC_BATCH = 32
DEC_SEQ = 1
PAST_LEN = 16384
PAGE_SIZE = 128

HEAD_DIM = 64
RWKV_HEADS = 6
SB_HEADS = 6
X_HEADS = 4
N_MEM = 256
RWKV_W = RWKV_HEADS * HEAD_DIM
SB_W = SB_HEADS * HEAD_DIM
X_W = X_HEADS * HEAD_DIM
D_MIX = RWKV_W + SB_W + X_W
LORA_W = 64
LORA_A = 64
RWKV_COLS = 3 * RWKV_W + LORA_W + LORA_A
SB_COLS = 3 * SB_W
GATE_COLS = D_MIX
D_IN = RWKV_COLS + SB_COLS + X_W + GATE_COLS
Q_BLOCK = 128
NORM_EPS = 1e-6
GN_EPS = 64e-5
DECAY_SCALE = math.exp(-0.5)
ATTN_SCALE = HEAD_DIM ** -0.5
SB_BIAS_INIT = -8.0

kernel_name = "hymba_rwkv7_stickbreaking_memxattn_step"


def rmsnorm(x, g):
    xf = x.astype(jnp.float32)
    y = xf * lax.rsqrt(jnp.mean(xf * xf, axis=-1, keepdims=True) + NORM_EPS)
    return (y * g.astype(jnp.float32)).astype(x.dtype)


def split_heads(t, h):
    return t.reshape(t.shape[:-1] + (h, HEAD_DIM))


def rwkv7_branch(p_rw, prev_row, s0, mu_shift, w0, w_lora_b, a0, a_lora_b, k_k, k_a, r_k, lnx_g, lnx_b):
    f32 = jnp.float32
    pf = p_rw.astype(f32)
    prev = jnp.concatenate([prev_row.astype(f32)[:, None, :], pf[:, :-1]], axis=1)
    xs = pf + (prev - pf) * mu_shift.astype(f32)
    r, k, v, xw, xa = jnp.split(xs, [RWKV_W, 2 * RWKV_W, 3 * RWKV_W, 3 * RWKV_W + LORA_W], axis=-1)
    log_w = -DECAY_SCALE * jax.nn.sigmoid(w0.astype(f32) + jnp.tanh(xw) @ w_lora_b.astype(f32))
    a = jax.nn.sigmoid(a0.astype(f32) + xa @ a_lora_b.astype(f32))
    kk = split_heads(k * k_k.astype(f32), RWKV_HEADS)
    kk = kk * lax.rsqrt(jnp.maximum(jnp.sum(kk * kk, axis=-1, keepdims=True), 1e-12))
    k = k * (1.0 + (a - 1.0) * k_a.astype(f32))
    r, k, v, w, a = [split_heads(t, RWKV_HEADS) for t in (r, k, v, jnp.exp(log_w), a)]

    def step(S, inp):
        r_t, w_t, k_t, v_t, kk_t, a_t = inp
        s_kk = jnp.einsum('bhvk,bhk->bhv', S, kk_t)
        S = (S * w_t[:, :, None, :]
             - s_kk[..., None] * (kk_t * a_t)[:, :, None, :]
             + v_t[..., None] * k_t[:, :, None, :])
        return S, jnp.einsum('bhvk,bhk->bhv', S, r_t)

    seq = tuple(jnp.moveaxis(t, 1, 0) for t in (r, w, k, v, kk, a))
    s_fin, o = lax.scan(step, s0.astype(f32), seq)
    o = jnp.moveaxis(o, 0, 1)
    mean = jnp.mean(o, axis=-1, keepdims=True)
    var = jnp.mean(jnp.square(o - mean), axis=-1, keepdims=True)
    o = (o - mean) * lax.rsqrt(var + GN_EPS)
    o = o.reshape(o.shape[:2] + (RWKV_W,)) * lnx_g.astype(f32) + lnx_b.astype(f32)
    bonus = jnp.sum(r * k * r_k.astype(f32), axis=-1, keepdims=True) * v
    o = o + bonus.reshape(o.shape)
    return o.astype(p_rw.dtype), s_fin.astype(s0.dtype), p_rw[:, -1]


def sb_attend(q, k, v, bias, q_pos, k_pos):
    z = jnp.einsum('bqhd,bkhd->bhqk', q, k, preferred_element_type=jnp.float32) * ATTN_SCALE
    z = z + bias.astype(jnp.float32)[None, :, None, None]
    mask = k_pos[None, :] < q_pos[:, None]
    log_not = jnp.where(mask, jax.nn.log_sigmoid(-z), 0.0)
    after = lax.cumsum(log_not, axis=3, reverse=True) - log_not
    A = jnp.where(mask, jnp.exp(jax.nn.log_sigmoid(z) + after), 0.0)
    o = jnp.einsum('bhqk,bkhd->bqhd', A, v.astype(jnp.float32))
    return o.astype(q.dtype)


def sb_prompt(q, k, v, bias):
    B, T = q.shape[0], q.shape[1]
    nb = T // Q_BLOCK
    qb = jnp.moveaxis(q.reshape(B, nb, Q_BLOCK, SB_HEADS, HEAD_DIM), 1, 0)
    k_pos = jnp.arange(T)

    def blk(args):
        q_i, i = args
        q_pos = i * Q_BLOCK + jnp.arange(Q_BLOCK)
        return sb_attend(q_i, k, v, bias, q_pos, k_pos)

    o = lax.map(blk, (qb, jnp.arange(nb)))
    return jnp.moveaxis(o, 0, 1).reshape(B, T, SB_W)


def sb_sample(q, k, v, bias, past_k, past_v):
    B, T = q.shape[0], q.shape[1]
    P = past_k.shape[1]
    k_all = jnp.concatenate([past_k.astype(k.dtype), k], axis=1)
    v_all = jnp.concatenate([past_v.astype(v.dtype), v], axis=1)
    q_pos = P + jnp.arange(T)
    k_pos = jnp.arange(P + T)
    return sb_attend(q, k_all, v_all, bias, q_pos, k_pos).reshape(B, T, SB_W)


def memory_kv(mem, g, wk, wv):
    h = rmsnorm(mem, g)
    return split_heads(h @ wk, X_HEADS), split_heads(h @ wv, X_HEADS)


def cross_attend(q, mk, mv):
    s = jnp.einsum('bqhd,bmhd->bhqm', q, mk, preferred_element_type=jnp.float32) * ATTN_SCALE
    p = jax.nn.softmax(s, axis=-1)
    o = jnp.einsum('bhqm,bmhd->bqhd', p, mv.astype(jnp.float32))
    return o.reshape(o.shape[:2] + (X_W,)).astype(q.dtype)


def mixer_layer(x, prev_row, s0, mem_k, mem_v, sb_fn, norm_g, w_in, sb_bias, rw, w_out):
    h = rmsnorm(x, norm_g)
    p = h @ w_in
    p_rw, p_sb, p_xq, p_gate = jnp.split(
        p, [RWKV_COLS, RWKV_COLS + SB_COLS, RWKV_COLS + SB_COLS + X_W], axis=-1)
    o_rw, s_fin, last_row = rwkv7_branch(p_rw, prev_row, s0, *rw)
    q, k, v = [split_heads(t, SB_HEADS) for t in jnp.split(p_sb, 3, axis=-1)]
    o_sb = sb_fn(q, k, v, sb_bias)
    o_x = cross_attend(split_heads(p_xq, X_HEADS), mem_k, mem_v)
    o = jnp.concatenate([o_rw, o_sb, o_x], axis=-1) * jax.nn.silu(p_gate)
    return x + o @ w_out, s_fin, last_row, k, v


def setup_inputs(seed: int = 0) -> dict:
    key = jax.random.key(seed)
    ks = jax.random.split(key, 32)
    f32 = jnp.float32
    n_pages = PAST_LEN // PAGE_SIZE
    n_pool = (DEC_BATCH * n_pages * 5) // 4

    def nrm(k, shape, scale):
        return jax.random.normal(k, shape, f32) * scale

    return {
        "x_prompt": nrm(ks[0], (BATCH, SEQ, D_MODEL), 1.0),
        "mem_prompt": nrm(ks[1], (BATCH, N_MEM, D_MODEL), 1.0),
        "x_sample": nrm(ks[2], (DEC_BATCH, DEC_SEQ, D_MODEL), 1.0),
        "cache_sb_k": nrm(ks[3], (DEPTH, n_pool, PAGE_SIZE, SB_HEADS, HEAD_DIM), 1.0),
        "cache_sb_v": nrm(ks[4], (DEPTH, n_pool, PAGE_SIZE, SB_HEADS, HEAD_DIM), 1.0),
        "page_table": jax.random.permutation(ks[5], n_pool)[:DEC_BATCH * n_pages]
                      .reshape(DEC_BATCH, n_pages).astype(jnp.int32),
        "state_wkv": nrm(ks[6], (DEPTH, DEC_BATCH, RWKV_HEADS, HEAD_DIM, HEAD_DIM), 0.3),
        "state_shift": nrm(ks[7], (DEPTH, DEC_BATCH, RWKV_COLS), 1.0),
        "cache_mem_k": nrm(ks[8], (DEPTH, DEC_BATCH, N_MEM, X_HEADS, HEAD_DIM), 1.0),
        "cache_mem_v": nrm(ks[9], (DEPTH, DEC_BATCH, N_MEM, X_HEADS, HEAD_DIM), 1.0),
        "norm_g": 1.0 + nrm(ks[10], (DEPTH, D_MODEL), 0.02),
        "w_in": nrm(ks[11], (DEPTH, D_MODEL, D_IN), D_MODEL ** -0.5),
        "sb_bias": SB_BIAS_INIT + nrm(ks[27], (DEPTH, SB_HEADS), 0.3),
        "mu_shift": jax.random.uniform(ks[12], (DEPTH, RWKV_COLS), f32, 0.1, 0.9),
        "w0": nrm(ks[13], (DEPTH, RWKV_W), 0.5),
        "w_lora_b": nrm(ks[14], (DEPTH, LORA_W, RWKV_W), LORA_W ** -0.5),
        "a0": nrm(ks[15], (DEPTH, RWKV_W), 0.3),
        "a_lora_b": nrm(ks[16], (DEPTH, LORA_A, RWKV_W), LORA_A ** -0.5),
        "k_k": 0.85 + nrm(ks[17], (DEPTH, RWKV_W), 0.05),
        "k_a": 1.0 + nrm(ks[18], (DEPTH, RWKV_W), 0.05),
        "r_k": nrm(ks[19], (DEPTH, RWKV_HEADS, HEAD_DIM), 0.1),
        "lnx_g": 1.0 + nrm(ks[20], (DEPTH, RWKV_W), 0.02),
        "lnx_b": nrm(ks[21], (DEPTH, RWKV_W), 0.02),
        "mem_norm_g": 1.0 + nrm(ks[22], (DEPTH, D_MODEL), 0.02),
        "w_mem_k": nrm(ks[23], (DEPTH, D_MODEL, X_W), D_MODEL ** -0.5),
        "w_mem_v": nrm(ks[24], (DEPTH, D_MODEL, X_W), D_MODEL ** -0.5),
        "w_out": nrm(ks[25], (DEPTH, D_MIX, D_MODEL), D_MIX ** -0.5),
        "final_norm_g": 1.0 + nrm(ks[26], (D_MODEL,), 0.02),
    }


def reference(x_prompt, mem_prompt, x_sample, cache_sb_k, cache_sb_v, page_table,
              state_wkv, state_shift, cache_mem_k, cache_mem_v,
              norm_g, w_in, sb_bias, mu_shift, w0, w_lora_b, a0, a_lora_b, k_k, k_a, r_k,
              lnx_g, lnx_b, mem_norm_g, w_mem_k, w_mem_v, w_out, final_norm_g):
    n_pages = page_table.shape[1]
    b_p = x_prompt.shape[0]
    b_s = x_sample.shape[0]
    xp, xs = x_prompt, x_sample
    sbk_p, sbv_p, wkv_p, sh_p, mk_p_l, mv_p_l = [], [], [], [], [], []
    sbk_s, sbv_s, wkv_s, sh_s = [], [], [], []
    for l in range(DEPTH):
        rw = (mu_shift[l], w0[l], w_lora_b[l], a0[l], a_lora_b[l], k_k[l], k_a[l], r_k[l],
              lnx_g[l], lnx_b[l])
        mk_p, mv_p = memory_kv(mem_prompt, mem_norm_g[l], w_mem_k[l], w_mem_v[l])
        xp, s_p, last_p, k_p, v_p = mixer_layer(
            xp, jnp.zeros((b_p, RWKV_COLS), xp.dtype),
            jnp.zeros((b_p, RWKV_HEADS, HEAD_DIM, HEAD_DIM), state_wkv.dtype),
            mk_p, mv_p, sb_prompt, norm_g[l], w_in[l], sb_bias[l], rw, w_out[l])
        sbk_p.append(k_p); sbv_p.append(v_p); wkv_p.append(s_p); sh_p.append(last_p)
        mk_p_l.append(mk_p); mv_p_l.append(mv_p)
        past_k = cache_sb_k[l][page_table].reshape(b_s, n_pages * PAGE_SIZE, SB_HEADS, HEAD_DIM)
        past_v = cache_sb_v[l][page_table].reshape(b_s, n_pages * PAGE_SIZE, SB_HEADS, HEAD_DIM)
        sb_fn = functools.partial(sb_sample, past_k=past_k, past_v=past_v)
        xs, s_s, last_s, k_s, v_s = mixer_layer(
            xs, state_shift[l], state_wkv[l], cache_mem_k[l], cache_mem_v[l], sb_fn,
            norm_g[l], w_in[l], sb_bias[l], rw, w_out[l])
        sbk_s.append(k_s); sbv_s.append(v_s); wkv_s.append(s_s); sh_s.append(last_s)
    y_prompt = rmsnorm(xp, final_norm_g)
    y_sample = rmsnorm(xs, final_norm_g)
    return (y_prompt, y_sample,
            jnp.stack(sbk_p), jnp.stack(sbv_p), jnp.stack(wkv_p), jnp.stack(sh_p),
            jnp.stack(mk_p_l), jnp.stack(mv_p_l),
            jnp.stack(sbk_s), jnp.stack(sbv_s), jnp.stack(wkv_s), jnp.stack(sh_s))
```

```cpp
#include <hip/hip_runtime.h>
#include <cstdio>
#include <cstdint>

#ifndef MK_REP
#define MK_REP -1
#endif
#define NREP(id) ((MK_REP) == (id) ? 2 : 1)
#ifndef MK_N_LAUNCHES
#define MK_N_LAUNCHES 1
#endif

constexpr int DM = 1024, NB = 4, SEQ = 4096, NTOK = NB * SEQ, DB = 32, NPAGES = 128, PAGE = 128;
constexpr int HD = 64, RH = 6, SH = 6, XH = 4, NMEM = 256;
constexpr int RW = 384, SBW = 384, XW = 256, RCOLS = 1280, DIN = 3712;
constexpr int NTK = NTOK + DB;
constexpr int ROWS_P = 16640;
constexpr int MEMROW0 = 16640;
constexpr int MROWS1 = 17664;
constexpr int NB1 = 4352;
constexpr float LOG2E = 1.4426950408889634f, QSCALE = 0.125f * 1.4426950408889634f;
constexpr float NORM_EPS = 1e-6f, GN_EPS = 64e-5f, DECAY_SCALE = 0.60653065971263342f;

constexpr size_t OUT_Y_P = 0;
constexpr size_t OUT_Y_S = OUT_Y_P + (size_t)NTOK * DM;
constexpr size_t OUT_SBK_P = OUT_Y_S + (size_t)DB * DM;
constexpr size_t OUT_SBV_P = OUT_SBK_P + (size_t)NTOK * SBW;
constexpr size_t OUT_WKV_P = OUT_SBV_P + (size_t)NTOK * SBW;
constexpr size_t OUT_SHIFT_P = OUT_WKV_P + (size_t)NB * RH * HD * HD;
constexpr size_t OUT_MK_P = OUT_SHIFT_P + (size_t)NB * RCOLS;
constexpr size_t OUT_MV_P = OUT_MK_P + (size_t)NB * NMEM * XW;
constexpr size_t OUT_SBK_S = OUT_MV_P + (size_t)NB * NMEM * XW;
constexpr size_t OUT_SBV_S = OUT_SBK_S + (size_t)DB * SBW;
constexpr size_t OUT_WKV_S = OUT_SBV_S + (size_t)DB * SBW;
constexpr size_t OUT_SHIFT_S = OUT_WKV_S + (size_t)DB * RH * HD * HD;
constexpr size_t OUT_END = OUT_SHIFT_S + (size_t)DB * RCOLS;

constexpr size_t al256(size_t x) { return (x + 255) & ~(size_t)255; }
constexpr size_t WS_BAR = 0;
constexpr size_t WS_A1 = 16384;
constexpr size_t WS_BT1 = WS_A1 + al256((size_t)MROWS1 * DM * 2);
constexpr size_t WS_BT2 = WS_BT1 + al256((size_t)NB1 * DM * 2);
constexpr size_t WS_PRW = WS_BT2 + al256((size_t)DM * DM * 2);
constexpr size_t WS_QB = WS_PRW + al256((size_t)ROWS_P * RCOLS * 2);
constexpr size_t WS_KB = WS_QB + al256((size_t)ROWS_P * SBW * 2);
constexpr size_t WS_VB = WS_KB + al256((size_t)ROWS_P * SBW * 2);
constexpr size_t WS_XQ = WS_VB + al256((size_t)ROWS_P * SBW * 2);
constexpr size_t WS_GATE = WS_XQ + al256((size_t)ROWS_P * XW * 2);
constexpr int RSB_BLK = 388;
constexpr size_t WS_RSB = WS_GATE + al256((size_t)ROWS_P * DM * 2);
constexpr size_t WS_ORAW = WS_RSB + al256((size_t)NTK * RH * RSB_BLK * 4);
constexpr size_t WS_O = WS_ORAW + al256((size_t)NTK * RW * 4);
constexpr size_t WS_YUN = WS_O + al256((size_t)ROWS_P * DM * 2);
constexpr size_t WS_DPART = WS_YUN + al256((size_t)ROWS_P * DM * 4);
constexpr size_t WS_DL = WS_DPART + al256((size_t)DB * NPAGES * SH * HD * 4);
constexpr size_t WS_LFRAG = WS_DL + al256((size_t)DB * NPAGES * SH * 4);
constexpr size_t WS_END = WS_LFRAG + al256((size_t)2 * 2 * 6 * 4 * 2 * 64 * 16);

constexpr int LDS_STAGE = 131072;
constexpr int LDS_CTL = 155648;
constexpr int LDS_BYTES = LDS_CTL + 1024;

typedef unsigned short bf16_t;

#define XB_TMO      128
#define XB_XCNT(j)  (256  + 64 * (j))
#define XB_XSUB(j)  (1280 + 64 * (j))
#define XB_XGEN(j)  (2304 + 64 * (j))
#define XB_TOP      3328
#define XB_TOPGEN   3392
#define XCD_BAR_WORDS 3456
#define XB_SPIN_CAP (1u << 18)
#define LAS __attribute__((address_space(3)))

__device__ __forceinline__ unsigned xb_ld(unsigned* p)              { return __hip_atomic_load(p, __ATOMIC_RELAXED, __HIP_MEMORY_SCOPE_AGENT); }
__device__ __forceinline__ unsigned xb_add(unsigned* p, unsigned v) { return __hip_atomic_fetch_add(p, v, __ATOMIC_RELAXED, __HIP_MEMORY_SCOPE_AGENT); }
__device__ __forceinline__ unsigned xb_xcc_id() { return (unsigned)__builtin_amdgcn_s_getreg((3 << 11) | 20) & 0xFu; }
#define XB_SPIN(cond, bar) do { unsigned _sp = 0; while (cond) { __builtin_amdgcn_s_sleep(1); \
    if ((++_sp & 255u) == 0u) { if (xb_ld(&(bar)[XB_TMO])) break; if (_sp > XB_SPIN_CAP) { atomicAdd(&(bar)[XB_TMO], 1u); break; } } } } while (0)

struct XcdBarrier {
    unsigned* bar; unsigned x;
    volatile LAS unsigned* st;
};
__device__ __forceinline__ XcdBarrier xcd_barrier_post(unsigned* bar, volatile LAS unsigned* st) {
    XcdBarrier b; b.bar = bar; b.x = xb_xcc_id(); b.st = st;
    if (threadIdx.x == 0) (void)xb_add(&bar[XB_XCNT(b.x)], 1u);
    return b;
}
__device__ __forceinline__ void xcd_barrier_complete(unsigned* bar, unsigned x, unsigned& nloc, unsigned& nx) {
    const unsigned G = gridDim.x * gridDim.y * gridDim.z;
    unsigned sum, cnt, mine, sp = 0u;
    for (;;) {
        sum = 0u; cnt = 0u; mine = 0u;
#pragma unroll
        for (unsigned j = 0; j < 16; ++j) { const unsigned c = xb_ld(&bar[XB_XCNT(j)]); sum += c; cnt += (c > 0u) ? 1u : 0u; mine = (j == x) ? c : mine; }
        if (sum == G) break;
        __builtin_amdgcn_s_sleep(1);
        if ((++sp & 255u) == 0u) { if (xb_ld(&bar[XB_TMO])) break; if (sp > XB_SPIN_CAP) { atomicAdd(&bar[XB_TMO], 1u); break; } }
    }
    nloc = mine > 0u ? mine : 1u; nx = cnt > 0u ? cnt : 1u;
}
__device__ __forceinline__ void xcd_barrier(const XcdBarrier& b) {
    asm volatile("s_waitcnt vmcnt(0)" ::: "memory");
    __syncthreads();
    if (threadIdx.x == 0) {
        unsigned* bar = b.bar;
        __builtin_amdgcn_s_waitcnt(0);
        unsigned nloc = b.st[0], nx = b.st[1];
        if (nloc == 0u) { xcd_barrier_complete(bar, b.x, nloc, nx); b.st[0] = nloc; b.st[1] = nx; }
        const unsigned old = xb_add(&bar[XB_XSUB(b.x)], 1u);
        const unsigned gen = old / nloc;
        if (old + 1u == (gen + 1u) * nloc) {
            __builtin_amdgcn_fence(__ATOMIC_RELEASE, "agent");
            asm volatile("s_waitcnt vmcnt(0)" ::: "memory");
            const unsigned og = xb_add(&bar[XB_TOP], 1u);
            const unsigned tg = og / nx;
            if (og + 1u == (tg + 1u) * nx) xb_add(&bar[XB_TOPGEN], 1u);
            else XB_SPIN(xb_ld(&bar[XB_TOPGEN]) == tg, bar);
            __builtin_amdgcn_fence(__ATOMIC_ACQUIRE, "agent");
            xb_add(&bar[XB_XGEN(b.x)], 1u);
            asm volatile("s_waitcnt vmcnt(0)" ::: "memory");
        } else {
            XB_SPIN(xb_ld(&bar[XB_XGEN(b.x)]) == gen, bar);
            __builtin_amdgcn_fence(__ATOMIC_ACQUIRE, "agent");
            asm volatile("s_waitcnt vmcnt(0)" ::: "memory");
        }
    }
    __syncthreads();
}

namespace pg8 {
#define PG8_LAS __attribute__((address_space(3)))
typedef short bf16x8 __attribute__((ext_vector_type(8)));
typedef float f32x4 __attribute__((ext_vector_type(4)));
typedef unsigned u32x4 __attribute__((ext_vector_type(4)));
constexpr int BM = 256, BK = 64, HALF = 128, HTB = HALF * BK * 2, STAGE_BYTES = 8 * HTB, NXCD = 8, WGM = 8;

__host__ __device__ __forceinline__ int lds_byte(int r, int c) { const int st = (r >> 4) * 2 + (c >> 5), rr = r & 15, cc = c & 31, ob = rr * 64 + cc * 2; return st * 1024 + (ob ^ (((ob >> 9) & 1) << 5)); }
__host__ __device__ __forceinline__ void stage_rc(int b, int& R, int& C) { const int st = b / 1024, sb = b % 1024, swz = sb ^ (((sb >> 9) & 1) << 5); R = (st >> 1) * 16 + swz / 64; C = (st & 1) * 32 + (swz % 64) / 2; }
__host__ __device__ __forceinline__ int perm32(int rho) { const int n = rho >> 4, i = rho & 15; return 8 * (i >> 2) + 4 * n + (i & 3); }

struct Unit { int pm, pn; };
struct Gemm { const bf16_t* A; const bf16_t* Bt; int M, N, K; };

struct GridOrder {
    int nM, nN, nmain, nextra, xm0, xn0, xnn, G, c;
    __device__ void init(int nM_, int nN_, int nextra_, int xm0_, int xn0_, int xnn_, int G_, int c_) { nM = nM_; nN = nN_; nmain = nM_ * nN_; nextra = nextra_; xm0 = xm0_; xn0 = xn0_; xnn = xnn_; G = G_; c = c_; }
    __device__ bool next(int i, Unit& u) const {
        const int L = i * G + c; if (L >= nmain + nextra) return false;
        if (L >= nmain) { const int e = L - nmain; u.pm = xm0 + e / xnn; u.pn = xn0 + e % xnn; return true; }
        const int wgid = L;
        const int nig = WGM * nN, gid = wgid / nig, fm = gid * WGM, gsz = (nM - fm) < WGM ? (nM - fm) : WGM;
        u.pm = fm + ((wgid % nig) % gsz); u.pn = (wgid % nig) / gsz; return true;
    }
    __device__ __forceinline__ void a_ready(const Unit&) const {}
    __device__ __forceinline__ void done(const Unit&) const {}
};

template <class Epi, class Sched>
__device__ __forceinline__ void gemm_phase(PG8_LAS unsigned char* lds, const Gemm g, const Sched& S, const Epi& E) {
    const int tid = threadIdx.x, wid = __builtin_amdgcn_readfirstlane(tid >> 6), lane = tid & 63, wr = wid >> 2, wc = wid & 3, fr = lane & 15, fq = lane >> 4;
    const int K = g.K, nt = K / BK;
    unsigned voffA[2], voffB[2];
#pragma unroll
    for (int i = 0; i < 2; ++i) { int R, C; stage_rc(tid * 16 + i * 8192, R, C); const int Rb = Epi::PERM ? ((R & ~31) + perm32(R & 31)) : R;
        voffA[i] = (unsigned)(R * K + C) * 2u; voffB[i] = (unsigned)(Rb * K + C) * 2u; }
    const size_t kstep = (size_t)(BK * 2);
    const size_t hstep = (size_t)HALF * K * 2;
    const size_t tstep = 2 * hstep;
    const unsigned ldsw = (unsigned)wid * 1024u;
    const int aoff = lds_byte(wr * 64 + fr, fq * 8), boff = lds_byte(wc * 32 + fr, fq * 8);
#define PG8_SA(b, h) (((b) * 2 + (h)) * HTB)
#define PG8_SB(b, h) ((4 + (b) * 2 + (h)) * HTB)
#define PG8_STAGE(bufoff, gbase, voff) do { _Pragma("unroll") for (int _i = 0; _i < 2; ++_i) \
        __builtin_amdgcn_global_load_lds((const unsigned*)((const char*)(gbase) + (voff)[_i]), (PG8_LAS unsigned*)(lds + (bufoff) + ldsw + _i * 8192), 16, 0, 0); } while (0)
#define PG8_LDA(dst, b, h) do { _Pragma("unroll") for (int m = 0; m < 4; ++m) _Pragma("unroll") for (int k = 0; k < 2; ++k) dst[m][k] = *(const PG8_LAS bf16x8*)(lds + PG8_SA(b, h) + aoff + m * 2048 + k * 1024); } while (0)
#define PG8_LDB(dst, b, h) do { _Pragma("unroll") for (int n = 0; n < 2; ++n) _Pragma("unroll") for (int k = 0; k < 2; ++k) dst[n][k] = *(const PG8_LAS bf16x8*)(lds + PG8_SB(b, h) + boff + n * 2048 + k * 1024); } while (0)
#define PG8_MMA(ai, bj, At, Bt) do { __builtin_amdgcn_s_setprio(1); _Pragma("unroll") for (int m = 0; m < 4; ++m) _Pragma("unroll") for (int n = 0; n < 2; ++n) _Pragma("unroll") for (int k = 0; k < 2; ++k) \
        acc[ai][bj][m][n] = __builtin_amdgcn_mfma_f32_16x16x32_bf16(Bt[n][k], At[m][k], acc[ai][bj][m][n], 0, 0, 0); __builtin_amdgcn_s_setprio(0); } while (0)
#define PG8_WAIT_V(n) asm volatile("s_waitcnt vmcnt(" #n ")" ::: "memory")
#define PG8_WAIT_L(n) asm volatile("s_waitcnt lgkmcnt(" #n ")" ::: "memory")
#define PG8_BAR __builtin_amdgcn_s_barrier()
#define PG8_SCHED __builtin_amdgcn_sched_barrier(0)
    Unit cur, nxt; int ui = 0;
    if (!S.next(0, cur)) return;
    f32x4 acc[2][2][4][2];
#pragma unroll
    for (int a = 0; a < 2; ++a)
#pragma unroll
        for (int b = 0; b < 2; ++b)
#pragma unroll
            for (int m = 0; m < 4; ++m)
#pragma unroll
                for (int n = 0; n < 2; ++n) acc[a][b][m][n] = (f32x4){0.f, 0.f, 0.f, 0.f};
    bf16x8 At[4][2], B0[2][2], B1[2][2];
    const char* cA = (const char*)g.A + (size_t)cur.pm * tstep; const char* cB = (const char*)g.Bt + (size_t)cur.pn * tstep;
    S.a_ready(cur);
    PG8_STAGE(PG8_SB(0, 0), cB, voffB); PG8_STAGE(PG8_SA(0, 0), cA, voffA); PG8_STAGE(PG8_SB(0, 1), cB + hstep, voffB); PG8_STAGE(PG8_SA(0, 1), cA + hstep, voffA);
    if (wr == 1) PG8_BAR;
    PG8_WAIT_V(4); PG8_BAR;
    PG8_STAGE(PG8_SB(1, 0), cB + kstep, voffB); PG8_STAGE(PG8_SA(1, 0), cA + kstep, voffA); PG8_STAGE(PG8_SB(1, 1), cB + hstep + kstep, voffB);
    PG8_WAIT_V(6); PG8_BAR;
    for (;;) {
        const bool has_next = S.next(ui + 1, nxt);
        const char* nA = has_next ? (const char*)g.A + (size_t)nxt.pm * tstep : cA; const char* nB = has_next ? (const char*)g.Bt + (size_t)nxt.pn * tstep : cB;
        for (int t = 0; t < nt; t += 2) {
            const bool last = (t == nt - 2);
            const char* a1 = cA + (size_t)(t + 1) * kstep;
            const char* a2 = last ? nA : cA + (size_t)(t + 2) * kstep; const char* b2 = last ? nB : cB + (size_t)(t + 2) * kstep;
            const char* a3 = a2 + kstep; const char* b3 = b2 + kstep;
            if (last && has_next) S.a_ready(nxt);
            PG8_LDB(B0, 0, 0); PG8_SCHED; PG8_LDA(At, 0, 0); PG8_STAGE(PG8_SA(1, 1), a1 + hstep, voffA);
            PG8_WAIT_L(8); PG8_BAR; PG8_WAIT_L(0); PG8_MMA(0, 0, At, B0); PG8_BAR; PG8_SCHED;
            PG8_LDB(B1, 0, 1); PG8_STAGE(PG8_SB(0, 0), b2, voffB);
            PG8_BAR; PG8_WAIT_L(0); PG8_MMA(0, 1, At, B1); PG8_BAR;
            PG8_LDA(At, 0, 1); PG8_STAGE(PG8_SA(0, 0), a2, voffA);
            PG8_BAR; PG8_WAIT_L(0); PG8_MMA(1, 0, At, B0); PG8_BAR; PG8_SCHED;
            PG8_STAGE(PG8_SB(0, 1), b2 + hstep, voffB);
            PG8_WAIT_V(6); PG8_BAR; PG8_MMA(1, 1, At, B1); PG8_BAR;
            PG8_LDB(B0, 1, 0); PG8_SCHED; PG8_LDA(At, 1, 0); PG8_STAGE(PG8_SA(0, 1), a2 + hstep, voffA);
            PG8_WAIT_L(8); PG8_BAR; PG8_WAIT_L(0); PG8_MMA(0, 0, At, B0); PG8_BAR; PG8_SCHED;
            PG8_LDB(B1, 1, 1); PG8_STAGE(PG8_SB(1, 0), b3, voffB);
            PG8_BAR; PG8_WAIT_L(0); PG8_MMA(0, 1, At, B1); PG8_BAR;
            PG8_LDA(At, 1, 1); PG8_STAGE(PG8_SA(1, 0), a3, voffA);
            PG8_BAR; PG8_WAIT_L(0); PG8_MMA(1, 0, At, B0); PG8_BAR; PG8_SCHED;
            PG8_STAGE(PG8_SB(1, 1), b3 + hstep, voffB);
            PG8_WAIT_V(6); PG8_BAR; PG8_MMA(1, 1, At, B1); PG8_BAR;
        }
        E(acc, cur, wr, wc, fr, fq); S.done(cur);
        if (!has_next) break;
#pragma unroll
        for (int a = 0; a < 2; ++a)
#pragma unroll
            for (int b = 0; b < 2; ++b)
#pragma unroll
                for (int m = 0; m < 4; ++m)
#pragma unroll
                    for (int n = 0; n < 2; ++n) acc[a][b][m][n] = (f32x4){0.f, 0.f, 0.f, 0.f};
        cur = nxt; cA = nA; cB = nB; ++ui;
    }
    PG8_WAIT_V(0);
    if (wr == 0) PG8_BAR;
    PG8_BAR;
#undef PG8_SA
#undef PG8_SB
#undef PG8_STAGE
#undef PG8_LDA
#undef PG8_LDB
#undef PG8_MMA
#undef PG8_WAIT_V
#undef PG8_WAIT_L
#undef PG8_BAR
#undef PG8_SCHED
}
}

typedef float f32x4 __attribute__((ext_vector_type(4)));
__device__ __forceinline__ float bf2f(bf16_t b) { return __uint_as_float(((unsigned)b) << 16); }
__device__ __forceinline__ bf16_t f2bf(float f) { unsigned u = __float_as_uint(f); u += 0x7FFFu + ((u >> 16) & 1u); return (bf16_t)(u >> 16); }
typedef __bf16 bf16x2_t __attribute__((ext_vector_type(2)));
typedef float f32x2_t __attribute__((ext_vector_type(2)));
__device__ __forceinline__ unsigned pack2(float lo, float hi) { const f32x2_t v = {lo, hi}; return __builtin_bit_cast(unsigned, __builtin_convertvector(v, bf16x2_t)); }
__device__ __forceinline__ float wave_sum(float v) {
#pragma unroll
    for (int o = 32; o >= 1; o >>= 1) v += __shfl_xor(v, o);
    return v;
}
__device__ __forceinline__ float wave_max(float v) {
#pragma unroll
    for (int o = 32; o >= 1; o >>= 1) v = fmaxf(v, __shfl_xor(v, o));
    return v;
}
template <int CTRL> __device__ __forceinline__ float dpp_f(float x) { return __builtin_bit_cast(float, __builtin_amdgcn_update_dpp(0, __builtin_bit_cast(int, x), CTRL, 0xF, 0xF, true)); }
__device__ __forceinline__ float sum16(float v) {
    v += dpp_f<0xB1>(v);
    v += dpp_f<0x4E>(v);
    v += dpp_f<0x124>(v);
    v += dpp_f<0x128>(v);
    return v;
}
__device__ __forceinline__ float wave_sum_fast(float v) {
    v = sum16(v);
    { const auto s = __builtin_amdgcn_permlane16_swap(__float_as_uint(v), __float_as_uint(v), false, false); v = __uint_as_float(s[0]) + __uint_as_float(s[1]); }
    { const auto s = __builtin_amdgcn_permlane32_swap(__float_as_uint(v), __float_as_uint(v), false, false); v = __uint_as_float(s[0]) + __uint_as_float(s[1]); }
    return v;
}
__device__ __forceinline__ float sigmoidf_(float x) { return 1.f / (1.f + __expf(-x)); }
__device__ __forceinline__ float softplusf_(float z) { return fmaxf(z, 0.f) + log1pf(__expf(-fabsf(z))); }
__device__ __forceinline__ float softplus2_(float z2) { return fmaxf(z2, 0.f) + log1pf(exp2f(-fabsf(z2))) * LOG2E; }

struct Params {
    const float *x_prompt, *mem_prompt, *x_sample, *cache_k, *cache_v; const int* page_table;
    const float *state_wkv, *state_shift, *cmem_k, *cmem_v, *norm_g, *w_in, *sb_bias, *mu_shift, *w0, *w_lora_b, *a0, *a_lora_b, *k_k, *k_a, *r_k,
        *lnx_g, *lnx_b, *mem_norm_g, *w_mem_k, *w_mem_v, *w_out, *final_norm_g;
    float* out; unsigned char* ws;
    int ph_lo, ph_hi;
};

struct EpiG1 {
    static constexpr bool PERM = true;
    bf16_t* prw; bf16_t *qb, *kb, *vb, *xq, *gate; float* out;
    __device__ __forceinline__ void operator()(const pg8::f32x4 (&acc)[2][2][4][2], const pg8::Unit& u, int wr, int wc, int fr, int fq) const {
        if (u.pm >= 65) {
            float* dst = out + (u.pn == 15 ? OUT_MK_P : OUT_MV_P);
#pragma unroll
            for (int ai = 0; ai < 2; ++ai)
#pragma unroll
                for (int m = 0; m < 4; ++m) { const int row = (u.pm - 65) * 256 + ai * 128 + wr * 64 + m * 16 + fr;
#pragma unroll
                    for (int bj = 0; bj < 2; ++bj) { const int col = bj * 128 + wc * 32 + 8 * fq;
                        *(pg8::f32x4*)(dst + (size_t)row * 256 + col) = acc[ai][bj][m][0]; *(pg8::f32x4*)(dst + (size_t)row * 256 + col + 4) = acc[ai][bj][m][1]; } }
            return;
        }
#pragma unroll
        for (int bj = 0; bj < 2; ++bj) {
            const int cb = u.pn * 256 + bj * 128;
            if (cb >= DIN) continue;
#pragma unroll
            for (int ai = 0; ai < 2; ++ai)
#pragma unroll
                for (int m = 0; m < 4; ++m) { const int row = u.pm * 256 + ai * 128 + wr * 64 + m * 16 + fr;
                    if (row >= NTK) continue;
                    const int col = cb + wc * 32 + 8 * fq; const pg8::f32x4 v0 = acc[ai][bj][m][0], v1 = acc[ai][bj][m][1];
                    if (cb < 1280) {
                        *(uint4*)(prw + (size_t)row * RCOLS + col) = make_uint4(pack2(v0[0], v0[1]), pack2(v0[2], v0[3]), pack2(v1[0], v1[1]), pack2(v1[2], v1[3]));
                        if (row >= NTOK) { float* e = out + OUT_SHIFT_S + (size_t)(row - NTOK) * RCOLS + col; *(pg8::f32x4*)e = v0; *(pg8::f32x4*)(e + 4) = v1; }
                        else if ((row & (SEQ - 1)) == SEQ - 1) { float* e = out + OUT_SHIFT_P + (size_t)(row >> 12) * RCOLS + col; *(pg8::f32x4*)e = v0; *(pg8::f32x4*)(e + 4) = v1; }
                    } else if (cb < 1664) {
                        *(uint4*)(qb + (size_t)row * SBW + (col - 1280)) = make_uint4(pack2(v0[0] * QSCALE, v0[1] * QSCALE), pack2(v0[2] * QSCALE, v0[3] * QSCALE), pack2(v1[0] * QSCALE, v1[1] * QSCALE), pack2(v1[2] * QSCALE, v1[3] * QSCALE));
                    } else if (cb < 2048) {
                        const int c2 = col - 1664;
                        *(uint4*)(kb + (size_t)row * SBW + c2) = make_uint4(pack2(v0[0], v0[1]), pack2(v0[2], v0[3]), pack2(v1[0], v1[1]), pack2(v1[2], v1[3]));
                        float* e = row < NTOK ? out + OUT_SBK_P + (size_t)row * SBW + c2 : out + OUT_SBK_S + (size_t)(row - NTOK) * SBW + c2; *(pg8::f32x4*)e = v0; *(pg8::f32x4*)(e + 4) = v1;
                    } else if (cb < 2432) {
                        const int c2 = col - 2048;
                        *(uint4*)(vb + (size_t)row * SBW + c2) = make_uint4(pack2(v0[0], v0[1]), pack2(v0[2], v0[3]), pack2(v1[0], v1[1]), pack2(v1[2], v1[3]));
                        float* e = row < NTOK ? out + OUT_SBV_P + (size_t)row * SBW + c2 : out + OUT_SBV_S + (size_t)(row - NTOK) * SBW + c2; *(pg8::f32x4*)e = v0; *(pg8::f32x4*)(e + 4) = v1;
                    } else if (cb < 2688) {
                        *(uint4*)(xq + (size_t)row * XW + (col - 2432)) = make_uint4(pack2(v0[0] * QSCALE, v0[1] * QSCALE), pack2(v0[2] * QSCALE, v0[3] * QSCALE), pack2(v1[0] * QSCALE, v1[1] * QSCALE), pack2(v1[2] * QSCALE, v1[3] * QSCALE));
                    } else {
                        *(uint4*)(gate + (size_t)row * DM + (col - 2688)) = make_uint4(pack2(v0[0] * sigmoidf_(v0[0]), v0[1] * sigmoidf_(v0[1])), pack2(v0[2] * sigmoidf_(v0[2]), v0[3] * sigmoidf_(v0[3])),
                                                                                    pack2(v1[0] * sigmoidf_(v1[0]), v1[1] * sigmoidf_(v1[1])), pack2(v1[2] * sigmoidf_(v1[2]), v1[3] * sigmoidf_(v1[3])));
                    }
                }
        }
    }
};
struct EpiG2 {
    static constexpr bool PERM = true;
    const float* xp; const float* xs; float* yun;
    __device__ __forceinline__ void operator()(const pg8::f32x4 (&acc)[2][2][4][2], const pg8::Unit& u, int wr, int wc, int fr, int fq) const {
#pragma unroll
        for (int ai = 0; ai < 2; ++ai)
#pragma unroll
            for (int m = 0; m < 4; ++m) { const int row = u.pm * 256 + ai * 128 + wr * 64 + m * 16 + fr;
                if (row >= NTK) continue;
                const float* xr = row < NTOK ? xp + (size_t)row * DM : xs + (size_t)(row - NTOK) * DM;
#pragma unroll
                for (int bj = 0; bj < 2; ++bj) { const int col = u.pn * 256 + bj * 128 + wc * 32 + 8 * fq;
                    *(pg8::f32x4*)(yun + (size_t)row * DM + col) = acc[ai][bj][m][0] + *(const pg8::f32x4*)(xr + col);
                    *(pg8::f32x4*)(yun + (size_t)row * DM + col + 4) = acc[ai][bj][m][1] + *(const pg8::f32x4*)(xr + col + 4); } }
    }
};

typedef short prep_bf16x8 __attribute__((ext_vector_type(8)));
typedef float prep_f32x4 __attribute__((ext_vector_type(4)));
__device__ __forceinline__ void split8(const float (&x)[8], prep_bf16x8& hi, prep_bf16x8& lo) {
    unsigned h[4], l[4];
#pragma unroll
    for (int q = 0; q < 4; ++q) { h[q] = pack2(x[2 * q], x[2 * q + 1]);
        const float r0 = x[2 * q] - __uint_as_float(h[q] << 16), r1 = x[2 * q + 1] - __uint_as_float(h[q] & 0xffff0000u); l[q] = pack2(r0, r1); }
    typedef unsigned u4 __attribute__((ext_vector_type(4)));
    const u4 hv = {h[0], h[1], h[2], h[3]}, lv = {l[0], l[1], l[2], l[3]};
    hi = __builtin_bit_cast(prep_bf16x8, hv); lo = __builtin_bit_cast(prep_bf16x8, lv);
}
__device__ __forceinline__ void p0_prologue(const Params& P, float* lds) {
    const int tid = threadIdx.x, lane = tid & 63, wave = tid >> 6;
    bf16_t* A1 = (bf16_t*)(P.ws + WS_A1); bf16_t* Bt1 = (bf16_t*)(P.ws + WS_BT1); bf16_t* Bt2 = (bf16_t*)(P.ws + WS_BT2);
    const int gw = blockIdx.x * 8 + wave, nw = gridDim.x * 8;
    for (int r0 = gw; r0 < MROWS1; r0 += 2 * nw) {
        const float* srcs[2]; const float* gs[2]; bf16_t* dsts[2]; bool live[2];
#pragma unroll
        for (int q = 0; q < 2; ++q) { const int r = r0 + q * nw; live[q] = r < MROWS1; const int rr = live[q] ? r : 0;
            dsts[q] = A1 + (size_t)rr * DM; srcs[q] = nullptr; gs[q] = P.norm_g;
            if (rr < NTOK) srcs[q] = P.x_prompt + (size_t)rr * DM;
            else if (rr < NTK) srcs[q] = P.x_sample + (size_t)(rr - NTOK) * DM;
            else if (rr >= MEMROW0) { srcs[q] = P.mem_prompt + (size_t)(rr - MEMROW0) * DM; gs[q] = P.mem_norm_g; } }
        float4 x[2][4]; float ss[2] = {0.f, 0.f};
#pragma unroll
        for (int q = 0; q < 2; ++q)
#pragma unroll
            for (int j = 0; j < 4; ++j) x[q][j] = (live[q] && srcs[q]) ? *(const float4*)(srcs[q] + 4 * lane + 256 * j) : make_float4(0.f, 0.f, 0.f, 0.f);
#pragma unroll
        for (int q = 0; q < 2; ++q) {
#pragma unroll
            for (int j = 0; j < 4; ++j) ss[q] += x[q][j].x * x[q][j].x + x[q][j].y * x[q][j].y + x[q][j].z * x[q][j].z + x[q][j].w * x[q][j].w;
            ss[q] = wave_sum_fast(ss[q]); }
#pragma unroll
        for (int q = 0; q < 2; ++q) { if (!live[q]) continue;
            const float rs = rsqrtf(ss[q] * (1.f / DM) + NORM_EPS);
#pragma unroll
            for (int j = 0; j < 4; ++j) { const float4 gg = *(const float4*)(gs[q] + 4 * lane + 256 * j);
                uint2 w; w.x = pack2(x[q][j].x * rs * gg.x, x[q][j].y * rs * gg.y); w.y = pack2(x[q][j].z * rs * gg.z, x[q][j].w * rs * gg.w);
                *(uint2*)(dsts[q] + 4 * lane + 256 * j) = w; } }
    }
    for (int i = blockIdx.x * 512 + tid; i < 128 * DM / 4; i += gridDim.x * 512) *(uint2*)(Bt1 + (size_t)DIN * DM + (size_t)i * 4) = make_uint2(0u, 0u);
    for (int task = blockIdx.x; task < 1312; task += gridDim.x) {
        const float* src; int ld; bf16_t* dst; int k0;
        if (task < 928) { const int kt = task / 58, nt = task % 58; src = P.w_in + (size_t)kt * 64 * DIN + nt * 64; ld = DIN; dst = Bt1 + (size_t)(nt * 64) * DM; k0 = kt * 64; }
        else if (task < 992) { const int e = task - 928, kt = e / 4, nt = e % 4; src = P.w_mem_k + (size_t)kt * 64 * XW + nt * 64; ld = XW; dst = Bt1 + (size_t)(3840 + nt * 64) * DM; k0 = kt * 64; }
        else if (task < 1056) { const int e = task - 992, kt = e / 4, nt = e % 4; src = P.w_mem_v + (size_t)kt * 64 * XW + nt * 64; ld = XW; dst = Bt1 + (size_t)(4096 + nt * 64) * DM; k0 = kt * 64; }
        else { const int e = task - 1056, kt = e / 16, nt = e % 16; src = P.w_out + (size_t)kt * 64 * DM + nt * 64; ld = DM; dst = Bt2 + (size_t)(nt * 64) * DM; k0 = kt * 64; }
        __syncthreads();
#pragma unroll
        for (int p = 0; p < 8; ++p) { const int i = p * 8 + wave; lds[i * 65 + lane] = src[(size_t)i * ld + lane]; }
        __syncthreads();
        {
            const int jj = tid >> 3, kc = tid & 7;
            unsigned w[4];
#pragma unroll
            for (int q = 0; q < 4; ++q) w[q] = pack2(lds[(kc * 8 + 2 * q) * 65 + jj], lds[(kc * 8 + 2 * q + 1) * 65 + jj]);
            *(uint4*)(dst + (size_t)jj * DM + k0 + kc * 8) = make_uint4(w[0], w[1], w[2], w[3]);
        }
    }
    for (int idx = blockIdx.x * 512 + tid; idx < 2 * 6 * 4 * 2 * 64; idx += gridDim.x * 512) {
        const int l = idx & 63, s = (idx >> 6) & 1, nt = (idx >> 7) & 3, w = (idx >> 9) % 6, mt = idx / (512 * 6);
        const float* W = mt ? P.a_lora_b : P.w_lora_b; float x[8];
#pragma unroll
        for (int j = 0; j < 8; ++j) x[j] = W[(size_t)(32 * s + 8 * (l >> 4) + j) * RW + 64 * w + 16 * nt + (l & 15)];
        prep_bf16x8 hi, lo; split8(x, hi, lo);
        prep_bf16x8* LF = (prep_bf16x8*)(P.ws + WS_LFRAG);
        LF[idx] = hi; LF[2 * 6 * 4 * 2 * 64 + idx] = lo;
    }
    __syncthreads();
}

__device__ __forceinline__ void prep_produce(const Params& P, const bf16_t* __restrict__ prw, int ch, float* buf, int j, float mux) {
    constexpr int CT = 8;
    const int tok0 = ch * CT;
    float pv = 0.f;
    if (tok0 < NTOK && (tok0 & (SEQ - 1))) pv = bf2f(prw[(size_t)(tok0 - 1) * RCOLS + 1152 + j]);
    float cur[CT];
#pragma unroll
    for (int tk = 0; tk < CT; ++tk) cur[tk] = bf2f(prw[(size_t)(tok0 + tk) * RCOLS + 1152 + j]);
#pragma unroll
    for (int tk = 0; tk < CT; ++tk) {
        const int tok = tok0 + tk;
        if (tok >= NTOK) pv = P.state_shift[(size_t)(tok - NTOK) * RCOLS + 1152 + j];
        float x = cur[tk] + (pv - cur[tk]) * mux;
        if (j < 64) x = tanhf(x);
        buf[tk * 128 + j] = x;
        pv = cur[tk];
    }
}
__device__ __forceinline__ void p2_rwkv_prep(const Params& P, float* lds) {
    const int tid = threadIdx.x, lane = tid & 63, wave = tid >> 6;
    const bf16_t* prw = (const bf16_t*)(P.ws + WS_PRW);
    float* RSB = (float*)(P.ws + WS_RSB);
    constexpr int CT = 8, NCHK = NTK / CT;
    float* xbuf = lds;
    float* yt = lds + 2 * CT * 128 + wave * (2 * CT * 64);
    float* ot = lds + 2 * CT * 128 + 8 * (2 * CT * 64) + wave * 384;
    prep_bf16x8 wbh[2][4][2], wbl[2][4][2];
    float w0c = 0.f, a0c = 0.f, kkc = 0.f, kac = 0.f, rkc = 0.f, mur = 0.f, muk = 0.f, muv = 0.f, mux = 0.f;
    if (tid < RW) {
        const prep_bf16x8* LF = (const prep_bf16x8*)(P.ws + WS_LFRAG);
#pragma unroll
        for (int mt = 0; mt < 2; ++mt)
#pragma unroll
            for (int nt = 0; nt < 4; ++nt)
#pragma unroll
                for (int s = 0; s < 2; ++s) { const int fi = (((mt * 6 + wave) * 4 + nt) * 2 + s) * 64 + lane; wbh[mt][nt][s] = LF[fi]; wbl[mt][nt][s] = LF[2 * 6 * 4 * 2 * 64 + fi]; }
        w0c = P.w0[tid]; a0c = P.a0[tid]; kkc = P.k_k[tid]; kac = P.k_a[tid]; rkc = P.r_k[tid];
        mur = P.mu_shift[tid]; muk = P.mu_shift[RW + tid]; muv = P.mu_shift[2 * RW + tid];
    } else {
#pragma unroll
        for (int mt = 0; mt < 2; ++mt)
#pragma unroll
            for (int nt = 0; nt < 4; ++nt)
#pragma unroll
                for (int s = 0; s < 2; ++s)
#pragma unroll
                    for (int j = 0; j < 8; ++j) { wbh[mt][nt][s][j] = 0; wbl[mt][nt][s][j] = 0; }
        mux = P.mu_shift[1152 + (tid - RW)];
    }
    int ch = blockIdx.x;
    if (tid >= RW && ch < NCHK) prep_produce(P, prw, ch, xbuf, tid - RW, mux);
    for (int it = 0; ch < NCHK; ch += gridDim.x, ++it) {
        const int tok0 = ch * CT;
        float* bufc = xbuf + (it & 1) * (CT * 128); float* bufn = xbuf + ((it + 1) & 1) * (CT * 128);
        float nr[4], nk[4], nv[4], qr = 0.f, qk = 0.f, qv = 0.f;
        if (tid < RW) {
#pragma unroll
            for (int q = 0; q < 4; ++q) { const bf16_t* p = prw + (size_t)(tok0 + q) * RCOLS + tid; nr[q] = bf2f(p[0]); nk[q] = bf2f(p[RW]); nv[q] = bf2f(p[2 * RW]); }
            if (tok0 < NTOK && (tok0 & (SEQ - 1))) { const bf16_t* p = prw + (size_t)(tok0 - 1) * RCOLS + tid; qr = bf2f(p[0]); qk = bf2f(p[RW]); qv = bf2f(p[2 * RW]); }
        }
        __syncthreads();
        if (tid >= RW) { if (ch + (int)gridDim.x < NCHK) prep_produce(P, prw, ch + gridDim.x, bufn, tid - RW, mux); }
        else {
            const int c = tid, h = tid >> 6, cc = c & 63;
            {
                prep_bf16x8 ah[2][2], al_[2][2];
#pragma unroll
                for (int mt = 0; mt < 2; ++mt)
#pragma unroll
                    for (int s = 0; s < 2; ++s) { float x[8];
                        const float* xp = bufc + (lane & 7) * 128 + mt * 64 + 32 * s + 8 * (lane >> 4);
                        const float4 x0 = *(const float4*)xp, x1 = *(const float4*)(xp + 4);
                        const bool real = (lane & 15) < CT;
                        x[0] = real ? x0.x : 0.f; x[1] = real ? x0.y : 0.f; x[2] = real ? x0.z : 0.f; x[3] = real ? x0.w : 0.f;
                        x[4] = real ? x1.x : 0.f; x[5] = real ? x1.y : 0.f; x[6] = real ? x1.z : 0.f; x[7] = real ? x1.w : 0.f;
                        split8(x, ah[mt][s], al_[mt][s]); }
#pragma unroll
                for (int mt = 0; mt < 2; ++mt)
#pragma unroll
                    for (int nt = 0; nt < 4; ++nt) { prep_f32x4 acc = {0.f, 0.f, 0.f, 0.f};
#pragma unroll
                        for (int s = 0; s < 2; ++s) {
                            acc = __builtin_amdgcn_mfma_f32_16x16x32_bf16(al_[mt][s], wbh[mt][nt][s], acc, 0, 0, 0);
                            acc = __builtin_amdgcn_mfma_f32_16x16x32_bf16(ah[mt][s], wbl[mt][nt][s], acc, 0, 0, 0);
                            acc = __builtin_amdgcn_mfma_f32_16x16x32_bf16(ah[mt][s], wbh[mt][nt][s], acc, 0, 0, 0); }
                        if ((lane >> 4) < 2) {
#pragma unroll
                            for (int r = 0; r < 4; ++r) yt[(mt * CT + 4 * (lane >> 4) + r) * 64 + 16 * nt + (lane & 15)] = acc[r]; } }
                asm volatile("s_waitcnt lgkmcnt(0)" ::: "memory");
                __builtin_amdgcn_wave_barrier();
            }
#pragma unroll
            for (int tk = 0; tk < CT; ++tk) {
                const int tok = tok0 + tk;
                if (tok >= NTOK) { const float* p = P.state_shift + (size_t)(tok - NTOK) * RCOLS + tid; qr = p[0]; qk = p[RW]; qv = p[2 * RW]; }
                const float cr = nr[tk & 3], ck = nk[tk & 3], cv = nv[tk & 3];
                if (tk + 4 < CT) { const bf16_t* p = prw + (size_t)(tok + 4) * RCOLS + tid; nr[tk & 3] = bf2f(p[0]); nk[tk & 3] = bf2f(p[RW]); nv[tk & 3] = bf2f(p[2 * RW]); }
                const float r = cr + (qr - cr) * mur, kraw = ck + (qk - ck) * muk, v = cv + (qv - cv) * muv;
                qr = cr; qk = ck; qv = cv;
                const float aw = w0c + yt[tk * 64 + cc], aa = a0c + yt[(CT + tk) * 64 + cc];
                float* blk = RSB + ((size_t)tok * RH + h) * RSB_BLK;
                const float w = __expf(-DECAY_SCALE * sigmoidf_(aw)), a = sigmoidf_(aa);
                const float kkv = kraw * kkc;
                const float n2 = wave_sum_fast(kkv * kkv);
                const float kk = kkv * rsqrtf(fmaxf(n2, 1e-12f));
                const float kmod = kraw * (1.f + (a - 1.f) * kac);
                const float rk = wave_sum_fast(r * kmod * rkc);
                const float bb = kk * a;
                const float br = wave_sum_fast(bb * r), kr = wave_sum_fast(kmod * r);
                ot[cc] = kk; ot[64 + cc] = w; ot[128 + cc] = bb; ot[192 + cc] = kmod; ot[256 + cc] = w * r; ot[320 + cc] = v;
                asm volatile("s_waitcnt lgkmcnt(0)" ::: "memory");
                __builtin_amdgcn_wave_barrier();
                *(float4*)(blk + 4 * lane) = *(const float4*)(ot + 4 * lane);
                if (lane < 32) *(float4*)(blk + 256 + 4 * lane) = *(const float4*)(ot + 256 + 4 * lane);
                if (lane == 0) *(float4*)(blk + 384) = make_float4(br, kr, rk, 0.f);
                __builtin_amdgcn_wave_barrier();
            }
            __builtin_amdgcn_wave_barrier();
        }
    }
    __syncthreads();
}

__device__ __forceinline__ void p2_xattn_sample(const Params& P, float* lds) {
    const int tid = threadIdx.x, lane = tid & 63, wave = tid >> 6;
    const bf16_t* xq = (const bf16_t*)(P.ws + WS_XQ); const bf16_t* gate = (const bf16_t*)(P.ws + WS_GATE); bf16_t* O = (bf16_t*)(P.ws + WS_O);
    float* zl = lds + wave * 64; float* part = lds + 512;
    const int c = lane & 15, g = lane >> 4;
    for (int task = (int)blockIdx.x - 128; task >= 0 && task < DB * XH; task += 128) {
        const int b = task >> 2, h = task & 3; const size_t row = NTOK + b;
        const bf16_t* qp = xq + row * XW + h * 64 + 4 * c;
        const float q0 = bf2f(qp[0]), q1 = bf2f(qp[1]), q2 = bf2f(qp[2]), q3 = bf2f(qp[3]);
        const float* Kp = P.cmem_k + (((size_t)b * NMEM + wave * 32) * XH + h) * HD + 4 * c; const float* Vp = P.cmem_v + (((size_t)b * NMEM + wave * 32) * XH + h) * HD + 4 * c;
        __syncthreads();
        float4 k4[8], v4[8];
#pragma unroll
        for (int i = 0; i < 8; ++i) { k4[i] = *(const float4*)(Kp + (size_t)(4 * i + g) * (XH * HD)); v4[i] = *(const float4*)(Vp + (size_t)(4 * i + g) * (XH * HD)); }
#pragma unroll
        for (int i = 0; i < 8; ++i) { float p = q0 * k4[i].x + q1 * k4[i].y + q2 * k4[i].z + q3 * k4[i].w; p = sum16(p); if (c == 0) zl[4 * i + g] = p; }
        asm volatile("s_waitcnt lgkmcnt(0)" ::: "memory");
        __builtin_amdgcn_wave_barrier();
        const float z = zl[lane & 31];
        const float mx = wave_max(z);
        const float p = (lane < 32) ? exp2f(z - mx) : 0.f;
        const float ls = wave_sum_fast(p);
        __builtin_amdgcn_wave_barrier();
        if (lane < 32) zl[lane] = p;
        asm volatile("s_waitcnt lgkmcnt(0)" ::: "memory");
        __builtin_amdgcn_wave_barrier();
        float4 o4 = make_float4(0.f, 0.f, 0.f, 0.f);
#pragma unroll
        for (int i = 0; i < 8; ++i) { const float w = zl[4 * i + g]; o4.x += w * v4[i].x; o4.y += w * v4[i].y; o4.z += w * v4[i].z; o4.w += w * v4[i].w; }
#pragma unroll
        for (int off = 16; off < 64; off <<= 1) { o4.x += __shfl_xor(o4.x, off); o4.y += __shfl_xor(o4.y, off); o4.z += __shfl_xor(o4.z, off); o4.w += __shfl_xor(o4.w, off); }
        if (g == 0) *(float4*)(part + wave * 68 + 4 * c) = o4;
        if (lane == 0) { part[wave * 68 + 64] = mx; part[wave * 68 + 65] = ls; }
        __syncthreads();
        if (wave == 0) {
            float M = part[64];
#pragma unroll
            for (int w = 1; w < 8; ++w) M = fmaxf(M, part[w * 68 + 64]);
            float L = 0.f, o = 0.f;
#pragma unroll
            for (int w = 0; w < 8; ++w) { const float sc = exp2f(part[w * 68 + 64] - M); L += part[w * 68 + 65] * sc; o += part[w * 68 + lane] * sc; }
            O[row * DM + 768 + h * 64 + lane] = f2bf(o / L * bf2f(gate[row * DM + 768 + h * 64 + lane]));
        }
    }
    __syncthreads();
}

constexpr int DEC_NTASK = DB * NPAGES * SH, DEC_LDS_OFF = 144384;
constexpr int QW_SB = 3584, QW_DEC = 3648;
__device__ __forceinline__ void sb_decode_task(const Params& P, float* lds, int task) {
    const int tid = threadIdx.x, lane = tid & 63, wave = tid >> 6;
    const bf16_t* qb = (const bf16_t*)(P.ws + WS_QB);
    float* dpart = (float*)(P.ws + WS_DPART); float* dl = (float*)(P.ws + WS_DL);
    float* zl = lds + DEC_LDS_OFF / 4 + wave * 256; float* wl = zl + 128;
    const int c = lane & 15, g = lane >> 4;
    {
        const int h = task % SH, bj = task / SH, b = bj / NPAGES;
        const int page = P.page_table[bj];
        const float* Kp = P.cache_k + ((size_t)page * PAGE * SH + h) * HD;
        const float* Vp = P.cache_v + ((size_t)page * PAGE * SH + h) * HD;
        const bf16_t* qp = qb + (size_t)(NTOK + b) * SBW + h * 64 + 4 * c;
        const float q0 = bf2f(qp[0]), q1 = bf2f(qp[1]), q2 = bf2f(qp[2]), q3 = bf2f(qp[3]);
        const float bias = P.sb_bias[h] * LOG2E;
        float4 kv[16];
#pragma unroll
        for (int i = 0; i < 16; ++i) kv[i] = *(const float4*)(Kp + (size_t)(4 * i + g) * (SH * HD) + 4 * c);
#pragma unroll
        for (int hb = 0; hb < 2; ++hb) {
            float4 nx[16];
            if (hb == 0) {
#pragma unroll
                for (int i = 0; i < 16; ++i) nx[i] = *(const float4*)(Kp + (size_t)(64 + 4 * i + g) * (SH * HD) + 4 * c);
            } else {
#pragma unroll
                for (int i = 0; i < 16; ++i) nx[i] = *(const float4*)(Vp + (size_t)(4 * i + g) * (SH * HD) + 4 * c);
            }
#pragma unroll
            for (int i = 0; i < 16; ++i) { const int s = 64 * hb + 4 * i + g;
                float part = q0 * kv[i].x + q1 * kv[i].y + q2 * kv[i].z + q3 * kv[i].w; part = sum16(part);
                if (c == 0) zl[s] = part + bias; }
#pragma unroll
            for (int i = 0; i < 16; ++i) kv[i] = nx[i];
        }
        asm volatile("s_waitcnt lgkmcnt(0)" ::: "memory");
        __builtin_amdgcn_wave_barrier();
        const float z0 = zl[2 * lane], z1 = zl[2 * lane + 1];
        const float sp0 = softplus2_(z0), sp1 = softplus2_(z1);
        float incl = sp0 + sp1;
#pragma unroll
        for (int off = 1; off < 64; off <<= 1) { const float t = __shfl_down(incl, off); if (lane + off < 64) incl += t; }
        const float excl = incl - (sp0 + sp1);
        wl[2 * lane] = exp2f(z0 - sp0 - (excl + sp1));
        wl[2 * lane + 1] = exp2f(z1 - sp1 - excl);
        const float Ltot = __shfl(incl, 0);
        asm volatile("s_waitcnt lgkmcnt(0)" ::: "memory");
        __builtin_amdgcn_wave_barrier();
        float4 o4 = make_float4(0.f, 0.f, 0.f, 0.f);
        {
            float4 nx[16];
#pragma unroll
            for (int i = 0; i < 16; ++i) nx[i] = *(const float4*)(Vp + (size_t)(64 + 4 * i + g) * (SH * HD) + 4 * c);
#pragma unroll
            for (int i = 0; i < 16; ++i) { const float w = wl[4 * i + g]; o4.x += w * kv[i].x; o4.y += w * kv[i].y; o4.z += w * kv[i].z; o4.w += w * kv[i].w; }
#pragma unroll
            for (int i = 0; i < 16; ++i) { const float w = wl[64 + 4 * i + g]; o4.x += w * nx[i].x; o4.y += w * nx[i].y; o4.z += w * nx[i].z; o4.w += w * nx[i].w; }
        }
#pragma unroll
        for (int off = 16; off < 64; off <<= 1) { o4.x += __shfl_xor(o4.x, off); o4.y += __shfl_xor(o4.y, off); o4.z += __shfl_xor(o4.z, off); o4.w += __shfl_xor(o4.w, off); }
        if (g == 0) *(float4*)(dpart + (size_t)task * HD + 4 * c) = o4;
        if (lane == 0) dl[task] = Ltot;
        __builtin_amdgcn_wave_barrier();
    }
}

__device__ __forceinline__ void sb_decode_wave_loop(const Params& P, float* lds) {
    unsigned* qd = (unsigned*)(P.ws + WS_BAR) + QW_DEC;
    const int lane = threadIdx.x & 63;
    unsigned nxt = 0u;
    if (lane == 0) nxt = atomicAdd(qd, 2u);
    for (;;) {
        const int t = __builtin_amdgcn_readfirstlane((int)nxt);
        if (t >= DEC_NTASK) break;
        if (lane == 0) nxt = atomicAdd(qd, 2u);
        sb_decode_task(P, lds, t); sb_decode_task(P, lds, t + 1);
    }
}

struct StepIn { float4 kk, w, b, k, wr; float v; float2 sc; };
__device__ __forceinline__ void load_step(StepIn& s, const float* __restrict__ p, int c0, int rl) {
    s.kk = *(const float4*)(p + c0); s.w = *(const float4*)(p + 64 + c0); s.b = *(const float4*)(p + 128 + c0); s.k = *(const float4*)(p + 192 + c0); s.wr = *(const float4*)(p + 256 + c0);
    s.v = p[320 + rl]; s.sc = *(const float2*)(p + 384);
}
__device__ __forceinline__ void scan_step(float4& S, const StepIn& s, float* __restrict__ op) {
    float d1 = S.x * s.kk.x + S.y * s.kk.y + S.z * s.kk.z + S.w * s.kk.w;
    float d2 = S.x * s.wr.x + S.y * s.wr.y + S.z * s.wr.z + S.w * s.wr.w;
    d1 = sum16(d1); d2 = sum16(d2);
    S.x = S.x * s.w.x - d1 * s.b.x + s.v * s.k.x; S.y = S.y * s.w.y - d1 * s.b.y + s.v * s.k.y; S.z = S.z * s.w.z - d1 * s.b.z + s.v * s.k.z; S.w = S.w * s.w.w - d1 * s.b.w + s.v * s.k.w;
    *op = d2 - d1 * s.sc.x + s.v * s.sc.y;
}
__device__ __forceinline__ float scan_step_asm(float4& S, const StepIn& s) {
    float o, d1, d2, t;
    asm volatile(
        "v_mul_f32 %5, %0, %8\n\t"  "v_mul_f32 %6, %0, %12\n\t"
        "v_fmac_f32 %5, %1, %9\n\t" "v_fmac_f32 %6, %1, %13\n\t"
        "v_fmac_f32 %5, %2, %10\n\t" "v_fmac_f32 %6, %2, %14\n\t"
        "v_fmac_f32 %5, %3, %11\n\t" "v_fmac_f32 %6, %3, %15\n\t"
        "v_mul_f32 %0, %0, %16\n\t" "v_mul_f32 %1, %1, %17\n\t"
        "v_add_f32_dpp %5, %5, %5 quad_perm:[1,0,3,2] row_mask:0xf bank_mask:0xf\n\t"
        "v_add_f32_dpp %6, %6, %6 quad_perm:[1,0,3,2] row_mask:0xf bank_mask:0xf\n\t"
        "v_mul_f32 %2, %2, %18\n\t" "v_mul_f32 %3, %3, %19\n\t"
        "v_add_f32_dpp %5, %5, %5 quad_perm:[2,3,0,1] row_mask:0xf bank_mask:0xf\n\t"
        "v_add_f32_dpp %6, %6, %6 quad_perm:[2,3,0,1] row_mask:0xf bank_mask:0xf\n\t"
        "v_fmac_f32 %0, %28, %20\n\t" "v_fmac_f32 %1, %28, %21\n\t"
        "v_add_f32_dpp %5, %5, %5 row_ror:4 row_mask:0xf bank_mask:0xf\n\t"
        "v_add_f32_dpp %6, %6, %6 row_ror:4 row_mask:0xf bank_mask:0xf\n\t"
        "v_fmac_f32 %2, %28, %22\n\t" "v_fmac_f32 %3, %28, %23\n\t"
        "v_add_f32_dpp %5, %5, %5 row_ror:8 row_mask:0xf bank_mask:0xf\n\t"
        "v_add_f32_dpp %6, %6, %6 row_ror:8 row_mask:0xf bank_mask:0xf\n\t"
        "v_mul_f32 %7, %28, %30\n\t"
        "v_fma_f32 %0, -%5, %24, %0\n\t" "v_fma_f32 %1, -%5, %25, %1\n\t" "v_fma_f32 %2, -%5, %26, %2\n\t" "v_fma_f32 %3, -%5, %27, %3\n\t"
        "v_add_f32 %4, %6, %7\n\t"
        "v_fma_f32 %4, -%5, %29, %4\n\t"
        "s_nop 0"
        : "+v"(S.x), "+v"(S.y), "+v"(S.z), "+v"(S.w), "=&v"(o), "=&v"(d1), "=&v"(d2), "=&v"(t)
        : "v"(s.kk.x), "v"(s.kk.y), "v"(s.kk.z), "v"(s.kk.w), "v"(s.wr.x), "v"(s.wr.y), "v"(s.wr.z), "v"(s.wr.w),
          "v"(s.w.x), "v"(s.w.y), "v"(s.w.z), "v"(s.w.w), "v"(s.k.x), "v"(s.k.y), "v"(s.k.z), "v"(s.k.w),
          "v"(s.b.x), "v"(s.b.y), "v"(s.b.z), "v"(s.b.w), "v"(s.v), "v"(s.sc.x), "v"(s.sc.y));
    return o;
}
__device__ __forceinline__ void scan_rows(const Params& P, int tok0, int T, int h, int row0, const float* S0, float* Sout, int lane) {
    const int rl = row0 + (lane >> 4), c0 = (lane & 15) * 4;
    const float* p = (const float*)(P.ws + WS_RSB) + ((size_t)tok0 * RH + h) * RSB_BLK;
    float* op = (float*)(P.ws + WS_ORAW) + (size_t)tok0 * RW + h * 64 + rl;
    constexpr int PST = RH * RSB_BLK;
    float4 S = S0 ? *(const float4*)(S0 + rl * 64 + c0) : make_float4(0.f, 0.f, 0.f, 0.f);
    if (T >= 16) {
        StepIn ring[8];
#pragma unroll
        for (int j = 0; j < 8; ++j) load_step(ring[j], p + (size_t)j * PST, c0, rl);
        for (int t0 = 0; t0 < T - 8; t0 += 8) {
#pragma unroll
            for (int j = 0; j < 8; ++j) { scan_step(S, ring[j], op + (size_t)j * RW); load_step(ring[j], p + (size_t)(8 + j) * PST, c0, rl); }
            p += 8 * PST; op += 8 * RW;
        }
#pragma unroll
        for (int j = 0; j < 8; ++j) scan_step(S, ring[j], op + (size_t)j * RW);
    } else {
        for (int t = 0; t < T; ++t) { StepIn s; load_step(s, p + (size_t)t * PST, c0, rl); scan_step(S, s, op + (size_t)t * RW); }
    }
    *(float4*)(Sout + rl * 64 + c0) = S;
}

constexpr int SCH = 16, SC_NPIECE = SCH * 97, SC_NP64 = (SC_NPIECE + 63) / 64, SC_BUF = 28672, SC_NB = 5;
__device__ __forceinline__ void lds_load_step(StepIn& s, const float* p, int c0, int rl) {
    s.kk = *(const float4*)(p + c0); s.w = *(const float4*)(p + 64 + c0); s.b = *(const float4*)(p + 128 + c0); s.k = *(const float4*)(p + 192 + c0); s.wr = *(const float4*)(p + 256 + c0);
    s.v = p[320 + rl]; s.sc = *(const float2*)(p + 384);
}
#ifndef SC_FREE_WAVES
#define SC_FREE_WAVES 2
#endif
constexpr int SC_CTL_OFF = SC_NB * 28672;
__device__ __forceinline__ void scan_prompt_wave(const Params& P, unsigned char* lds, int b, int h, int quarter) {
    const int tid = threadIdx.x, lane = tid & 63; const int wave = __builtin_amdgcn_readfirstlane(tid >> 6);
    constexpr int PST = RH * RSB_BLK, NCH = SEQ / SCH;
    volatile LAS unsigned* scw = (volatile LAS unsigned*)((LAS unsigned char*)lds + SC_CTL_OFF);
    if (wave == 4) {
        const float* g0 = (const float*)(P.ws + WS_RSB) + ((size_t)(b * SEQ) * RH + h) * RSB_BLK;
        LAS unsigned char* l3 = (LAS unsigned char*)lds;
        int soff[SC_NP64];
#pragma unroll
        for (int j = 0; j < SC_NP64; ++j) { const int i = j * 64 + lane; const int ii = i < SC_NPIECE ? i : SC_NPIECE - 1; soff[j] = (ii / 97) * PST + (ii % 97) * 4; }
        for (int c = 0; c < NCH; ++c) {
            if (c >= SC_NB) {
                for (;;) { const unsigned d0 = scw[1], d1 = scw[2], d2 = scw[3], d3 = scw[4]; const unsigned m01 = d0 < d1 ? d0 : d1, m23 = d2 < d3 ? d2 : d3;
                    if ((m01 < m23 ? m01 : m23) >= (unsigned)(c - SC_NB + 1)) break; __builtin_amdgcn_s_sleep(1); }
            }
            const float* g_ = g0 + (size_t)c * SCH * PST;
#pragma unroll
            for (int j = 0; j < SC_NP64; ++j) {
                if (j * 64 + lane < SC_NPIECE) __builtin_amdgcn_global_load_lds((const unsigned*)(g_ + soff[j]), (LAS unsigned*)(l3 + (c % SC_NB) * SC_BUF + j * 1024), 16, 0, 0);
            }
            if (c >= 1) { asm volatile("s_waitcnt vmcnt(25)" ::: "memory"); if (lane == 0) scw[0] = (unsigned)c; }
        }
        asm volatile("s_waitcnt vmcnt(0)" ::: "memory");
        if (lane == 0) scw[0] = (unsigned)NCH;
    } else if (wave < 4) {
        const int rl = quarter * 16 + wave * 4 + (lane >> 4), cl = lane & 15, c0 = cl * 4;
        float* op = (float*)(P.ws + WS_ORAW) + (size_t)(b * SEQ) * RW + h * 64 + rl;
        float4 S = make_float4(0.f, 0.f, 0.f, 0.f);
        while (scw[0] < 1u) __builtin_amdgcn_s_sleep(1);
        asm volatile("" ::: "memory");
        StepIn r[4];
        lds_load_step(r[0], (const float*)lds, c0, rl); lds_load_step(r[1], (const float*)lds + RSB_BLK, c0, rl); lds_load_step(r[2], (const float*)lds + 2 * RSB_BLK, c0, rl);
        for (int c = 0; c < NCH; ++c) {
            const float* bp = (const float*)(lds + (c % SC_NB) * SC_BUF); const float* bpn = (const float*)(lds + ((c + 1) % SC_NB) * SC_BUF);
            float ov = 0.f;
#pragma unroll
            for (int s = 0; s < SCH; ++s) {
                if (s == SCH - 3 && c + 1 < NCH) { while (scw[0] < (unsigned)(c + 2)) __builtin_amdgcn_s_sleep(1); asm volatile("" ::: "memory"); }
                lds_load_step(r[(s + 3) & 3], (s + 3 < SCH) ? bp + (s + 3) * RSB_BLK : bpn + (s + 3 - SCH) * RSB_BLK, c0, rl); __builtin_amdgcn_sched_barrier(0);
                const float o = scan_step_asm(S, r[s & 3]); __builtin_amdgcn_sched_barrier(0);
                ov = (cl == s) ? o : ov;
            }
            op[(size_t)cl * RW] = ov;
            op += (size_t)SCH * RW;
            if (lane == 0) scw[1 + wave] = (unsigned)(c + 1);
        }
        *(float4*)(P.out + OUT_WKV_P + ((size_t)(b * RH + h) * HD + rl) * HD + c0) = S;
    }
}

namespace sba {
typedef short bf16x8 __attribute__((ext_vector_type(8)));
typedef short s16x4 __attribute__((ext_vector_type(4)));
typedef float f32x16 __attribute__((ext_vector_type(16)));
typedef unsigned u32x4 __attribute__((ext_vector_type(4)));
typedef __attribute__((address_space(3))) const unsigned char* lds_cptr;
constexpr int SLOT = 16384;
#define SBA_MFMA(a, b, c) __builtin_amdgcn_mfma_f32_32x32x16_bf16(a, b, c, 0, 0, 0)
__device__ __forceinline__ unsigned cvtpk(float lo, float hi) { return pack2(lo, hi); }
__device__ __forceinline__ bf16x8 pack8(const f32x16& x, int base) {
    u32x4 w; w[0] = cvtpk(x[base], x[base + 1]); w[1] = cvtpk(x[base + 2], x[base + 3]); w[2] = cvtpk(x[base + 4], x[base + 5]); w[3] = cvtpk(x[base + 6], x[base + 7]);
    return __builtin_bit_cast(bf16x8, w);
}
__device__ __forceinline__ int crow(int r, int hi) { return (r & 3) + 8 * (r >> 2) + 4 * hi; }
__device__ __forceinline__ bf16x8 vfrag(lds_cptr p) {
    const s16x4 a = __builtin_bit_cast(s16x4, __builtin_amdgcn_ds_read_tr16_b64_v4i16((__attribute__((address_space(3))) s16x4*)p));
    const s16x4 b = __builtin_bit_cast(s16x4, __builtin_amdgcn_ds_read_tr16_b64_v4i16((__attribute__((address_space(3))) s16x4*)(p + 8 * 64)));
    bf16x8 r; r[0] = a[0]; r[1] = a[1]; r[2] = a[2]; r[3] = a[3]; r[4] = b[0]; r[5] = b[1]; r[6] = b[2]; r[7] = b[3]; return r;
}

template <bool MASK>
__device__ __forceinline__ void tile(lds_cptr kp0, lds_cptr vp0, const bf16x8 (&qr)[4], const f32x16& biasv, const bf16x8& ut0, const bf16x8& ut1, const bf16x8& uon,
                                     f32x16& o0, f32x16& o1, float& R, int kbase, int trel, int hi) {
    f32x16 p0 = biasv, p1 = biasv;
#pragma unroll
    for (int d0 = 0; d0 < 4; ++d0) {
        const bf16x8 ka = *(const __attribute__((address_space(3))) bf16x8*)(kp0 + d0 * 2048);
        const bf16x8 kb = *(const __attribute__((address_space(3))) bf16x8*)(kp0 + d0 * 2048 + 512);
        p0 = SBA_MFMA(ka, qr[d0], p0); p1 = SBA_MFMA(kb, qr[d0], p1);
    }
    f32x16 s0, s1;
#pragma unroll
    for (int r = 0; r < 16; ++r) {
        s0[r] = __builtin_amdgcn_logf(1.f + __builtin_amdgcn_exp2f(p0[r]));
        s1[r] = __builtin_amdgcn_logf(1.f + __builtin_amdgcn_exp2f(p1[r]));
        if (MASK) { const int k0 = kbase + crow(r, hi); if (k0 >= trel) s0[r] = 0.f; if (k0 + 32 >= trel) s1[r] = 0.f; }
    }
    const bf16x8 b00 = pack8(s0, 0), b01 = pack8(s0, 8), b10 = pack8(s1, 0), b11 = pack8(s1, 8);
    f32x16 c0, c1;
#pragma unroll
    for (int r = 0; r < 16; ++r) { c0[r] = p0[r] - R; c1[r] = p1[r] - R; }
    const float top = c0[0];
    c0 = SBA_MFMA(ut0, b00, c0); c0 = SBA_MFMA(ut1, b01, c0); c0 = SBA_MFMA(uon, b10, c0); c0 = SBA_MFMA(uon, b11, c0);
    c1 = SBA_MFMA(ut0, b10, c1); c1 = SBA_MFMA(ut1, b11, c1);
    const float tot_l = top - c0[0];
    const auto sw = __builtin_amdgcn_permlane32_swap(__float_as_uint(tot_l), __float_as_uint(tot_l), false, false);
    const float tot = __uint_as_float(sw[0]);
#pragma unroll
    for (int r = 0; r < 16; ++r) {
        c0[r] = __builtin_amdgcn_exp2f(c0[r]); c1[r] = __builtin_amdgcn_exp2f(c1[r]);
        if (MASK) { const int k0 = kbase + crow(r, hi); if (k0 >= trel) c0[r] = 0.f; if (k0 + 32 >= trel) c1[r] = 0.f; }
    }
    const bf16x8 a00 = pack8(c0, 0), a01 = pack8(c0, 8), a10 = pack8(c1, 0), a11 = pack8(c1, 8);
    o0 = SBA_MFMA(vfrag(vp0 + 0 * 1024), a00, o0); o1 = SBA_MFMA(vfrag(vp0 + 4096 + 0 * 1024), a00, o1);
    o0 = SBA_MFMA(vfrag(vp0 + 1 * 1024), a01, o0); o1 = SBA_MFMA(vfrag(vp0 + 4096 + 1 * 1024), a01, o1);
    o0 = SBA_MFMA(vfrag(vp0 + 2 * 1024), a10, o0); o1 = SBA_MFMA(vfrag(vp0 + 4096 + 2 * 1024), a10, o1);
    o0 = SBA_MFMA(vfrag(vp0 + 3 * 1024), a11, o0); o1 = SBA_MFMA(vfrag(vp0 + 4096 + 3 * 1024), a11, o1);
    R += tot;
}

__device__ __forceinline__ void unit(const Params& P, unsigned char* lds, int b, int h, int qb) {
    const int tid = threadIdx.x, lane = tid & 63, r32 = lane & 31, hi = lane >> 5; const int wid = __builtin_amdgcn_readfirstlane(tid >> 6);
    const bf16_t* Q = (const bf16_t*)(P.ws + WS_QB); const bf16_t* K = (const bf16_t*)(P.ws + WS_KB); const bf16_t* V = (const bf16_t*)(P.ws + WS_VB);
    const bf16_t* gate = (const bf16_t*)(P.ws + WS_GATE); bf16_t* O = (bf16_t*)(P.ws + WS_O);
    const size_t rowbase = (size_t)b * SEQ; const int q0 = qb * 256, NT = (q0 + 256) / 64;
    const int trel = wid * 32 + r32;
    const size_t qrow = rowbase + q0 + trel;
    bf16x8 qr[4];
#pragma unroll
    for (int d0 = 0; d0 < 4; ++d0) qr[d0] = *(const bf16x8*)(Q + qrow * SBW + h * 64 + d0 * 16 + hi * 8);
    const bf16_t* ksrc = K + (rowbase + lane) * SBW + h * 64 + wid * 8;
    const bf16_t* vsrc = V + (rowbase + 16 * (wid & 3) + (lane >> 2)) * SBW + h * 64 + (wid >> 2) * 32 + (lane & 3) * 8;
    LAS unsigned char* l3 = (LAS unsigned char*)lds;
#define SBA_DMA(t, slot) do { __builtin_amdgcn_global_load_lds((const unsigned*)(ksrc + (size_t)(t) * 64 * SBW), (LAS unsigned*)(l3 + (slot) + wid * 1024), 16, 0, 0); \
        __builtin_amdgcn_global_load_lds((const unsigned*)(vsrc + (size_t)(t) * 64 * SBW), (LAS unsigned*)(l3 + (slot) + 8192 + wid * 1024), 16, 0, 0); } while (0)
    const int koff = hi * 1024 + r32 * 16;
    const int voff = 8192 + ((lane >> 4) & 1) * 32 + (lane & 3) * 8 + (4 * hi + ((lane & 15) >> 2)) * 64;
    bf16x8 ut0, ut1, uon;
#pragma unroll
    for (int jj = 0; jj < 8; ++jj) { const int kj = 8 * (jj >> 2) + 4 * hi + (jj & 3);
        ut0[jj] = (kj >= r32) ? (short)0xBF80 : (short)0; ut1[jj] = (16 + kj >= r32) ? (short)0xBF80 : (short)0; uon[jj] = (short)0xBF80; }
    f32x16 biasv; { const float b2 = P.sb_bias[h] * LOG2E;
#pragma unroll
        for (int r = 0; r < 16; ++r) biasv[r] = b2; }
    f32x16 o0, o1;
#pragma unroll
    for (int r = 0; r < 16; ++r) { o0[r] = 0.f; o1[r] = 0.f; }
    float R = 0.f;
    __syncthreads();
    SBA_DMA(NT - 1, ((NT - 1) & 1) * SLOT);
    asm volatile("s_waitcnt vmcnt(0)" ::: "memory");
    __syncthreads();
    for (int t = NT - 1; t >= 0; --t) {
        const int slot = (t & 1) * SLOT;
        if (t > 0) SBA_DMA(t - 1, slot ^ SLOT);
        const int jb = t - (NT - 4);
        const lds_cptr kp0 = (lds_cptr)l3 + slot + koff, vp0 = (lds_cptr)l3 + slot + voff;
        if (jb < 0) tile<false>(kp0, vp0, qr, biasv, ut0, ut1, uon, o0, o1, R, 0, 0, hi);
        else if (64 * jb < wid * 32 + 31) {
            if (64 * jb + 63 >= wid * 32) tile<true>(kp0, vp0, qr, biasv, ut0, ut1, uon, o0, o1, R, 64 * jb, trel, hi);
            else tile<false>(kp0, vp0, qr, biasv, ut0, ut1, uon, o0, o1, R, 0, 0, hi);
        }
        asm volatile("s_waitcnt vmcnt(0)" ::: "memory");
        __syncthreads();
    }
#undef SBA_DMA
    const bf16_t* gr = gate + qrow * DM + 384 + h * 64; bf16_t* orow = O + qrow * DM + 384 + h * 64;
#pragma unroll
    for (int half = 0; half < 2; ++half)
#pragma unroll
        for (int g = 0; g < 4; ++g) { const int d = 32 * half + 8 * g + 4 * hi; const uint2 gt = *(const uint2*)(gr + d);
            const f32x16& o = half ? o1 : o0;
            uint2 w; w.x = cvtpk(o[4 * g] * __uint_as_float(gt.x << 16), o[4 * g + 1] * __uint_as_float(gt.x & 0xffff0000u));
            w.y = cvtpk(o[4 * g + 2] * __uint_as_float(gt.y << 16), o[4 * g + 3] * __uint_as_float(gt.y & 0xffff0000u));
            *(uint2*)(orow + d) = w; }
}
}

__device__ __forceinline__ void p2_xattn_prompt(const Params& P, unsigned char* lds) {
    using namespace sba;
    const int tid = threadIdx.x, lane = tid & 63, r32 = lane & 31, hi = lane >> 5; const int wid = __builtin_amdgcn_readfirstlane(tid >> 6);
    const bf16_t* xq = (const bf16_t*)(P.ws + WS_XQ); const bf16_t* gate = (const bf16_t*)(P.ws + WS_GATE); bf16_t* O = (bf16_t*)(P.ws + WS_O);
    const float* MK = P.out + OUT_MK_P; const float* MV = P.out + OUT_MV_P;
    for (int task = blockIdx.x; task < NB * XH * 16; task += gridDim.x) {
        const int qblk = task & 15, h = (task >> 4) & 3, b = task >> 6;
        __syncthreads();
        for (int it = tid; it < 2048; it += 512) {
            const int key = it & 255, ch = it >> 8;
            const float* s = MK + ((size_t)(b * NMEM + key)) * XW + h * 64 + ch * 8;
            const float4 a = *(const float4*)s, c = *(const float4*)(s + 4);
            *(uint4*)(lds + (key >> 6) * 8192 + ch * 1024 + (key & 63) * 16) = make_uint4(pack2(a.x, a.y), pack2(a.z, a.w), pack2(c.x, c.y), pack2(c.z, c.w));
        }
        for (int it = tid; it < 2048; it += 512) {
            const int pl = it & 3, key = (it >> 2) & 255, ph = it >> 10;
            const float* s = MV + ((size_t)(b * NMEM + key)) * XW + h * 64 + ph * 32 + pl * 8;
            const float4 a = *(const float4*)s, c = *(const float4*)(s + 4);
            *(uint4*)(lds + 32768 + (key >> 6) * 8192 + ph * 4096 + (key & 63) * 64 + pl * 16) = make_uint4(pack2(a.x, a.y), pack2(a.z, a.w), pack2(c.x, c.y), pack2(c.z, c.w));
        }
        __syncthreads();
        const size_t row = (size_t)b * SEQ + qblk * 256 + wid * 32 + r32;
        bf16x8 qr[4];
#pragma unroll
        for (int d0 = 0; d0 < 4; ++d0) qr[d0] = *(const bf16x8*)(xq + row * XW + h * 64 + d0 * 16 + hi * 8);
        f32x16 p[8];
#pragma unroll
        for (int i = 0; i < 8; ++i)
#pragma unroll
            for (int r = 0; r < 16; ++r) p[i][r] = 0.f;
        const lds_cptr kp = (lds_cptr)(LAS unsigned char*)lds + hi * 1024 + r32 * 16;
#pragma unroll
        for (int tl = 0; tl < 4; ++tl)
#pragma unroll
            for (int d0 = 0; d0 < 4; ++d0) {
                const bf16x8 ka = *(const __attribute__((address_space(3))) bf16x8*)(kp + tl * 8192 + d0 * 2048);
                const bf16x8 kb = *(const __attribute__((address_space(3))) bf16x8*)(kp + tl * 8192 + d0 * 2048 + 512);
                p[2 * tl] = SBA_MFMA(ka, qr[d0], p[2 * tl]); p[2 * tl + 1] = SBA_MFMA(kb, qr[d0], p[2 * tl + 1]);
            }
        float m = p[0][0];
#pragma unroll
        for (int i = 0; i < 8; ++i)
#pragma unroll
            for (int r = 0; r < 16; ++r) m = fmaxf(m, p[i][r]);
        { const auto sw = __builtin_amdgcn_permlane32_swap(__float_as_uint(m), __float_as_uint(m), false, false); m = fmaxf(__uint_as_float(sw[0]), __uint_as_float(sw[1])); }
        float l = 0.f;
#pragma unroll
        for (int i = 0; i < 8; ++i)
#pragma unroll
            for (int r = 0; r < 16; ++r) { p[i][r] = __builtin_amdgcn_exp2f(p[i][r] - m); l += p[i][r]; }
        { const auto sw = __builtin_amdgcn_permlane32_swap(__float_as_uint(l), __float_as_uint(l), false, false); l = __uint_as_float(sw[0]) + __uint_as_float(sw[1]); }
        f32x16 o0, o1;
#pragma unroll
        for (int r = 0; r < 16; ++r) { o0[r] = 0.f; o1[r] = 0.f; }
        const lds_cptr vp = (lds_cptr)(LAS unsigned char*)lds + 32768 + ((lane >> 4) & 1) * 32 + (lane & 3) * 8 + (4 * hi + ((lane & 15) >> 2)) * 64;
#pragma unroll
        for (int tl = 0; tl < 4; ++tl)
#pragma unroll
            for (int X = 0; X < 4; ++X) {
                const bf16x8 a = pack8(p[2 * tl + (X >> 1)], (X & 1) * 8);
                o0 = SBA_MFMA(vfrag(vp + tl * 8192 + X * 1024), a, o0); o1 = SBA_MFMA(vfrag(vp + tl * 8192 + 4096 + X * 1024), a, o1);
            }
        const float inv = 1.f / l;
        const bf16_t* gr = gate + row * DM + 768 + h * 64; bf16_t* orow = O + row * DM + 768 + h * 64;
#pragma unroll
        for (int half = 0; half < 2; ++half)
#pragma unroll
            for (int g = 0; g < 4; ++g) { const int d = 32 * half + 8 * g + 4 * hi; const uint2 gt = *(const uint2*)(gr + d);
                const f32x16& o = half ? o1 : o0;
                uint2 w; w.x = pack2(o[4 * g] * inv * __uint_as_float(gt.x << 16), o[4 * g + 1] * inv * __uint_as_float(gt.x & 0xffff0000u));
                w.y = pack2(o[4 * g + 2] * inv * __uint_as_float(gt.y << 16), o[4 * g + 3] * inv * __uint_as_float(gt.y & 0xffff0000u));
                *(uint2*)(orow + d) = w; }
    }
    __syncthreads();
}

__device__ __forceinline__ void p3_scan_and_sb(const Params& P, float* lds) {
    const int tid = threadIdx.x, lane = tid & 63, wave = tid >> 6;
    for (int task = blockIdx.x * 8 + wave; task < DB * RH * 16; task += gridDim.x * 8) {
        const int rg = task & 15, bh = task >> 4, b = bh / RH, h = bh % RH;
        scan_rows(P, NTOK + b, 1, h, rg * 4, P.state_wkv + (size_t)bh * HD * HD, P.out + OUT_WKV_S + (size_t)bh * HD * HD, lane);
    }
    if (blockIdx.x < 96) {
        const int bh = blockIdx.x >> 2, quarter = blockIdx.x & 3, b = bh / RH, h = bh % RH;
        volatile LAS unsigned* scw = (volatile LAS unsigned*)((LAS unsigned char*)lds + SC_CTL_OFF);
        if (tid < 5) scw[tid] = 0u;
        __syncthreads();
        scan_prompt_wave(P, (unsigned char*)lds, b, h, quarter);
        if (wave >= 5 + SC_FREE_WAVES) {
            constexpr unsigned NCHU = SEQ / SCH;
            while (scw[1] < NCHU || scw[2] < NCHU || scw[3] < NCHU || scw[4] < NCHU) __builtin_amdgcn_s_sleep(32);
        }
    } else {
        volatile LAS unsigned* qw = (volatile LAS unsigned*)((LAS unsigned char*)lds + LDS_CTL + 16);
        unsigned* qhead = (unsigned*)(P.ws + WS_BAR) + QW_SB;
        unsigned nxt = 0u;
        if (tid == 0) nxt = atomicAdd(qhead, 1u);
        for (;;) {
            if (tid == 0) qw[0] = nxt;
            __syncthreads();
            const unsigned u = qw[0];
            __syncthreads();
            if (u >= 384u) break;
            if (tid == 0) nxt = atomicAdd(qhead, 1u);
            const int qb = 15 - (int)(u / 24u), bh = (int)(u % 24u);
            sba::unit(P, (unsigned char*)lds, bh / SH, bh % SH, qb);
        }
    }
    sb_decode_wave_loop(P, lds);
    __syncthreads();
}

__device__ __forceinline__ void p4_combine(const Params& P, float* lds) {
    const int tid = threadIdx.x, lane = tid & 63, wave = tid >> 6;
    const float* oraw = (const float*)(P.ws + WS_ORAW); const float* RSB = (const float*)(P.ws + WS_RSB);
    const bf16_t* gate = (const bf16_t*)(P.ws + WS_GATE); bf16_t* O = (bf16_t*)(P.ws + WS_O);
    for (int it = blockIdx.x * 512 + tid; it < NTK * RH * 16; it += gridDim.x * 512) {
        const int c = it & 15, th = it >> 4, h = th % RH, tok = th / RH;
        const size_t o = (size_t)tok * RW + h * 64 + 4 * c;
        const float4 v = *(const float4*)(oraw + o);
        const float mean = sum16(v.x + v.y + v.z + v.w) * (1.f / 64.f);
        const float dx = v.x - mean, dy = v.y - mean, dz = v.z - mean, dw = v.w - mean;
        const float var = sum16(dx * dx + dy * dy + dz * dz + dw * dw) * (1.f / 64.f);
        const float rs = rsqrtf(var + GN_EPS);
        const float4 g = *(const float4*)(P.lnx_g + h * 64 + 4 * c), bb = *(const float4*)(P.lnx_b + h * 64 + 4 * c), vv = *(const float4*)(RSB + ((size_t)tok * RH + h) * RSB_BLK + 320 + 4 * c);
        const float rk = RSB[((size_t)tok * RH + h) * RSB_BLK + 386];
        const uint2 gt = *(const uint2*)(gate + (size_t)tok * DM + h * 64 + 4 * c);
        const float r0 = (dx * rs * g.x + bb.x + rk * vv.x) * __uint_as_float(gt.x << 16), r1 = (dy * rs * g.y + bb.y + rk * vv.y) * __uint_as_float(gt.x & 0xffff0000u);
        const float r2 = (dz * rs * g.z + bb.z + rk * vv.z) * __uint_as_float(gt.y << 16), r3 = (dw * rs * g.w + bb.w + rk * vv.w) * __uint_as_float(gt.y & 0xffff0000u);
        uint2 w; w.x = pack2(r0, r1); w.y = pack2(r2, r3);
        *(uint2*)(O + (size_t)tok * DM + h * 64 + 4 * c) = w;
    }
    const float* dpart = (const float*)(P.ws + WS_DPART); const float* dl = (const float*)(P.ws + WS_DL);
    float* coef = lds + wave * 128;
    for (int task = blockIdx.x * 8 + wave; task < DB * SH; task += gridDim.x * 8) {
        const int b = task / SH, h = task % SH;
        const float L0 = dl[(size_t)(b * NPAGES + 2 * lane) * SH + h], L1 = dl[(size_t)(b * NPAGES + 2 * lane + 1) * SH + h];
        float incl = L0 + L1;
#pragma unroll
        for (int off = 1; off < 64; off <<= 1) { const float t = __shfl_down(incl, off); if (lane + off < 64) incl += t; }
        const float excl = incl - (L0 + L1);
        coef[2 * lane] = exp2f(-(excl + L1)); coef[2 * lane + 1] = exp2f(-excl);
        asm volatile("s_waitcnt lgkmcnt(0)" ::: "memory");
        __builtin_amdgcn_wave_barrier();
        float o = 0.f;
#pragma unroll 16
        for (int j = 0; j < NPAGES; ++j) o += coef[j] * dpart[((size_t)(b * NPAGES + j) * SH + h) * HD + lane];
        const size_t row = NTOK + b;
        O[row * DM + 384 + h * 64 + lane] = f2bf(o * bf2f(gate[row * DM + 384 + h * 64 + lane]));
        __builtin_amdgcn_wave_barrier();
    }
    for (int i = blockIdx.x * 512 + tid; i < (ROWS_P - NTK) * DM / 4; i += gridDim.x * 512) *(uint2*)(O + (size_t)NTK * DM + (size_t)i * 4) = make_uint2(0u, 0u);
}

__device__ __forceinline__ void p5_sample_out(const Params& P) {
    const int tid = threadIdx.x, row = tid >> 4, kq = tid & 15;
    const bf16_t* O = (const bf16_t*)(P.ws + WS_O) + (size_t)(NTOK + row) * DM + kq * 64;
    const bf16_t* Bt2 = (const bf16_t*)(P.ws + WS_BT2);
    float* yun = (float*)(P.ws + WS_YUN);
    for (int cb = blockIdx.x; cb < DM / 4; cb += gridDim.x) {
        float acc[4] = {0.f, 0.f, 0.f, 0.f};
#pragma unroll
        for (int k8 = 0; k8 < 8; ++k8) {
            const uint4 ov = *(const uint4*)(O + k8 * 8); const unsigned oo[4] = {ov.x, ov.y, ov.z, ov.w};
#pragma unroll
            for (int c = 0; c < 4; ++c) { const uint4 wv = *(const uint4*)(Bt2 + (size_t)(cb * 4 + c) * DM + kq * 64 + k8 * 8); const unsigned ww[4] = {wv.x, wv.y, wv.z, wv.w};
#pragma unroll
                for (int j = 0; j < 4; ++j) acc[c] += __uint_as_float(oo[j] << 16) * __uint_as_float(ww[j] << 16) + __uint_as_float(oo[j] & 0xffff0000u) * __uint_as_float(ww[j] & 0xffff0000u); }
        }
#pragma unroll
        for (int c = 0; c < 4; ++c) acc[c] = sum16(acc[c]);
        if (kq == 0) { const size_t o = (size_t)(NTOK + row) * DM + cb * 4; const float4 xv = *(const float4*)(P.x_sample + (size_t)row * DM + cb * 4);
            *(float4*)(yun + o) = make_float4(xv.x + acc[0], xv.y + acc[1], xv.z + acc[2], xv.w + acc[3]); }
    }
}

__device__ __forceinline__ void p6_final_norm(const Params& P) {
    const int tid = threadIdx.x, lane = tid & 63, wave = tid >> 6;
    const float* yun = (const float*)(P.ws + WS_YUN);
    const int gw = blockIdx.x * 8 + wave, nw = gridDim.x * 8;
    for (int r0 = gw; r0 < NTK; r0 += 2 * nw) {
        float4 x[2][4]; float ss[2] = {0.f, 0.f}; bool live[2]; float* dsts[2];
#pragma unroll
        for (int q = 0; q < 2; ++q) { const int r = r0 + q * nw; live[q] = r < NTK; const int rr = live[q] ? r : 0;
            dsts[q] = rr < NTOK ? P.out + OUT_Y_P + (size_t)rr * DM : P.out + OUT_Y_S + (size_t)(rr - NTOK) * DM;
#pragma unroll
            for (int j = 0; j < 4; ++j) x[q][j] = *(const float4*)(yun + (size_t)rr * DM + 4 * lane + 256 * j); }
#pragma unroll
        for (int q = 0; q < 2; ++q) {
#pragma unroll
            for (int j = 0; j < 4; ++j) ss[q] += x[q][j].x * x[q][j].x + x[q][j].y * x[q][j].y + x[q][j].z * x[q][j].z + x[q][j].w * x[q][j].w;
            ss[q] = wave_sum_fast(ss[q]); }
#pragma unroll
        for (int q = 0; q < 2; ++q) { if (!live[q]) continue;
            const float rs = rsqrtf(ss[q] * (1.f / DM) + NORM_EPS);
#pragma unroll
            for (int j = 0; j < 4; ++j) { const float4 gg = *(const float4*)(P.final_norm_g + 4 * lane + 256 * j);
                *(float4*)(dsts[q] + 4 * lane + 256 * j) = make_float4(x[q][j].x * rs * gg.x, x[q][j].y * rs * gg.y, x[q][j].z * rs * gg.z, x[q][j].w * rs * gg.w); } }
    }
}

constexpr int NPHASE = 7;
__global__ void __launch_bounds__(512, 2) mk_fwd(Params P) {
    extern __shared__ __attribute__((aligned(16))) unsigned char lds[];
    volatile LAS unsigned* xbw = (volatile LAS unsigned*)((LAS unsigned char*)lds + LDS_CTL);
    if (threadIdx.x < 4) xbw[threadIdx.x] = 0u;
    __syncthreads();
    XcdBarrier bar; bar.bar = (unsigned*)(P.ws + WS_BAR); bar.x = 0; bar.st = xbw;
#if MK_N_LAUNCHES == 1
    bar = xcd_barrier_post((unsigned*)(P.ws + WS_BAR), xbw);
#endif
    const int lo = P.ph_lo, hi = P.ph_hi;
#define IN(k) (lo <= (k) && (k) < hi)
#define SEAM(k) do { if (IN(k) && IN((k) + 1)) xcd_barrier(bar); } while (0)
    float* ldsf = (float*)lds;
    if (IN(0)) { for (int rep = 0; rep < NREP(0); ++rep) p0_prologue(P, ldsf); }
    SEAM(0);
    if (IN(1)) {
        pg8::Gemm g{(const bf16_t*)(P.ws + WS_A1), (const bf16_t*)(P.ws + WS_BT1), MROWS1, NB1, DM};
        pg8::GridOrder S; S.init(65, 15, 8, 65, 15, 2, (int)gridDim.x, (int)((blockIdx.x % 8) * (gridDim.x / 8) + blockIdx.x / 8));
        EpiG1 E{(bf16_t*)(P.ws + WS_PRW), (bf16_t*)(P.ws + WS_QB), (bf16_t*)(P.ws + WS_KB), (bf16_t*)(P.ws + WS_VB), (bf16_t*)(P.ws + WS_XQ), (bf16_t*)(P.ws + WS_GATE), P.out};
        for (int rep = 0; rep < NREP(1); ++rep) pg8::gemm_phase<EpiG1, pg8::GridOrder>((PG8_LAS unsigned char*)lds, g, S, E);
    }
    SEAM(1);
    if (IN(2)) {
        for (int rep = 0; rep < NREP(20); ++rep) p2_rwkv_prep(P, ldsf);
        for (int rep = 0; rep < NREP(21); ++rep) p2_xattn_prompt(P, lds);
        for (int rep = 0; rep < NREP(22); ++rep) p2_xattn_sample(P, ldsf);
    }
    SEAM(2);
    if (IN(3)) { p3_scan_and_sb(P, ldsf); }
    SEAM(3);
    if (IN(4)) { for (int rep = 0; rep < NREP(4); ++rep) p4_combine(P, ldsf); }
    SEAM(4);
    if (IN(5)) {
        pg8::Gemm g{(const bf16_t*)(P.ws + WS_O), (const bf16_t*)(P.ws + WS_BT2), NTOK, DM, DM};
        pg8::GridOrder S; S.init(64, 4, 0, 0, 0, 1, (int)gridDim.x, (int)((blockIdx.x % 8) * (gridDim.x / 8) + blockIdx.x / 8));
        EpiG2 E{P.x_prompt, P.x_sample, (float*)(P.ws + WS_YUN)};
        for (int rep = 0; rep < NREP(5); ++rep) pg8::gemm_phase<EpiG2, pg8::GridOrder>((PG8_LAS unsigned char*)lds, g, S, E);
        p5_sample_out(P);
    }
    SEAM(5);
    if (IN(6)) { for (int rep = 0; rep < NREP(6); ++rep) p6_final_norm(P); }
#undef IN
#undef SEAM
}

extern "C" void kernel_launch(void* const* d_in, const int* in_sizes, int n_in, void* d_out, int out_size, void* d_ws, size_t ws_size, hipStream_t stream) {
    static int grid = 0;
    if (grid == 0) {
        if (n_in != 28 || (size_t)out_size != OUT_END || ws_size < WS_END) { fprintf(stderr, "kernel_launch: unexpected shapes: n_in %d out %d (want %zu) ws %zu (want %zu)\n", n_in, out_size, (size_t)OUT_END, ws_size, (size_t)WS_END); grid = -1; return; }
        int dev = 0, cus = 0, per_cu = 0;
        if (hipGetDevice(&dev) != hipSuccess || hipDeviceGetAttribute(&cus, hipDeviceAttributeMultiprocessorCount, dev) != hipSuccess) { grid = -1; return; }
        if (hipFuncSetAttribute((const void*)mk_fwd, hipFuncAttributeMaxDynamicSharedMemorySize, LDS_BYTES) != hipSuccess) { fprintf(stderr, "kernel_launch: hipFuncSetAttribute failed\n"); grid = -1; return; }
        if (hipOccupancyMaxActiveBlocksPerMultiprocessor(&per_cu, (const void*)mk_fwd, 512, LDS_BYTES) != hipSuccess || per_cu < 1) fprintf(stderr, "kernel_launch: occupancy query says %d\n", per_cu);
        (void)hipGetLastError();
        grid = cus;
        if (grid % 8 != 0) grid -= grid % 8;
    }
    if (grid < 0) return;
    (void)hipMemsetAsync((char*)d_ws + WS_BAR, 0, 16384, stream);
    Params P{};
    P.x_prompt = (const float*)d_in[0]; P.mem_prompt = (const float*)d_in[1]; P.x_sample = (const float*)d_in[2]; P.cache_k = (const float*)d_in[3]; P.cache_v = (const float*)d_in[4];
    P.page_table = (const int*)d_in[5]; P.state_wkv = (const float*)d_in[6]; P.state_shift = (const float*)d_in[7]; P.cmem_k = (const float*)d_in[8]; P.cmem_v = (const float*)d_in[9];
    P.norm_g = (const float*)d_in[10]; P.w_in = (const float*)d_in[11]; P.sb_bias = (const float*)d_in[12]; P.mu_shift = (const float*)d_in[13]; P.w0 = (const float*)d_in[14];
    P.w_lora_b = (const float*)d_in[15]; P.a0 = (const float*)d_in[16]; P.a_lora_b = (const float*)d_in[17]; P.k_k = (const float*)d_in[18]; P.k_a = (const float*)d_in[19]; P.r_k = (const float*)d_in[20];
    P.lnx_g = (const float*)d_in[21]; P.lnx_b = (const float*)d_in[22]; P.mem_norm_g = (const float*)d_in[23]; P.w_mem_k = (const float*)d_in[24]; P.w_mem_v = (const float*)d_in[25];
    P.w_out = (const float*)d_in[26]; P.final_norm_g = (const float*)d_in[27];
    P.out = (float*)d_out; P.ws = (unsigned char*)d_ws;
#if MK_N_LAUNCHES == 1
    P.ph_lo = 0; P.ph_hi = NPHASE;
    hipLaunchKernelGGL(mk_fwd, dim3(grid), dim3(512), LDS_BYTES, stream, P);
#else
    for (int ph = 0; ph < NPHASE; ++ph) { P.ph_lo = ph; P.ph_hi = ph + 1; hipLaunchKernelGGL(mk_fwd, dim3(grid), dim3(512), LDS_BYTES, stream, P); }
#endif
    const hipError_t le = hipPeekAtLastError();
    if (le != hipSuccess) fprintf(stderr, "kernel_launch: launch failed: %s\n", hipGetErrorName(le));
}
```

```cpp
#include <hip/hip_runtime.h>
#include <cstdio>
#include <cstdint>

#ifndef MK_REP
#define MK_REP -1
#endif
#define NREP(id) ((MK_REP) == (id) ? 2 : 1)
#ifndef MK_N_LAUNCHES
#define MK_N_LAUNCHES 1
#endif

constexpr int DM = 1024, NB = 4, SEQ = 4096, NTOK = NB * SEQ, DB = 32, NPAGES = 128, PAGE = 128;
constexpr int HD = 64, RH = 6, SH = 6, XH = 4, NMEM = 256;
constexpr int RW = 384, SBW = 384, XW = 256, RCOLS = 1280, DIN = 3712;
constexpr int NTK = NTOK + DB;
constexpr int ROWS_P = 16640;
constexpr int MEMROW0 = 16640;
constexpr int MROWS1 = 17664;
constexpr int NB1 = 4352;
constexpr float LOG2E = 1.4426950408889634f, QSCALE = 0.125f * 1.4426950408889634f;
constexpr float NORM_EPS = 1e-6f, GN_EPS = 64e-5f, DECAY_SCALE = 0.60653065971263342f;

constexpr size_t OUT_Y_P = 0;
constexpr size_t OUT_Y_S = OUT_Y_P + (size_t)NTOK * DM;
constexpr size_t OUT_SBK_P = OUT_Y_S + (size_t)DB * DM;
constexpr size_t OUT_SBV_P = OUT_SBK_P + (size_t)NTOK * SBW;
constexpr size_t OUT_WKV_P = OUT_SBV_P + (size_t)NTOK * SBW;
constexpr size_t OUT_SHIFT_P = OUT_WKV_P + (size_t)NB * RH * HD * HD;
constexpr size_t OUT_MK_P = OUT_SHIFT_P + (size_t)NB * RCOLS;
constexpr size_t OUT_MV_P = OUT_MK_P + (size_t)NB * NMEM * XW;
constexpr size_t OUT_SBK_S = OUT_MV_P + (size_t)NB * NMEM * XW;
constexpr size_t OUT_SBV_S = OUT_SBK_S + (size_t)DB * SBW;
constexpr size_t OUT_WKV_S = OUT_SBV_S + (size_t)DB * SBW;
constexpr size_t OUT_SHIFT_S = OUT_WKV_S + (size_t)DB * RH * HD * HD;
constexpr size_t OUT_END = OUT_SHIFT_S + (size_t)DB * RCOLS;

constexpr size_t al256(size_t x) { return (x + 255) & ~(size_t)255; }
constexpr size_t WS_BAR = 0;
constexpr size_t WS_A1 = 16384;
constexpr size_t WS_BT1 = WS_A1 + al256((size_t)MROWS1 * DM * 2);
constexpr size_t WS_BT2 = WS_BT1 + al256((size_t)NB1 * DM * 2);
constexpr size_t WS_PRW = WS_BT2 + al256((size_t)DM * DM * 2);
constexpr size_t WS_QB = WS_PRW + al256((size_t)ROWS_P * RCOLS * 2);
constexpr size_t WS_KB = WS_QB + al256((size_t)ROWS_P * SBW * 2);
constexpr size_t WS_VB = WS_KB + al256((size_t)ROWS_P * SBW * 2);
constexpr size_t WS_XQ = WS_VB + al256((size_t)ROWS_P * SBW * 2);
constexpr size_t WS_GATE = WS_XQ + al256((size_t)ROWS_P * XW * 2);
constexpr int RSB_BLK = 388;
constexpr size_t WS_RSB = WS_GATE + al256((size_t)ROWS_P * DM * 2);
constexpr size_t WS_ORAW = WS_RSB + al256((size_t)NTK * RH * RSB_BLK * 4);
constexpr size_t WS_O = WS_ORAW + al256((size_t)NTK * RW * 4);
constexpr size_t WS_YUN = WS_O + al256((size_t)ROWS_P * DM * 2);
constexpr size_t WS_DPART = WS_YUN + al256((size_t)ROWS_P * DM * 4);
constexpr size_t WS_DL = WS_DPART + al256((size_t)DB * NPAGES * SH * HD * 4);
constexpr size_t WS_LFRAG = WS_DL + al256((size_t)DB * NPAGES * SH * 4);
constexpr size_t WS_END = WS_LFRAG + al256((size_t)2 * 2 * 6 * 4 * 2 * 64 * 16);

constexpr int LDS_STAGE = 131072;
constexpr int LDS_CTL = 155648;
constexpr int LDS_BYTES = LDS_CTL + 1024;

typedef unsigned short bf16_t;

#define XB_TMO      128
#define XB_XCNT(j)  (256  + 64 * (j))
#define XB_XSUB(j)  (1280 + 64 * (j))
#define XB_XGEN(j)  (2304 + 64 * (j))
#define XB_TOP      3328
#define XB_TOPGEN   3392
#define XCD_BAR_WORDS 3456
#define XB_SPIN_CAP (1u << 18)
#define LAS __attribute__((address_space(3)))

__device__ __forceinline__ unsigned xb_ld(unsigned* p)              { return __hip_atomic_load(p, __ATOMIC_RELAXED, __HIP_MEMORY_SCOPE_AGENT); }
__device__ __forceinline__ unsigned xb_add(unsigned* p, unsigned v) { return __hip_atomic_fetch_add(p, v, __ATOMIC_RELAXED, __HIP_MEMORY_SCOPE_AGENT); }
__device__ __forceinline__ unsigned xb_xcc_id() { return (unsigned)__builtin_amdgcn_s_getreg((3 << 11) | 20) & 0xFu; }
#define XB_SPIN(cond, bar) do { unsigned _sp = 0; while (cond) { __builtin_amdgcn_s_sleep(1); \
    if ((++_sp & 255u) == 0u) { if (xb_ld(&(bar)[XB_TMO])) break; if (_sp > XB_SPIN_CAP) { atomicAdd(&(bar)[XB_TMO], 1u); break; } } } } while (0)

struct XcdBarrier {
    unsigned* bar; unsigned x;
    volatile LAS unsigned* st;
};
__device__ __forceinline__ XcdBarrier xcd_barrier_post(unsigned* bar, volatile LAS unsigned* st) {
    XcdBarrier b; b.bar = bar; b.x = xb_xcc_id(); b.st = st;
    if (threadIdx.x == 0) (void)xb_add(&bar[XB_XCNT(b.x)], 1u);
    return b;
}
__device__ __forceinline__ void xcd_barrier_complete(unsigned* bar, unsigned x, unsigned& nloc, unsigned& nx) {
    const unsigned G = gridDim.x * gridDim.y * gridDim.z;
    unsigned sum, cnt, mine, sp = 0u;
    for (;;) {
        sum = 0u; cnt = 0u; mine = 0u;
#pragma unroll
        for (unsigned j = 0; j < 16; ++j) { const unsigned c = xb_ld(&bar[XB_XCNT(j)]); sum += c; cnt += (c > 0u) ? 1u : 0u; mine = (j == x) ? c : mine; }
        if (sum == G) break;
        __builtin_amdgcn_s_sleep(1);
        if ((++sp & 255u) == 0u) { if (xb_ld(&bar[XB_TMO])) break; if (sp > XB_SPIN_CAP) { atomicAdd(&bar[XB_TMO], 1u); break; } }
    }
    nloc = mine > 0u ? mine : 1u; nx = cnt > 0u ? cnt : 1u;
}
__device__ __forceinline__ void xcd_barrier(const XcdBarrier& b) {
    asm volatile("s_waitcnt vmcnt(0)" ::: "memory");
    __syncthreads();
    if (threadIdx.x == 0) {
        unsigned* bar = b.bar;
        __builtin_amdgcn_s_waitcnt(0);
        unsigned nloc = b.st[0], nx = b.st[1];
        if (nloc == 0u) { xcd_barrier_complete(bar, b.x, nloc, nx); b.st[0] = nloc; b.st[1] = nx; }
        const unsigned old = xb_add(&bar[XB_XSUB(b.x)], 1u);
        const unsigned gen = old / nloc;
        if (old + 1u == (gen + 1u) * nloc) {
            __builtin_amdgcn_fence(__ATOMIC_RELEASE, "agent");
            asm volatile("s_waitcnt vmcnt(0)" ::: "memory");
            const unsigned og = xb_add(&bar[XB_TOP], 1u);
            const unsigned tg = og / nx;
            if (og + 1u == (tg + 1u) * nx) xb_add(&bar[XB_TOPGEN], 1u);
            else XB_SPIN(xb_ld(&bar[XB_TOPGEN]) == tg, bar);
            __builtin_amdgcn_fence(__ATOMIC_ACQUIRE, "agent");
            xb_add(&bar[XB_XGEN(b.x)], 1u);
            asm volatile("s_waitcnt vmcnt(0)" ::: "memory");
        } else {
            XB_SPIN(xb_ld(&bar[XB_XGEN(b.x)]) == gen, bar);
            __builtin_amdgcn_fence(__ATOMIC_ACQUIRE, "agent");
            asm volatile("s_waitcnt vmcnt(0)" ::: "memory");
        }
    }
    __syncthreads();
}

namespace pg8 {
#define PG8_LAS __attribute__((address_space(3)))
typedef short bf16x8 __attribute__((ext_vector_type(8)));
typedef float f32x4 __attribute__((ext_vector_type(4)));
typedef unsigned u32x4 __attribute__((ext_vector_type(4)));
constexpr int BM = 256, BK = 64, HALF = 128, HTB = HALF * BK * 2, STAGE_BYTES = 8 * HTB, NXCD = 8, WGM = 8;

__host__ __device__ __forceinline__ int lds_byte(int r, int c) { const int st = (r >> 4) * 2 + (c >> 5), rr = r & 15, cc = c & 31, ob = rr * 64 + cc * 2; return st * 1024 + (ob ^ (((ob >> 9) & 1) << 5)); }
__host__ __device__ __forceinline__ void stage_rc(int b, int& R, int& C) { const int st = b / 1024, sb = b % 1024, swz = sb ^ (((sb >> 9) & 1) << 5); R = (st >> 1) * 16 + swz / 64; C = (st & 1) * 32 + (swz % 64) / 2; }
__host__ __device__ __forceinline__ int perm32(int rho) { const int n = rho >> 4, i = rho & 15; return 8 * (i >> 2) + 4 * n + (i & 3); }

struct Unit { int pm, pn; };
struct Gemm { const bf16_t* A; const bf16_t* Bt; int M, N, K; };

struct GridOrder {
    int nM, nN, nmain, nextra, xm0, xn0, xnn, G, c;
    __device__ void init(int nM_, int nN_, int nextra_, int xm0_, int xn0_, int xnn_, int G_, int c_) { nM = nM_; nN = nN_; nmain = nM_ * nN_; nextra = nextra_; xm0 = xm0_; xn0 = xn0_; xnn = xnn_; G = G_; c = c_; }
    __device__ bool next(int i, Unit& u) const {
        const int L = i * G + c; if (L >= nmain + nextra) return false;
        if (L >= nmain) { const int e = L - nmain; u.pm = xm0 + e / xnn; u.pn = xn0 + e % xnn; return true; }
        const int wgid = L;
        const int nig = WGM * nN, gid = wgid / nig, fm = gid * WGM, gsz = (nM - fm) < WGM ? (nM - fm) : WGM;
        u.pm = fm + ((wgid % nig) % gsz); u.pn = (wgid % nig) / gsz; return true;
    }
    __device__ __forceinline__ void a_ready(const Unit&) const {}
    __device__ __forceinline__ void done(const Unit&) const {}
};

template <class Epi, class Sched>
__device__ __forceinline__ void gemm_phase(PG8_LAS unsigned char* lds, const Gemm g, const Sched& S, const Epi& E) {
    const int tid = threadIdx.x, wid = __builtin_amdgcn_readfirstlane(tid >> 6), lane = tid & 63, wr = wid >> 2, wc = wid & 3, fr = lane & 15, fq = lane >> 4;
    const int K = g.K, nt = K / BK;
    unsigned voffA[2], voffB[2];
#pragma unroll
    for (int i = 0; i < 2; ++i) { int R, C; stage_rc(tid * 16 + i * 8192, R, C); const int Rb = Epi::PERM ? ((R & ~31) + perm32(R & 31)) : R;
        voffA[i] = (unsigned)(R * K + C) * 2u; voffB[i] = (unsigned)(Rb * K + C) * 2u; }
    const size_t kstep = (size_t)(BK * 2);
    const size_t hstep = (size_t)HALF * K * 2;
    const size_t tstep = 2 * hstep;
    const unsigned ldsw = (unsigned)wid * 1024u;
    const int aoff = lds_byte(wr * 64 + fr, fq * 8), boff = lds_byte(wc * 32 + fr, fq * 8);
#define PG8_SA(b, h) (((b) * 2 + (h)) * HTB)
#define PG8_SB(b, h) ((4 + (b) * 2 + (h)) * HTB)
#define PG8_STAGE(bufoff, gbase, voff) do { _Pragma("unroll") for (int _i = 0; _i < 2; ++_i) \
        __builtin_amdgcn_global_load_lds((const unsigned*)((const char*)(gbase) + (voff)[_i]), (PG8_LAS unsigned*)(lds + (bufoff) + ldsw + _i * 8192), 16, 0, 0); } while (0)
#define PG8_LDA(dst, b, h) do { _Pragma("unroll") for (int m = 0; m < 4; ++m) _Pragma("unroll") for (int k = 0; k < 2; ++k) dst[m][k] = *(const PG8_LAS bf16x8*)(lds + PG8_SA(b, h) + aoff + m * 2048 + k * 1024); } while (0)
#define PG8_LDB(dst, b, h) do { _Pragma("unroll") for (int n = 0; n < 2; ++n) _Pragma("unroll") for (int k = 0; k < 2; ++k) dst[n][k] = *(const PG8_LAS bf16x8*)(lds + PG8_SB(b, h) + boff + n * 2048 + k * 1024); } while (0)
#define PG8_MMA(ai, bj, At, Bt) do { __builtin_amdgcn_s_setprio(1); _Pragma("unroll") for (int m = 0; m < 4; ++m) _Pragma("unroll") for (int n = 0; n < 2; ++n) _Pragma("unroll") for (int k = 0; k < 2; ++k) \
        acc[ai][bj][m][n] = __builtin_amdgcn_mfma_f32_16x16x32_bf16(Bt[n][k], At[m][k], acc[ai][bj][m][n], 0, 0, 0); __builtin_amdgcn_s_setprio(0); } while (0)
#define PG8_WAIT_V(n) asm volatile("s_waitcnt vmcnt(" #n ")" ::: "memory")
#define PG8_WAIT_L(n) asm volatile("s_waitcnt lgkmcnt(" #n ")" ::: "memory")
#define PG8_BAR __builtin_amdgcn_s_barrier()
#define PG8_SCHED __builtin_amdgcn_sched_barrier(0)
    Unit cur, nxt; int ui = 0;
    if (!S.next(0, cur)) return;
    f32x4 acc[2][2][4][2];
#pragma unroll
    for (int a = 0; a < 2; ++a)
#pragma unroll
        for (int b = 0; b < 2; ++b)
#pragma unroll
            for (int m = 0; m < 4; ++m)
#pragma unroll
                for (int n = 0; n < 2; ++n) acc[a][b][m][n] = (f32x4){0.f, 0.f, 0.f, 0.f};
    bf16x8 At[4][2], B0[2][2], B1[2][2];
    const char* cA = (const char*)g.A + (size_t)cur.pm * tstep; const char* cB = (const char*)g.Bt + (size_t)cur.pn * tstep;
    S.a_ready(cur);
    PG8_STAGE(PG8_SB(0, 0), cB, voffB); PG8_STAGE(PG8_SA(0, 0), cA, voffA); PG8_STAGE(PG8_SB(0, 1), cB + hstep, voffB); PG8_STAGE(PG8_SA(0, 1), cA + hstep, voffA);
    if (wr == 1) PG8_BAR;
    PG8_WAIT_V(4); PG8_BAR;
    PG8_STAGE(PG8_SB(1, 0), cB + kstep, voffB); PG8_STAGE(PG8_SA(1, 0), cA + kstep, voffA); PG8_STAGE(PG8_SB(1, 1), cB + hstep + kstep, voffB);
    PG8_WAIT_V(6); PG8_BAR;
    for (;;) {
        const bool has_next = S.next(ui + 1, nxt);
        const char* nA = has_next ? (const char*)g.A + (size_t)nxt.pm * tstep : cA; const char* nB = has_next ? (const char*)g.Bt + (size_t)nxt.pn * tstep : cB;
        for (int t = 0; t < nt; t += 2) {
            const bool last = (t == nt - 2);
            const char* a1 = cA + (size_t)(t + 1) * kstep;
            const char* a2 = last ? nA : cA + (size_t)(t + 2) * kstep; const char* b2 = last ? nB : cB + (size_t)(t + 2) * kstep;
            const char* a3 = a2 + kstep; const char* b3 = b2 + kstep;
            if (last && has_next) S.a_ready(nxt);
            PG8_LDB(B0, 0, 0); PG8_SCHED; PG8_LDA(At, 0, 0); PG8_STAGE(PG8_SA(1, 1), a1 + hstep, voffA);
            PG8_WAIT_L(8); PG8_BAR; PG8_WAIT_L(0); PG8_MMA(0, 0, At, B0); PG8_BAR; PG8_SCHED;
            PG8_LDB(B1, 0, 1); PG8_STAGE(PG8_SB(0, 0), b2, voffB);
            PG8_BAR; PG8_WAIT_L(0); PG8_MMA(0, 1, At, B1); PG8_BAR;
            PG8_LDA(At, 0, 1); PG8_STAGE(PG8_SA(0, 0), a2, voffA);
            PG8_BAR; PG8_WAIT_L(0); PG8_MMA(1, 0, At, B0); PG8_BAR; PG8_SCHED;
            PG8_STAGE(PG8_SB(0, 1), b2 + hstep, voffB);
            PG8_WAIT_V(6); PG8_BAR; PG8_MMA(1, 1, At, B1); PG8_BAR;
            PG8_LDB(B0, 1, 0); PG8_SCHED; PG8_LDA(At, 1, 0); PG8_STAGE(PG8_SA(0, 1), a2 + hstep, voffA);
            PG8_WAIT_L(8); PG8_BAR; PG8_WAIT_L(0); PG8_MMA(0, 0, At, B0); PG8_BAR; PG8_SCHED;
            PG8_LDB(B1, 1, 1); PG8_STAGE(PG8_SB(1, 0), b3, voffB);
            PG8_BAR; PG8_WAIT_L(0); PG8_MMA(0, 1, At, B1); PG8_BAR;
            PG8_LDA(At, 1, 1); PG8_STAGE(PG8_SA(1, 0), a3, voffA);
            PG8_BAR; PG8_WAIT_L(0); PG8_MMA(1, 0, At, B0); PG8_BAR; PG8_SCHED;
            PG8_STAGE(PG8_SB(1, 1), b3 + hstep, voffB);
            PG8_WAIT_V(6); PG8_BAR; PG8_MMA(1, 1, At, B1); PG8_BAR;
        }
        E(acc, cur, wr, wc, fr, fq); S.done(cur);
        if (!has_next) break;
#pragma unroll
        for (int a = 0; a < 2; ++a)
#pragma unroll
            for (int b = 0; b < 2; ++b)
#pragma unroll
                for (int m = 0; m < 4; ++m)
#pragma unroll
                    for (int n = 0; n < 2; ++n) acc[a][b][m][n] = (f32x4){0.f, 0.f, 0.f, 0.f};
        cur = nxt; cA = nA; cB = nB; ++ui;
    }
    PG8_WAIT_V(0);
    if (wr == 0) PG8_BAR;
    PG8_BAR;
#undef PG8_SA
#undef PG8_SB
#undef PG8_STAGE
#undef PG8_LDA
#undef PG8_LDB
#undef PG8_MMA
#undef PG8_WAIT_V
#undef PG8_WAIT_L
#undef PG8_BAR
#undef PG8_SCHED
}
}

typedef float f32x4 __attribute__((ext_vector_type(4)));
__device__ __forceinline__ float bf2f(bf16_t b) { return __uint_as_float(((unsigned)b) << 16); }
__device__ __forceinline__ bf16_t f2bf(float f) { unsigned u = __float_as_uint(f); u += 0x7FFFu + ((u >> 16) & 1u); return (bf16_t)(u >> 16); }
typedef __bf16 bf16x2_t __attribute__((ext_vector_type(2)));
typedef float f32x2_t __attribute__((ext_vector_type(2)));
__device__ __forceinline__ unsigned pack2(float lo, float hi) { const f32x2_t v = {lo, hi}; return __builtin_bit_cast(unsigned, __builtin_convertvector(v, bf16x2_t)); }
__device__ __forceinline__ float wave_sum(float v) {
#pragma unroll
    for (int o = 32; o >= 1; o >>= 1) v += __shfl_xor(v, o);
    return v;
}
__device__ __forceinline__ float wave_max(float v) {
#pragma unroll
    for (int o = 32; o >= 1; o >>= 1) v = fmaxf(v, __shfl_xor(v, o));
    return v;
}
template <int CTRL> __device__ __forceinline__ float dpp_f(float x) { return __builtin_bit_cast(float, __builtin_amdgcn_update_dpp(0, __builtin_bit_cast(int, x), CTRL, 0xF, 0xF, true)); }
__device__ __forceinline__ float sum16(float v) {
    v += dpp_f<0xB1>(v);
    v += dpp_f<0x4E>(v);
    v += dpp_f<0x124>(v);
    v += dpp_f<0x128>(v);
    return v;
}
__device__ __forceinline__ float wave_sum_fast(float v) {
    v = sum16(v);
    { const auto s = __builtin_amdgcn_permlane16_swap(__float_as_uint(v), __float_as_uint(v), false, false); v = __uint_as_float(s[0]) + __uint_as_float(s[1]); }
    { const auto s = __builtin_amdgcn_permlane32_swap(__float_as_uint(v), __float_as_uint(v), false, false); v = __uint_as_float(s[0]) + __uint_as_float(s[1]); }
    return v;
}
__device__ __forceinline__ float sigmoidf_(float x) { return 1.f / (1.f + __expf(-x)); }
__device__ __forceinline__ float softplusf_(float z) { return fmaxf(z, 0.f) + log1pf(__expf(-fabsf(z))); }
__device__ __forceinline__ float softplus2_(float z2) { return fmaxf(z2, 0.f) + log1pf(exp2f(-fabsf(z2))) * LOG2E; }

struct Params {
    const float *x_prompt, *mem_prompt, *x_sample, *cache_k, *cache_v; const int* page_table;
    const float *state_wkv, *state_shift, *cmem_k, *cmem_v, *norm_g, *w_in, *sb_bias, *mu_shift, *w0, *w_lora_b, *a0, *a_lora_b, *k_k, *k_a, *r_k,
        *lnx_g, *lnx_b, *mem_norm_g, *w_mem_k, *w_mem_v, *w_out, *final_norm_g;
    float* out; unsigned char* ws;
    int ph_lo, ph_hi;
};

struct EpiG1 {
    static constexpr bool PERM = true;
    bf16_t* prw; bf16_t *qb, *kb, *vb, *xq, *gate; float* out;
    __device__ __forceinline__ void operator()(const pg8::f32x4 (&acc)[2][2][4][2], const pg8::Unit& u, int wr, int wc, int fr, int fq) const {
        if (u.pm >= 65) {
            float* dst = out + (u.pn == 15 ? OUT_MK_P : OUT_MV_P);
#pragma unroll
            for (int ai = 0; ai < 2; ++ai)
#pragma unroll
                for (int m = 0; m < 4; ++m) { const int row = (u.pm - 65) * 256 + ai * 128 + wr * 64 + m * 16 + fr;
#pragma unroll
                    for (int bj = 0; bj < 2; ++bj) { const int col = bj * 128 + wc * 32 + 8 * fq;
                        *(pg8::f32x4*)(dst + (size_t)row * 256 + col) = acc[ai][bj][m][0]; *(pg8::f32x4*)(dst + (size_t)row * 256 + col + 4) = acc[ai][bj][m][1]; } }
            return;
        }
#pragma unroll
        for (int bj = 0; bj < 2; ++bj) {
            const int cb = u.pn * 256 + bj * 128;
            if (cb >= DIN) continue;
#pragma unroll
            for (int ai = 0; ai < 2; ++ai)
#pragma unroll
                for (int m = 0; m < 4; ++m) { const int row = u.pm * 256 + ai * 128 + wr * 64 + m * 16 + fr;
                    if (row >= NTK) continue;
                    const int col = cb + wc * 32 + 8 * fq; const pg8::f32x4 v0 = acc[ai][bj][m][0], v1 = acc[ai][bj][m][1];
                    if (cb < 1280) {
                        *(uint4*)(prw + (size_t)row * RCOLS + col) = make_uint4(pack2(v0[0], v0[1]), pack2(v0[2], v0[3]), pack2(v1[0], v1[1]), pack2(v1[2], v1[3]));
                        if (row >= NTOK) { float* e = out + OUT_SHIFT_S + (size_t)(row - NTOK) * RCOLS + col; *(pg8::f32x4*)e = v0; *(pg8::f32x4*)(e + 4) = v1; }
                        else if ((row & (SEQ - 1)) == SEQ - 1) { float* e = out + OUT_SHIFT_P + (size_t)(row >> 12) * RCOLS + col; *(pg8::f32x4*)e = v0; *(pg8::f32x4*)(e + 4) = v1; }
                    } else if (cb < 1664) {
                        *(uint4*)(qb + (size_t)row * SBW + (col - 1280)) = make_uint4(pack2(v0[0] * QSCALE, v0[1] * QSCALE), pack2(v0[2] * QSCALE, v0[3] * QSCALE), pack2(v1[0] * QSCALE, v1[1] * QSCALE), pack2(v1[2] * QSCALE, v1[3] * QSCALE));
                    } else if (cb < 2048) {
                        const int c2 = col - 1664;
                        *(uint4*)(kb + (size_t)row * SBW + c2) = make_uint4(pack2(v0[0], v0[1]), pack2(v0[2], v0[3]), pack2(v1[0], v1[1]), pack2(v1[2], v1[3]));
                        float* e = row < NTOK ? out + OUT_SBK_P + (size_t)row * SBW + c2 : out + OUT_SBK_S + (size_t)(row - NTOK) * SBW + c2; *(pg8::f32x4*)e = v0; *(pg8::f32x4*)(e + 4) = v1;
                    } else if (cb < 2432) {
                        const int c2 = col - 2048;
                        *(uint4*)(vb + (size_t)row * SBW + c2) = make_uint4(pack2(v0[0], v0[1]), pack2(v0[2], v0[3]), pack2(v1[0], v1[1]), pack2(v1[2], v1[3]));
                        float* e = row < NTOK ? out + OUT_SBV_P + (size_t)row * SBW + c2 : out + OUT_SBV_S + (size_t)(row - NTOK) * SBW + c2; *(pg8::f32x4*)e = v0; *(pg8::f32x4*)(e + 4) = v1;
                    } else if (cb < 2688) {
                        *(uint4*)(xq + (size_t)row * XW + (col - 2432)) = make_uint4(pack2(v0[0] * QSCALE, v0[1] * QSCALE), pack2(v0[2] * QSCALE, v0[3] * QSCALE), pack2(v1[0] * QSCALE, v1[1] * QSCALE), pack2(v1[2] * QSCALE, v1[3] * QSCALE));
                    } else {
                        *(uint4*)(gate + (size_t)row * DM + (col - 2688)) = make_uint4(pack2(v0[0] * sigmoidf_(v0[0]), v0[1] * sigmoidf_(v0[1])), pack2(v0[2] * sigmoidf_(v0[2]), v0[3] * sigmoidf_(v0[3])),
                                                                                    pack2(v1[0] * sigmoidf_(v1[0]), v1[1] * sigmoidf_(v1[1])), pack2(v1[2] * sigmoidf_(v1[2]), v1[3] * sigmoidf_(v1[3])));
                    }
                }
        }
    }
};
struct EpiG2 {
    static constexpr bool PERM = true;
    const float* xp; const float* xs; float* yun;
    __device__ __forceinline__ void operator()(const pg8::f32x4 (&acc)[2][2][4][2], const pg8::Unit& u, int wr, int wc, int fr, int fq) const {
#pragma unroll
        for (int ai = 0; ai < 2; ++ai)
#pragma unroll
            for (int m = 0; m < 4; ++m) { const int row = u.pm * 256 + ai * 128 + wr * 64 + m * 16 + fr;
                if (row >= NTK) continue;
                const float* xr = row < NTOK ? xp + (size_t)row * DM : xs + (size_t)(row - NTOK) * DM;
#pragma unroll
                for (int bj = 0; bj < 2; ++bj) { const int col = u.pn * 256 + bj * 128 + wc * 32 + 8 * fq;
                    *(pg8::f32x4*)(yun + (size_t)row * DM + col) = acc[ai][bj][m][0] + *(const pg8::f32x4*)(xr + col);
                    *(pg8::f32x4*)(yun + (size_t)row * DM + col + 4) = acc[ai][bj][m][1] + *(const pg8::f32x4*)(xr + col + 4); } }
    }
};

typedef short prep_bf16x8 __attribute__((ext_vector_type(8)));
typedef float prep_f32x4 __attribute__((ext_vector_type(4)));
__device__ __forceinline__ void split8(const float (&x)[8], prep_bf16x8& hi, prep_bf16x8& lo) {
    unsigned h[4], l[4];
#pragma unroll
    for (int q = 0; q < 4; ++q) { h[q] = pack2(x[2 * q], x[2 * q + 1]);
        const float r0 = x[2 * q] - __uint_as_float(h[q] << 16), r1 = x[2 * q + 1] - __uint_as_float(h[q] & 0xffff0000u); l[q] = pack2(r0, r1); }
    typedef unsigned u4 __attribute__((ext_vector_type(4)));
    const u4 hv = {h[0], h[1], h[2], h[3]}, lv = {l[0], l[1], l[2], l[3]};
    hi = __builtin_bit_cast(prep_bf16x8, hv); lo = __builtin_bit_cast(prep_bf16x8, lv);
}
__device__ __forceinline__ void p0_prologue(const Params& P, float* lds) {
    const int tid = threadIdx.x, lane = tid & 63, wave = tid >> 6;
    bf16_t* A1 = (bf16_t*)(P.ws + WS_A1); bf16_t* Bt1 = (bf16_t*)(P.ws + WS_BT1); bf16_t* Bt2 = (bf16_t*)(P.ws + WS_BT2);
    const int gw = blockIdx.x * 8 + wave, nw = gridDim.x * 8;
    for (int r0 = gw; r0 < MROWS1; r0 += 2 * nw) {
        const float* srcs[2]; const float* gs[2]; bf16_t* dsts[2]; bool live[2];
#pragma unroll
        for (int q = 0; q < 2; ++q) { const int r = r0 + q * nw; live[q] = r < MROWS1; const int rr = live[q] ? r : 0;
            dsts[q] = A1 + (size_t)rr * DM; srcs[q] = nullptr; gs[q] = P.norm_g;
            if (rr < NTOK) srcs[q] = P.x_prompt + (size_t)rr * DM;
            else if (rr < NTK) srcs[q] = P.x_sample + (size_t)(rr - NTOK) * DM;
            else if (rr >= MEMROW0) { srcs[q] = P.mem_prompt + (size_t)(rr - MEMROW0) * DM; gs[q] = P.mem_norm_g; } }
        float4 x[2][4]; float ss[2] = {0.f, 0.f};
#pragma unroll
        for (int q = 0; q < 2; ++q)
#pragma unroll
            for (int j = 0; j < 4; ++j) x[q][j] = (live[q] && srcs[q]) ? *(const float4*)(srcs[q] + 4 * lane + 256 * j) : make_float4(0.f, 0.f, 0.f, 0.f);
#pragma unroll
        for (int q = 0; q < 2; ++q) {
#pragma unroll
            for (int j = 0; j < 4; ++j) ss[q] += x[q][j].x * x[q][j].x + x[q][j].y * x[q][j].y + x[q][j].z * x[q][j].z + x[q][j].w * x[q][j].w;
            ss[q] = wave_sum_fast(ss[q]); }
#pragma unroll
        for (int q = 0; q < 2; ++q) { if (!live[q]) continue;
            const float rs = rsqrtf(ss[q] * (1.f / DM) + NORM_EPS);
#pragma unroll
            for (int j = 0; j < 4; ++j) { const float4 gg = *(const float4*)(gs[q] + 4 * lane + 256 * j);
                uint2 w; w.x = pack2(x[q][j].x * rs * gg.x, x[q][j].y * rs * gg.y); w.y = pack2(x[q][j].z * rs * gg.z, x[q][j].w * rs * gg.w);
                *(uint2*)(dsts[q] + 4 * lane + 256 * j) = w; } }
    }
    for (int i = blockIdx.x * 512 + tid; i < 128 * DM / 4; i += gridDim.x * 512) *(uint2*)(Bt1 + (size_t)DIN * DM + (size_t)i * 4) = make_uint2(0u, 0u);
    for (int task = blockIdx.x; task < 1312; task += gridDim.x) {
        const float* src; int ld; bf16_t* dst; int k0;
        if (task < 928) { const int kt = task / 58, nt = task % 58; src = P.w_in + (size_t)kt * 64 * DIN + nt * 64; ld = DIN; dst = Bt1 + (size_t)(nt * 64) * DM; k0 = kt * 64; }
        else if (task < 992) { const int e = task - 928, kt = e / 4, nt = e % 4; src = P.w_mem_k + (size_t)kt * 64 * XW + nt * 64; ld = XW; dst = Bt1 + (size_t)(3840 + nt * 64) * DM; k0 = kt * 64; }
        else if (task < 1056) { const int e = task - 992, kt = e / 4, nt = e % 4; src = P.w_mem_v + (size_t)kt * 64 * XW + nt * 64; ld = XW; dst = Bt1 + (size_t)(4096 + nt * 64) * DM; k0 = kt * 64; }
        else { const int e = task - 1056, kt = e / 16, nt = e % 16; src = P.w_out + (size_t)kt * 64 * DM + nt * 64; ld = DM; dst = Bt2 + (size_t)(nt * 64) * DM; k0 = kt * 64; }
        __syncthreads();
#pragma unroll
        for (int p = 0; p < 8; ++p) { const int i = p * 8 + wave; lds[i * 65 + lane] = src[(size_t)i * ld + lane]; }
        __syncthreads();
        {
            const int jj = tid >> 3, kc = tid & 7;
            unsigned w[4];
#pragma unroll
            for (int q = 0; q < 4; ++q) w[q] = pack2(lds[(kc * 8 + 2 * q) * 65 + jj], lds[(kc * 8 + 2 * q + 1) * 65 + jj]);
            *(uint4*)(dst + (size_t)jj * DM + k0 + kc * 8) = make_uint4(w[0], w[1], w[2], w[3]);
        }
    }
    for (int idx = blockIdx.x * 512 + tid; idx < 2 * 6 * 4 * 2 * 64; idx += gridDim.x * 512) {
        const int l = idx & 63, s = (idx >> 6) & 1, nt = (idx >> 7) & 3, w = (idx >> 9) % 6, mt = idx / (512 * 6);
        const float* W = mt ? P.a_lora_b : P.w_lora_b; float x[8];
#pragma unroll
        for (int j = 0; j < 8; ++j) x[j] = W[(size_t)(32 * s + 8 * (l >> 4) + j) * RW + 64 * w + 16 * nt + (l & 15)];
        prep_bf16x8 hi, lo; split8(x, hi, lo);
        prep_bf16x8* LF = (prep_bf16x8*)(P.ws + WS_LFRAG);
        LF[idx] = hi; LF[2 * 6 * 4 * 2 * 64 + idx] = lo;
    }
    __syncthreads();
}

__device__ __forceinline__ void prep_produce(const Params& P, const bf16_t* __restrict__ prw, int ch, float* buf, int j, float mux) {
    constexpr int CT = 8;
    const int tok0 = ch * CT;
    float pv = 0.f;
    if (tok0 < NTOK && (tok0 & (SEQ - 1))) pv = bf2f(prw[(size_t)(tok0 - 1) * RCOLS + 1152 + j]);
    float cur[CT];
#pragma unroll
    for (int tk = 0; tk < CT; ++tk) cur[tk] = bf2f(prw[(size_t)(tok0 + tk) * RCOLS + 1152 + j]);
#pragma unroll
    for (int tk = 0; tk < CT; ++tk) {
        const int tok = tok0 + tk;
        if (tok >= NTOK) pv = P.state_shift[(size_t)(tok - NTOK) * RCOLS + 1152 + j];
        float x = cur[tk] + (pv - cur[tk]) * mux;
        if (j < 64) x = tanhf(x);
        buf[tk * 128 + j] = x;
        pv = cur[tk];
    }
}
__device__ __forceinline__ void p2_rwkv_prep(const Params& P, float* lds) {
    const int tid = threadIdx.x, lane = tid & 63, wave = tid >> 6;
    const bf16_t* prw = (const bf16_t*)(P.ws + WS_PRW);
    float* RSB = (float*)(P.ws + WS_RSB);
    constexpr int CT = 8, NCHK = NTK / CT;
    float* xbuf = lds;
    float* yt = lds + 2 * CT * 128 + wave * (2 * CT * 64);
    float* ot = lds + 2 * CT * 128 + 8 * (2 * CT * 64) + wave * 768;
    prep_bf16x8 wbh[2][4][2], wbl[2][4][2];
    float w0c = 0.f, a0c = 0.f, kkc = 0.f, kac = 0.f, rkc = 0.f, mur = 0.f, muk = 0.f, muv = 0.f, mux = 0.f;
    if (tid < RW) {
        const prep_bf16x8* LF = (const prep_bf16x8*)(P.ws + WS_LFRAG);
#pragma unroll
        for (int mt = 0; mt < 2; ++mt)
#pragma unroll
            for (int nt = 0; nt < 4; ++nt)
#pragma unroll
                for (int s = 0; s < 2; ++s) { const int fi = (((mt * 6 + wave) * 4 + nt) * 2 + s) * 64 + lane; wbh[mt][nt][s] = LF[fi]; wbl[mt][nt][s] = LF[2 * 6 * 4 * 2 * 64 + fi]; }
        w0c = P.w0[tid]; a0c = P.a0[tid]; kkc = P.k_k[tid]; kac = P.k_a[tid]; rkc = P.r_k[tid];
        mur = P.mu_shift[tid]; muk = P.mu_shift[RW + tid]; muv = P.mu_shift[2 * RW + tid];
    } else {
#pragma unroll
        for (int mt = 0; mt < 2; ++mt)
#pragma unroll
            for (int nt = 0; nt < 4; ++nt)
#pragma unroll
                for (int s = 0; s < 2; ++s)
#pragma unroll
                    for (int j = 0; j < 8; ++j) { wbh[mt][nt][s][j] = 0; wbl[mt][nt][s][j] = 0; }
        mux = P.mu_shift[1152 + (tid - RW)];
    }
    int ch = blockIdx.x;
    if (tid >= RW && ch < NCHK) prep_produce(P, prw, ch, xbuf, tid - RW, mux);
    for (int it = 0; ch < NCHK; ch += gridDim.x, ++it) {
        const int tok0 = ch * CT;
        float* bufc = xbuf + (it & 1) * (CT * 128); float* bufn = xbuf + ((it + 1) & 1) * (CT * 128);
        float nr[4], nk[4], nv[4], qr = 0.f, qk = 0.f, qv = 0.f;
        if (tid < RW) {
#pragma unroll
            for (int q = 0; q < 4; ++q) { const bf16_t* p = prw + (size_t)(tok0 + q) * RCOLS + tid; nr[q] = bf2f(p[0]); nk[q] = bf2f(p[RW]); nv[q] = bf2f(p[2 * RW]); }
            if (tok0 < NTOK && (tok0 & (SEQ - 1))) { const bf16_t* p = prw + (size_t)(tok0 - 1) * RCOLS + tid; qr = bf2f(p[0]); qk = bf2f(p[RW]); qv = bf2f(p[2 * RW]); }
        }
        asm volatile("s_waitcnt lgkmcnt(0)" ::: "memory");
        __builtin_amdgcn_s_barrier(); asm volatile("" ::: "memory");
        if (tid >= RW) { if (ch + (int)gridDim.x < NCHK) prep_produce(P, prw, ch + gridDim.x, bufn, tid - RW, mux); }
        else {
            const int c = tid, h = tid >> 6, cc = c & 63;
            {
                prep_bf16x8 ah[2][2], al_[2][2];
#pragma unroll
                for (int mt = 0; mt < 2; ++mt)
#pragma unroll
                    for (int s = 0; s < 2; ++s) { float x[8];
                        const float* xp = bufc + (lane & 7) * 128 + mt * 64 + 32 * s + 8 * (lane >> 4);
                        const float4 x0 = *(const float4*)xp, x1 = *(const float4*)(xp + 4);
                        const bool real = (lane & 15) < CT;
                        x[0] = real ? x0.x : 0.f; x[1] = real ? x0.y : 0.f; x[2] = real ? x0.z : 0.f; x[3] = real ? x0.w : 0.f;
                        x[4] = real ? x1.x : 0.f; x[5] = real ? x1.y : 0.f; x[6] = real ? x1.z : 0.f; x[7] = real ? x1.w : 0.f;
                        split8(x, ah[mt][s], al_[mt][s]); }
#pragma unroll
                for (int mt = 0; mt < 2; ++mt)
#pragma unroll
                    for (int nt = 0; nt < 4; ++nt) { prep_f32x4 acc = {0.f, 0.f, 0.f, 0.f};
#pragma unroll
                        for (int s = 0; s < 2; ++s) {
                            acc = __builtin_amdgcn_mfma_f32_16x16x32_bf16(al_[mt][s], wbh[mt][nt][s], acc, 0, 0, 0);
                            acc = __builtin_amdgcn_mfma_f32_16x16x32_bf16(ah[mt][s], wbl[mt][nt][s], acc, 0, 0, 0);
                            acc = __builtin_amdgcn_mfma_f32_16x16x32_bf16(ah[mt][s], wbh[mt][nt][s], acc, 0, 0, 0); }
                        if ((lane >> 4) < 2) {
#pragma unroll
                            for (int r = 0; r < 4; ++r) yt[(mt * CT + 4 * (lane >> 4) + r) * 64 + 16 * nt + (lane & 15)] = acc[r]; } }
                asm volatile("s_waitcnt lgkmcnt(0)" ::: "memory");
                __builtin_amdgcn_wave_barrier();
            }
#pragma unroll
            for (int tk = 0; tk < CT; ++tk) {
                const int tok = tok0 + tk;
                if (tok >= NTOK) { const float* p = P.state_shift + (size_t)(tok - NTOK) * RCOLS + tid; qr = p[0]; qk = p[RW]; qv = p[2 * RW]; }
                const float cr = nr[tk & 3], ck = nk[tk & 3], cv = nv[tk & 3];
                if (tk + 4 < CT) { const bf16_t* p = prw + (size_t)(tok + 4) * RCOLS + tid; nr[tk & 3] = bf2f(p[0]); nk[tk & 3] = bf2f(p[RW]); nv[tk & 3] = bf2f(p[2 * RW]); }
                const float r = cr + (qr - cr) * mur, kraw = ck + (qk - ck) * muk, v = cv + (qv - cv) * muv;
                qr = cr; qk = ck; qv = cv;
                const float aw = w0c + yt[tk * 64 + cc], aa = a0c + yt[(CT + tk) * 64 + cc];
                float* blk = RSB + ((size_t)tok * RH + h) * RSB_BLK;
                const float w = __expf(-DECAY_SCALE * sigmoidf_(aw)), a = sigmoidf_(aa);
                const float kkv = kraw * kkc;
                const float n2 = wave_sum_fast(kkv * kkv);
                const float kk = kkv * rsqrtf(fmaxf(n2, 1e-12f));
                const float kmod = kraw * (1.f + (a - 1.f) * kac);
                const float rk = wave_sum_fast(r * kmod * rkc);
                const float bb = kk * a;
                const float br = wave_sum_fast(bb * r), kr = wave_sum_fast(kmod * r);
                float* oq = ot + (tk & 1) * 384;
                oq[cc] = kk; oq[64 + cc] = w; oq[128 + cc] = bb; oq[192 + cc] = kmod; oq[256 + cc] = w * r; oq[320 + cc] = v;
                __builtin_amdgcn_wave_barrier();
                *(float4*)(blk + 4 * lane) = *(const float4*)(oq + 4 * lane);
                if (lane < 32) *(float4*)(blk + 256 + 4 * lane) = *(const float4*)(oq + 256 + 4 * lane);
                if (lane == 0) *(float4*)(blk + 384) = make_float4(br, kr, rk, 0.f);
                __builtin_amdgcn_wave_barrier();
            }
            __builtin_amdgcn_wave_barrier();
        }
    }
    __syncthreads();
}

__device__ __forceinline__ void p2_xattn_sample(const Params& P, float* lds) {
    const int tid = threadIdx.x, lane = tid & 63, wave = tid >> 6;
    const bf16_t* xq = (const bf16_t*)(P.ws + WS_XQ); const bf16_t* gate = (const bf16_t*)(P.ws + WS_GATE); bf16_t* O = (bf16_t*)(P.ws + WS_O);
    float* zl = lds + wave * 64; float* part = lds + 512;
    const int c = lane & 15, g = lane >> 4;
    for (int task = (int)blockIdx.x - 128; task >= 0 && task < DB * XH; task += 128) {
        const int b = task >> 2, h = task & 3; const size_t row = NTOK + b;
        const bf16_t* qp = xq + row * XW + h * 64 + 4 * c;
        const float q0 = bf2f(qp[0]), q1 = bf2f(qp[1]), q2 = bf2f(qp[2]), q3 = bf2f(qp[3]);
        const float* Kp = P.cmem_k + (((size_t)b * NMEM + wave * 32) * XH + h) * HD + 4 * c; const float* Vp = P.cmem_v + (((size_t)b * NMEM + wave * 32) * XH + h) * HD + 4 * c;
        __syncthreads();
        float4 k4[8], v4[8];
#pragma unroll
        for (int i = 0; i < 8; ++i) { k4[i] = *(const float4*)(Kp + (size_t)(4 * i + g) * (XH * HD)); v4[i] = *(const float4*)(Vp + (size_t)(4 * i + g) * (XH * HD)); }
#pragma unroll
        for (int i = 0; i < 8; ++i) { float p = q0 * k4[i].x + q1 * k4[i].y + q2 * k4[i].z + q3 * k4[i].w; p = sum16(p); if (c == 0) zl[4 * i + g] = p; }
        asm volatile("s_waitcnt lgkmcnt(0)" ::: "memory");
        __builtin_amdgcn_wave_barrier();
        const float z = zl[lane & 31];
        const float mx = wave_max(z);
        const float p = (lane < 32) ? exp2f(z - mx) : 0.f;
        const float ls = wave_sum_fast(p);
        __builtin_amdgcn_wave_barrier();
        if (lane < 32) zl[lane] = p;
        asm volatile("s_waitcnt lgkmcnt(0)" ::: "memory");
        __builtin_amdgcn_wave_barrier();
        float4 o4 = make_float4(0.f, 0.f, 0.f, 0.f);
#pragma unroll
        for (int i = 0; i < 8; ++i) { const float w = zl[4 * i + g]; o4.x += w * v4[i].x; o4.y += w * v4[i].y; o4.z += w * v4[i].z; o4.w += w * v4[i].w; }
#pragma unroll
        for (int off = 16; off < 64; off <<= 1) { o4.x += __shfl_xor(o4.x, off); o4.y += __shfl_xor(o4.y, off); o4.z += __shfl_xor(o4.z, off); o4.w += __shfl_xor(o4.w, off); }
        if (g == 0) *(float4*)(part + wave * 68 + 4 * c) = o4;
        if (lane == 0) { part[wave * 68 + 64] = mx; part[wave * 68 + 65] = ls; }
        __syncthreads();
        if (wave == 0) {
            float M = part[64];
#pragma unroll
            for (int w = 1; w < 8; ++w) M = fmaxf(M, part[w * 68 + 64]);
            float L = 0.f, o = 0.f;
#pragma unroll
            for (int w = 0; w < 8; ++w) { const float sc = exp2f(part[w * 68 + 64] - M); L += part[w * 68 + 65] * sc; o += part[w * 68 + lane] * sc; }
            O[row * DM + 768 + h * 64 + lane] = f2bf(o / L * bf2f(gate[row * DM + 768 + h * 64 + lane]));
        }
    }
    __syncthreads();
}

constexpr int DEC_NTASK = DB * NPAGES * SH, DEC_LDS_OFF = 144384;
constexpr int QW_SB = 3584, QW_DEC = 3648;
__device__ __forceinline__ void sb_decode_task(const Params& P, float* lds, int task) {
    const int tid = threadIdx.x, lane = tid & 63, wave = tid >> 6;
    const bf16_t* qb = (const bf16_t*)(P.ws + WS_QB);
    float* dpart = (float*)(P.ws + WS_DPART); float* dl = (float*)(P.ws + WS_DL);
    float* zl = lds + DEC_LDS_OFF / 4 + wave * 256; float* wl = zl + 128;
    const int c = lane & 15, g = lane >> 4;
    {
        const int h = task % SH, bj = task / SH, b = bj / NPAGES;
        const int page = P.page_table[bj];
        const float* Kp = P.cache_k + ((size_t)page * PAGE * SH + h) * HD;
        const float* Vp = P.cache_v + ((size_t)page * PAGE * SH + h) * HD;
        const bf16_t* qp = qb + (size_t)(NTOK + b) * SBW + h * 64 + 4 * c;
        const float q0 = bf2f(qp[0]), q1 = bf2f(qp[1]), q2 = bf2f(qp[2]), q3 = bf2f(qp[3]);
        const float bias = P.sb_bias[h] * LOG2E;
        float4 kv[16];
#pragma unroll
        for (int i = 0; i < 16; ++i) kv[i] = *(const float4*)(Kp + (size_t)(4 * i + g) * (SH * HD) + 4 * c);
#pragma unroll
        for (int hb = 0; hb < 2; ++hb) {
            float4 nx[16];
            if (hb == 0) {
#pragma unroll
                for (int i = 0; i < 16; ++i) nx[i] = *(const float4*)(Kp + (size_t)(64 + 4 * i + g) * (SH * HD) + 4 * c);
            } else {
#pragma unroll
                for (int i = 0; i < 16; ++i) nx[i] = *(const float4*)(Vp + (size_t)(4 * i + g) * (SH * HD) + 4 * c);
            }
#pragma unroll
            for (int i = 0; i < 16; ++i) { const int s = 64 * hb + 4 * i + g;
                float part = q0 * kv[i].x + q1 * kv[i].y + q2 * kv[i].z + q3 * kv[i].w; part = sum16(part);
                if (c == 0) zl[s] = part + bias; }
#pragma unroll
            for (int i = 0; i < 16; ++i) kv[i] = nx[i];
        }
        asm volatile("s_waitcnt lgkmcnt(0)" ::: "memory");
        __builtin_amdgcn_wave_barrier();
        const float z0 = zl[2 * lane], z1 = zl[2 * lane + 1];
        const float sp0 = softplus2_(z0), sp1 = softplus2_(z1);
        float incl = sp0 + sp1;
#pragma unroll
        for (int off = 1; off < 64; off <<= 1) { const float t = __shfl_down(incl, off); if (lane + off < 64) incl += t; }
        const float excl = incl - (sp0 + sp1);
        wl[2 * lane] = exp2f(z0 - sp0 - (excl + sp1));
        wl[2 * lane + 1] = exp2f(z1 - sp1 - excl);
        const float Ltot = __shfl(incl, 0);
        asm volatile("s_waitcnt lgkmcnt(0)" ::: "memory");
        __builtin_amdgcn_wave_barrier();
        float4 o4 = make_float4(0.f, 0.f, 0.f, 0.f);
        {
            float4 nx[16];
#pragma unroll
            for (int i = 0; i < 16; ++i) nx[i] = *(const float4*)(Vp + (size_t)(64 + 4 * i + g) * (SH * HD) + 4 * c);
#pragma unroll
            for (int i = 0; i < 16; ++i) { const float w = wl[4 * i + g]; o4.x += w * kv[i].x; o4.y += w * kv[i].y; o4.z += w * kv[i].z; o4.w += w * kv[i].w; }
#pragma unroll
            for (int i = 0; i < 16; ++i) { const float w = wl[64 + 4 * i + g]; o4.x += w * nx[i].x; o4.y += w * nx[i].y; o4.z += w * nx[i].z; o4.w += w * nx[i].w; }
        }
#pragma unroll
        for (int off = 16; off < 64; off <<= 1) { o4.x += __shfl_xor(o4.x, off); o4.y += __shfl_xor(o4.y, off); o4.z += __shfl_xor(o4.z, off); o4.w += __shfl_xor(o4.w, off); }
        if (g == 0) *(float4*)(dpart + (size_t)task * HD + 4 * c) = o4;
        if (lane == 0) dl[task] = Ltot;
        __builtin_amdgcn_wave_barrier();
    }
}

__device__ __forceinline__ void sb_decode_wave_loop(const Params& P, float* lds) {
    unsigned* qd = (unsigned*)(P.ws + WS_BAR) + QW_DEC;
    const int lane = threadIdx.x & 63;
    unsigned nxt = 0u;
    if (lane == 0) nxt = atomicAdd(qd, 2u);
    for (;;) {
        const int t = __builtin_amdgcn_readfirstlane((int)nxt);
        if (t >= DEC_NTASK) break;
        if (lane == 0) nxt = atomicAdd(qd, 2u);
        sb_decode_task(P, lds, t); sb_decode_task(P, lds, t + 1);
    }
}

struct StepIn { float4 kk, w, b, k, wr; float v; float2 sc; };
__device__ __forceinline__ void load_step(StepIn& s, const float* __restrict__ p, int c0, int rl) {
    s.kk = *(const float4*)(p + c0); s.w = *(const float4*)(p + 64 + c0); s.b = *(const float4*)(p + 128 + c0); s.k = *(const float4*)(p + 192 + c0); s.wr = *(const float4*)(p + 256 + c0);
    s.v = p[320 + rl]; s.sc = *(const float2*)(p + 384);
}
__device__ __forceinline__ void scan_step(float4& S, const StepIn& s, float* __restrict__ op) {
    float d1 = S.x * s.kk.x + S.y * s.kk.y + S.z * s.kk.z + S.w * s.kk.w;
    float d2 = S.x * s.wr.x + S.y * s.wr.y + S.z * s.wr.z + S.w * s.wr.w;
    d1 = sum16(d1); d2 = sum16(d2);
    S.x = S.x * s.w.x - d1 * s.b.x + s.v * s.k.x; S.y = S.y * s.w.y - d1 * s.b.y + s.v * s.k.y; S.z = S.z * s.w.z - d1 * s.b.z + s.v * s.k.z; S.w = S.w * s.w.w - d1 * s.b.w + s.v * s.k.w;
    *op = d2 - d1 * s.sc.x + s.v * s.sc.y;
}
__device__ __forceinline__ float scan_step_asm(float4& S, const StepIn& s) {
    float o, d1, d2, t;
    asm volatile(
        "v_mul_f32 %5, %0, %8\n\t"  "v_mul_f32 %6, %0, %12\n\t"
        "v_fmac_f32 %5, %1, %9\n\t" "v_fmac_f32 %6, %1, %13\n\t"
        "v_fmac_f32 %5, %2, %10\n\t" "v_fmac_f32 %6, %2, %14\n\t"
        "v_fmac_f32 %5, %3, %11\n\t" "v_fmac_f32 %6, %3, %15\n\t"
        "v_mul_f32 %0, %0, %16\n\t" "v_mul_f32 %1, %1, %17\n\t"
        "v_add_f32_dpp %5, %5, %5 quad_perm:[1,0,3,2] row_mask:0xf bank_mask:0xf\n\t"
        "v_add_f32_dpp %6, %6, %6 quad_perm:[1,0,3,2] row_mask:0xf bank_mask:0xf\n\t"
        "v_mul_f32 %2, %2, %18\n\t" "v_mul_f32 %3, %3, %19\n\t"
        "v_add_f32_dpp %5, %5, %5 quad_perm:[2,3,0,1] row_mask:0xf bank_mask:0xf\n\t"
        "v_add_f32_dpp %6, %6, %6 quad_perm:[2,3,0,1] row_mask:0xf bank_mask:0xf\n\t"
        "v_fmac_f32 %0, %28, %20\n\t" "v_fmac_f32 %1, %28, %21\n\t"
        "v_add_f32_dpp %5, %5, %5 row_ror:4 row_mask:0xf bank_mask:0xf\n\t"
        "v_add_f32_dpp %6, %6, %6 row_ror:4 row_mask:0xf bank_mask:0xf\n\t"
        "v_fmac_f32 %2, %28, %22\n\t" "v_fmac_f32 %3, %28, %23\n\t"
        "v_add_f32_dpp %5, %5, %5 row_ror:8 row_mask:0xf bank_mask:0xf\n\t"
        "v_add_f32_dpp %6, %6, %6 row_ror:8 row_mask:0xf bank_mask:0xf\n\t"
        "v_mul_f32 %7, %28, %30\n\t"
        "v_fma_f32 %0, -%5, %24, %0\n\t" "v_fma_f32 %1, -%5, %25, %1\n\t" "v_fma_f32 %2, -%5, %26, %2\n\t" "v_fma_f32 %3, -%5, %27, %3\n\t"
        "v_add_f32 %4, %6, %7\n\t"
        "v_fma_f32 %4, -%5, %29, %4\n\t"
        "s_nop 0"
        : "+v"(S.x), "+v"(S.y), "+v"(S.z), "+v"(S.w), "=&v"(o), "=&v"(d1), "=&v"(d2), "=&v"(t)
        : "v"(s.kk.x), "v"(s.kk.y), "v"(s.kk.z), "v"(s.kk.w), "v"(s.wr.x), "v"(s.wr.y), "v"(s.wr.z), "v"(s.wr.w),
          "v"(s.w.x), "v"(s.w.y), "v"(s.w.z), "v"(s.w.w), "v"(s.k.x), "v"(s.k.y), "v"(s.k.z), "v"(s.k.w),
          "v"(s.b.x), "v"(s.b.y), "v"(s.b.z), "v"(s.b.w), "v"(s.v), "v"(s.sc.x), "v"(s.sc.y));
    return o;
}
__device__ __forceinline__ void scan_rows(const Params& P, int tok0, int T, int h, int row0, const float* S0, float* Sout, int lane) {
    const int rl = row0 + (lane >> 4), c0 = (lane & 15) * 4;
    const float* p = (const float*)(P.ws + WS_RSB) + ((size_t)tok0 * RH + h) * RSB_BLK;
    float* op = (float*)(P.ws + WS_ORAW) + (size_t)tok0 * RW + h * 64 + rl;
    constexpr int PST = RH * RSB_BLK;
    float4 S = S0 ? *(const float4*)(S0 + rl * 64 + c0) : make_float4(0.f, 0.f, 0.f, 0.f);
    if (T >= 16) {
        StepIn ring[8];
#pragma unroll
        for (int j = 0; j < 8; ++j) load_step(ring[j], p + (size_t)j * PST, c0, rl);
        for (int t0 = 0; t0 < T - 8; t0 += 8) {
#pragma unroll
            for (int j = 0; j < 8; ++j) { scan_step(S, ring[j], op + (size_t)j * RW); load_step(ring[j], p + (size_t)(8 + j) * PST, c0, rl); }
            p += 8 * PST; op += 8 * RW;
        }
#pragma unroll
        for (int j = 0; j < 8; ++j) scan_step(S, ring[j], op + (size_t)j * RW);
    } else {
        for (int t = 0; t < T; ++t) { StepIn s; load_step(s, p + (size_t)t * PST, c0, rl); scan_step(S, s, op + (size_t)t * RW); }
    }
    *(float4*)(Sout + rl * 64 + c0) = S;
}

constexpr int SCH = 16, SC_NPIECE = SCH * 97, SC_NP64 = (SC_NPIECE + 63) / 64, SC_BUF = 28672, SC_NB = 5;
__device__ __forceinline__ void lds_load_step(StepIn& s, const float* p, int c0, int rl) {
    s.kk = *(const float4*)(p + c0); s.w = *(const float4*)(p + 64 + c0); s.b = *(const float4*)(p + 128 + c0); s.k = *(const float4*)(p + 192 + c0); s.wr = *(const float4*)(p + 256 + c0);
    s.v = p[320 + rl]; s.sc = *(const float2*)(p + 384);
}
#ifndef SC_FREE_WAVES
#define SC_FREE_WAVES 2
#endif
constexpr int SC_CTL_OFF = SC_NB * 28672;
__device__ __forceinline__ void scan_prompt_wave(const Params& P, unsigned char* lds, int b, int h, int quarter) {
    const int tid = threadIdx.x, lane = tid & 63; const int wave = __builtin_amdgcn_readfirstlane(tid >> 6);
    constexpr int PST = RH * RSB_BLK, NCH = SEQ / SCH;
    volatile LAS unsigned* scw = (volatile LAS unsigned*)((LAS unsigned char*)lds + SC_CTL_OFF);
    if (wave == 4) {
        const float* g0 = (const float*)(P.ws + WS_RSB) + ((size_t)(b * SEQ) * RH + h) * RSB_BLK;
        LAS unsigned char* l3 = (LAS unsigned char*)lds;
        int soff[SC_NP64];
#pragma unroll
        for (int j = 0; j < SC_NP64; ++j) { const int i = j * 64 + lane; const int ii = i < SC_NPIECE ? i : SC_NPIECE - 1; soff[j] = (ii / 97) * PST + (ii % 97) * 4; }
        for (int c = 0; c < NCH; ++c) {
            if (c >= SC_NB) {
                for (;;) { const unsigned d0 = scw[1], d1 = scw[2], d2 = scw[3], d3 = scw[4]; const unsigned m01 = d0 < d1 ? d0 : d1, m23 = d2 < d3 ? d2 : d3;
                    if ((m01 < m23 ? m01 : m23) >= (unsigned)(c - SC_NB + 1)) break; __builtin_amdgcn_s_sleep(1); }
            }
            const float* g_ = g0 + (size_t)c * SCH * PST;
#pragma unroll
            for (int j = 0; j < SC_NP64; ++j) {
                if (j * 64 + lane < SC_NPIECE) __builtin_amdgcn_global_load_lds((const unsigned*)(g_ + soff[j]), (LAS unsigned*)(l3 + (c % SC_NB) * SC_BUF + j * 1024), 16, 0, 0);
            }
            if (c >= 1) { asm volatile("s_waitcnt vmcnt(25)" ::: "memory"); if (lane == 0) scw[0] = (unsigned)c; }
        }
        asm volatile("s_waitcnt vmcnt(0)" ::: "memory");
        if (lane == 0) scw[0] = (unsigned)NCH;
    } else if (wave < 4) {
        const int rl = quarter * 16 + wave * 4 + (lane >> 4), cl = lane & 15, c0 = cl * 4;
        float* op = (float*)(P.ws + WS_ORAW) + (size_t)(b * SEQ) * RW + h * 64 + rl;
        float4 S = make_float4(0.f, 0.f, 0.f, 0.f);
        while (scw[0] < 1u) __builtin_amdgcn_s_sleep(1);
        asm volatile("" ::: "memory");
        StepIn r[4];
        lds_load_step(r[0], (const float*)lds, c0, rl); lds_load_step(r[1], (const float*)lds + RSB_BLK, c0, rl); lds_load_step(r[2], (const float*)lds + 2 * RSB_BLK, c0, rl);
        for (int c = 0; c < NCH; ++c) {
            const float* bp = (const float*)(lds + (c % SC_NB) * SC_BUF); const float* bpn = (const float*)(lds + ((c + 1) % SC_NB) * SC_BUF);
            float ov = 0.f;
#pragma unroll
            for (int s = 0; s < SCH; ++s) {
                if (s == SCH - 3 && c + 1 < NCH) { while (scw[0] < (unsigned)(c + 2)) __builtin_amdgcn_s_sleep(1); asm volatile("" ::: "memory"); }
                lds_load_step(r[(s + 3) & 3], (s + 3 < SCH) ? bp + (s + 3) * RSB_BLK : bpn + (s + 3 - SCH) * RSB_BLK, c0, rl); __builtin_amdgcn_sched_barrier(0);
                const float o = scan_step_asm(S, r[s & 3]); __builtin_amdgcn_sched_barrier(0);
                ov = (cl == s) ? o : ov;
            }
            op[(size_t)cl * RW] = ov;
            op += (size_t)SCH * RW;
            if (lane == 0) scw[1 + wave] = (unsigned)(c + 1);
        }
        *(float4*)(P.out + OUT_WKV_P + ((size_t)(b * RH + h) * HD + rl) * HD + c0) = S;
    }
}

namespace sba {
typedef short bf16x8 __attribute__((ext_vector_type(8)));
typedef short s16x4 __attribute__((ext_vector_type(4)));
typedef float f32x16 __attribute__((ext_vector_type(16)));
typedef unsigned u32x4 __attribute__((ext_vector_type(4)));
typedef __attribute__((address_space(3))) const unsigned char* lds_cptr;
constexpr int SLOT = 16384;
#define SBA_MFMA(a, b, c) __builtin_amdgcn_mfma_f32_32x32x16_bf16(a, b, c, 0, 0, 0)
__device__ __forceinline__ unsigned cvtpk(float lo, float hi) { return pack2(lo, hi); }
__device__ __forceinline__ bf16x8 pack8(const f32x16& x, int base) {
    u32x4 w; w[0] = cvtpk(x[base], x[base + 1]); w[1] = cvtpk(x[base + 2], x[base + 3]); w[2] = cvtpk(x[base + 4], x[base + 5]); w[3] = cvtpk(x[base + 6], x[base + 7]);
    return __builtin_bit_cast(bf16x8, w);
}
__device__ __forceinline__ int crow(int r, int hi) { return (r & 3) + 8 * (r >> 2) + 4 * hi; }
__device__ __forceinline__ bf16x8 vfrag(lds_cptr p) {
    const s16x4 a = __builtin_bit_cast(s16x4, __builtin_amdgcn_ds_read_tr16_b64_v4i16((__attribute__((address_space(3))) s16x4*)p));
    const s16x4 b = __builtin_bit_cast(s16x4, __builtin_amdgcn_ds_read_tr16_b64_v4i16((__attribute__((address_space(3))) s16x4*)(p + 8 * 64)));
    bf16x8 r; r[0] = a[0]; r[1] = a[1]; r[2] = a[2]; r[3] = a[3]; r[4] = b[0]; r[5] = b[1]; r[6] = b[2]; r[7] = b[3]; return r;
}

template <bool MASK>
__device__ __forceinline__ void tile(lds_cptr kp0, lds_cptr vp0, const bf16x8 (&qr)[4], const f32x16& biasv, const bf16x8& ut0, const bf16x8& ut1, const bf16x8& uon,
                                     f32x16& o0, f32x16& o1, float& R, int kbase, int trel, int hi) {
    f32x16 p0 = biasv, p1 = biasv;
#pragma unroll
    for (int d0 = 0; d0 < 4; ++d0) {
        const bf16x8 ka = *(const __attribute__((address_space(3))) bf16x8*)(kp0 + d0 * 2048);
        const bf16x8 kb = *(const __attribute__((address_space(3))) bf16x8*)(kp0 + d0 * 2048 + 512);
        p0 = SBA_MFMA(ka, qr[d0], p0); p1 = SBA_MFMA(kb, qr[d0], p1);
    }
    f32x16 s0, s1;
#pragma unroll
    for (int r = 0; r < 16; ++r) {
        s0[r] = __builtin_amdgcn_logf(1.f + __builtin_amdgcn_exp2f(p0[r]));
        s1[r] = __builtin_amdgcn_logf(1.f + __builtin_amdgcn_exp2f(p1[r]));
        if (MASK) { const int k0 = kbase + crow(r, hi); if (k0 >= trel) s0[r] = 0.f; if (k0 + 32 >= trel) s1[r] = 0.f; }
    }
    const bf16x8 b00 = pack8(s0, 0), b01 = pack8(s0, 8), b10 = pack8(s1, 0), b11 = pack8(s1, 8);
    f32x16 c0, c1;
#pragma unroll
    for (int r = 0; r < 16; ++r) { c0[r] = p0[r] - R; c1[r] = p1[r] - R; }
    const float top = c0[0];
    c0 = SBA_MFMA(ut0, b00, c0); c0 = SBA_MFMA(ut1, b01, c0); c0 = SBA_MFMA(uon, b10, c0); c0 = SBA_MFMA(uon, b11, c0);
    c1 = SBA_MFMA(ut0, b10, c1); c1 = SBA_MFMA(ut1, b11, c1);
    const float tot_l = top - c0[0];
    const auto sw = __builtin_amdgcn_permlane32_swap(__float_as_uint(tot_l), __float_as_uint(tot_l), false, false);
    const float tot = __uint_as_float(sw[0]);
#pragma unroll
    for (int r = 0; r < 16; ++r) {
        c0[r] = __builtin_amdgcn_exp2f(c0[r]); c1[r] = __builtin_amdgcn_exp2f(c1[r]);
        if (MASK) { const int k0 = kbase + crow(r, hi); if (k0 >= trel) c0[r] = 0.f; if (k0 + 32 >= trel) c1[r] = 0.f; }
    }
    const bf16x8 a00 = pack8(c0, 0), a01 = pack8(c0, 8), a10 = pack8(c1, 0), a11 = pack8(c1, 8);
    o0 = SBA_MFMA(vfrag(vp0 + 0 * 1024), a00, o0); o1 = SBA_MFMA(vfrag(vp0 + 4096 + 0 * 1024), a00, o1);
    o0 = SBA_MFMA(vfrag(vp0 + 1 * 1024), a01, o0); o1 = SBA_MFMA(vfrag(vp0 + 4096 + 1 * 1024), a01, o1);
    o0 = SBA_MFMA(vfrag(vp0 + 2 * 1024), a10, o0); o1 = SBA_MFMA(vfrag(vp0 + 4096 + 2 * 1024), a10, o1);
    o0 = SBA_MFMA(vfrag(vp0 + 3 * 1024), a11, o0); o1 = SBA_MFMA(vfrag(vp0 + 4096 + 3 * 1024), a11, o1);
    R += tot;
}

__device__ __forceinline__ void unit(const Params& P, unsigned char* lds, int b, int h, int qb) {
    const int tid = threadIdx.x, lane = tid & 63, r32 = lane & 31, hi = lane >> 5; const int wid = __builtin_amdgcn_readfirstlane(tid >> 6);
    const bf16_t* Q = (const bf16_t*)(P.ws + WS_QB); const bf16_t* K = (const bf16_t*)(P.ws + WS_KB); const bf16_t* V = (const bf16_t*)(P.ws + WS_VB);
    const bf16_t* gate = (const bf16_t*)(P.ws + WS_GATE); bf16_t* O = (bf16_t*)(P.ws + WS_O);
    const size_t rowbase = (size_t)b * SEQ; const int q0 = qb * 256, NT = (q0 + 256) / 64;
    const int trel = wid * 32 + r32;
    const size_t qrow = rowbase + q0 + trel;
    bf16x8 qr[4];
#pragma unroll
    for (int d0 = 0; d0 < 4; ++d0) qr[d0] = *(const bf16x8*)(Q + qrow * SBW + h * 64 + d0 * 16 + hi * 8);
    const bf16_t* ksrc = K + (rowbase + lane) * SBW + h * 64 + wid * 8;
    const bf16_t* vsrc = V + (rowbase + 16 * (wid & 3) + (lane >> 2)) * SBW + h * 64 + (wid >> 2) * 32 + (lane & 3) * 8;
    LAS unsigned char* l3 = (LAS unsigned char*)lds;
#define SBA_DMA(t, slot) do { __builtin_amdgcn_global_load_lds((const unsigned*)(ksrc + (size_t)(t) * 64 * SBW), (LAS unsigned*)(l3 + (slot) + wid * 1024), 16, 0, 0); \
        __builtin_amdgcn_global_load_lds((const unsigned*)(vsrc + (size_t)(t) * 64 * SBW), (LAS unsigned*)(l3 + (slot) + 8192 + wid * 1024), 16, 0, 0); } while (0)
    const int koff = hi * 1024 + r32 * 16;
    const int voff = 8192 + ((lane >> 4) & 1) * 32 + (lane & 3) * 8 + (4 * hi + ((lane & 15) >> 2)) * 64;
    bf16x8 ut0, ut1, uon;
#pragma unroll
    for (int jj = 0; jj < 8; ++jj) { const int kj = 8 * (jj >> 2) + 4 * hi + (jj & 3);
        ut0[jj] = (kj >= r32) ? (short)0xBF80 : (short)0; ut1[jj] = (16 + kj >= r32) ? (short)0xBF80 : (short)0; uon[jj] = (short)0xBF80; }
    f32x16 biasv; { const float b2 = P.sb_bias[h] * LOG2E;
#pragma unroll
        for (int r = 0; r < 16; ++r) biasv[r] = b2; }
    f32x16 o0, o1;
#pragma unroll
    for (int r = 0; r < 16; ++r) { o0[r] = 0.f; o1[r] = 0.f; }
    float R = 0.f;
    __syncthreads();
    SBA_DMA(NT - 1, ((NT - 1) & 1) * SLOT);
    asm volatile("s_waitcnt vmcnt(0)" ::: "memory");
    __syncthreads();
    for (int t = NT - 1; t >= 0; --t) {
        const int slot = (t & 1) * SLOT;
        if (t > 0) SBA_DMA(t - 1, slot ^ SLOT);
        const int jb = t - (NT - 4);
        const lds_cptr kp0 = (lds_cptr)l3 + slot + koff, vp0 = (lds_cptr)l3 + slot + voff;
        if (jb < 0) tile<false>(kp0, vp0, qr, biasv, ut0, ut1, uon, o0, o1, R, 0, 0, hi);
        else if (64 * jb < wid * 32 + 31) {
            if (64 * jb + 63 >= wid * 32) tile<true>(kp0, vp0, qr, biasv, ut0, ut1, uon, o0, o1, R, 64 * jb, trel, hi);
            else tile<false>(kp0, vp0, qr, biasv, ut0, ut1, uon, o0, o1, R, 0, 0, hi);
        }
        asm volatile("s_waitcnt vmcnt(0)" ::: "memory");
        __syncthreads();
    }
#undef SBA_DMA
    const bf16_t* gr = gate + qrow * DM + 384 + h * 64; bf16_t* orow = O + qrow * DM + 384 + h * 64;
#pragma unroll
    for (int half = 0; half < 2; ++half)
#pragma unroll
        for (int g = 0; g < 4; ++g) { const int d = 32 * half + 8 * g + 4 * hi; const uint2 gt = *(const uint2*)(gr + d);
            const f32x16& o = half ? o1 : o0;
            uint2 w; w.x = cvtpk(o[4 * g] * __uint_as_float(gt.x << 16), o[4 * g + 1] * __uint_as_float(gt.x & 0xffff0000u));
            w.y = cvtpk(o[4 * g + 2] * __uint_as_float(gt.y << 16), o[4 * g + 3] * __uint_as_float(gt.y & 0xffff0000u));
            *(uint2*)(orow + d) = w; }
}
}

__device__ __forceinline__ void p2_xattn_prompt(const Params& P, unsigned char* lds) {
    using namespace sba;
    const int tid = threadIdx.x, lane = tid & 63, r32 = lane & 31, hi = lane >> 5; const int wid = __builtin_amdgcn_readfirstlane(tid >> 6);
    const bf16_t* xq = (const bf16_t*)(P.ws + WS_XQ); const bf16_t* gate = (const bf16_t*)(P.ws + WS_GATE); bf16_t* O = (bf16_t*)(P.ws + WS_O);
    const float* MK = P.out + OUT_MK_P; const float* MV = P.out + OUT_MV_P;
    for (int task = blockIdx.x; task < NB * XH * 16; task += gridDim.x) {
        const int qblk = task & 15, h = (task >> 4) & 3, b = task >> 6;
        __syncthreads();
        for (int it = tid; it < 2048; it += 512) {
            const int key = it & 255, ch = it >> 8;
            const float* s = MK + ((size_t)(b * NMEM + key)) * XW + h * 64 + ch * 8;
            const float4 a = *(const float4*)s, c = *(const float4*)(s + 4);
            *(uint4*)(lds + (key >> 6) * 8192 + ch * 1024 + (key & 63) * 16) = make_uint4(pack2(a.x, a.y), pack2(a.z, a.w), pack2(c.x, c.y), pack2(c.z, c.w));
        }
        for (int it = tid; it < 2048; it += 512) {
            const int pl = it & 3, key = (it >> 2) & 255, ph = it >> 10;
            const float* s = MV + ((size_t)(b * NMEM + key)) * XW + h * 64 + ph * 32 + pl * 8;
            const float4 a = *(const float4*)s, c = *(const float4*)(s + 4);
            *(uint4*)(lds + 32768 + (key >> 6) * 8192 + ph * 4096 + (key & 63) * 64 + pl * 16) = make_uint4(pack2(a.x, a.y), pack2(a.z, a.w), pack2(c.x, c.y), pack2(c.z, c.w));
        }
        __syncthreads();
        const size_t row = (size_t)b * SEQ + qblk * 256 + wid * 32 + r32;
        bf16x8 qr[4];
#pragma unroll
        for (int d0 = 0; d0 < 4; ++d0) qr[d0] = *(const bf16x8*)(xq + row * XW + h * 64 + d0 * 16 + hi * 8);
        f32x16 p[8];
#pragma unroll
        for (int i = 0; i < 8; ++i)
#pragma unroll
            for (int r = 0; r < 16; ++r) p[i][r] = 0.f;
        const lds_cptr kp = (lds_cptr)(LAS unsigned char*)lds + hi * 1024 + r32 * 16;
#pragma unroll
        for (int tl = 0; tl < 4; ++tl)
#pragma unroll
            for (int d0 = 0; d0 < 4; ++d0) {
                const bf16x8 ka = *(const __attribute__((address_space(3))) bf16x8*)(kp + tl * 8192 + d0 * 2048);
                const bf16x8 kb = *(const __attribute__((address_space(3))) bf16x8*)(kp + tl * 8192 + d0 * 2048 + 512);
                p[2 * tl] = SBA_MFMA(ka, qr[d0], p[2 * tl]); p[2 * tl + 1] = SBA_MFMA(kb, qr[d0], p[2 * tl + 1]);
            }
        float m = p[0][0];
#pragma unroll
        for (int i = 0; i < 8; ++i)
#pragma unroll
            for (int r = 0; r < 16; ++r) m = fmaxf(m, p[i][r]);
        { const auto sw = __builtin_amdgcn_permlane32_swap(__float_as_uint(m), __float_as_uint(m), false, false); m = fmaxf(__uint_as_float(sw[0]), __uint_as_float(sw[1])); }
        float l = 0.f;
#pragma unroll
        for (int i = 0; i < 8; ++i)
#pragma unroll
            for (int r = 0; r < 16; ++r) { p[i][r] = __builtin_amdgcn_exp2f(p[i][r] - m); l += p[i][r]; }
        { const auto sw = __builtin_amdgcn_permlane32_swap(__float_as_uint(l), __float_as_uint(l), false, false); l = __uint_as_float(sw[0]) + __uint_as_float(sw[1]); }
        f32x16 o0, o1;
#pragma unroll
        for (int r = 0; r < 16; ++r) { o0[r] = 0.f; o1[r] = 0.f; }
        const lds_cptr vp = (lds_cptr)(LAS unsigned char*)lds + 32768 + ((lane >> 4) & 1) * 32 + (lane & 3) * 8 + (4 * hi + ((lane & 15) >> 2)) * 64;
#pragma unroll
        for (int tl = 0; tl < 4; ++tl)
#pragma unroll
            for (int X = 0; X < 4; ++X) {
                const bf16x8 a = pack8(p[2 * tl + (X >> 1)], (X & 1) * 8);
                o0 = SBA_MFMA(vfrag(vp + tl * 8192 + X * 1024), a, o0); o1 = SBA_MFMA(vfrag(vp + tl * 8192 + 4096 + X * 1024), a, o1);
            }
        const float inv = 1.f / l;
        const bf16_t* gr = gate + row * DM + 768 + h * 64; bf16_t* orow = O + row * DM + 768 + h * 64;
#pragma unroll
        for (int half = 0; half < 2; ++half)
#pragma unroll
            for (int g = 0; g < 4; ++g) { const int d = 32 * half + 8 * g + 4 * hi; const uint2 gt = *(const uint2*)(gr + d);
                const f32x16& o = half ? o1 : o0;
                uint2 w; w.x = pack2(o[4 * g] * inv * __uint_as_float(gt.x << 16), o[4 * g + 1] * inv * __uint_as_float(gt.x & 0xffff0000u));
                w.y = pack2(o[4 * g + 2] * inv * __uint_as_float(gt.y << 16), o[4 * g + 3] * inv * __uint_as_float(gt.y & 0xffff0000u));
                *(uint2*)(orow + d) = w; }
    }
    __syncthreads();
}

__device__ __forceinline__ void p3_scan_and_sb(const Params& P, float* lds) {
    const int tid = threadIdx.x, lane = tid & 63, wave = tid >> 6;
    for (int task = blockIdx.x * 8 + wave; task < DB * RH * 16; task += gridDim.x * 8) {
        const int rg = task & 15, bh = task >> 4, b = bh / RH, h = bh % RH;
        scan_rows(P, NTOK + b, 1, h, rg * 4, P.state_wkv + (size_t)bh * HD * HD, P.out + OUT_WKV_S + (size_t)bh * HD * HD, lane);
    }
    if (blockIdx.x < 96) {
        const int bh = blockIdx.x >> 2, quarter = blockIdx.x & 3, b = bh / RH, h = bh % RH;
        volatile LAS unsigned* scw = (volatile LAS unsigned*)((LAS unsigned char*)lds + SC_CTL_OFF);
        if (tid < 5) scw[tid] = 0u;
        __syncthreads();
        scan_prompt_wave(P, (unsigned char*)lds, b, h, quarter);
        if (wave >= 5 + SC_FREE_WAVES) {
            constexpr unsigned NCHU = SEQ / SCH;
            while (scw[1] < NCHU || scw[2] < NCHU || scw[3] < NCHU || scw[4] < NCHU) __builtin_amdgcn_s_sleep(32);
        }
    } else {
        volatile LAS unsigned* qw = (volatile LAS unsigned*)((LAS unsigned char*)lds + LDS_CTL + 16);
        unsigned* qhead = (unsigned*)(P.ws + WS_BAR) + QW_SB;
        unsigned nxt = 0u;
        if (tid == 0) nxt = atomicAdd(qhead, 1u);
        for (;;) {
            if (tid == 0) qw[0] = nxt;
            __syncthreads();
            const unsigned u = qw[0];
            __syncthreads();
            if (u >= 384u) break;
            if (tid == 0) nxt = atomicAdd(qhead, 1u);
            const int qb = 15 - (int)(u / 24u), bh = (int)(u % 24u);
            sba::unit(P, (unsigned char*)lds, bh / SH, bh % SH, qb);
        }
    }
    sb_decode_wave_loop(P, lds);
    __syncthreads();
}

__device__ __forceinline__ void p4_combine(const Params& P, float* lds) {
    const int tid = threadIdx.x, lane = tid & 63, wave = tid >> 6;
    const float* oraw = (const float*)(P.ws + WS_ORAW); const float* RSB = (const float*)(P.ws + WS_RSB);
    const bf16_t* gate = (const bf16_t*)(P.ws + WS_GATE); bf16_t* O = (bf16_t*)(P.ws + WS_O);
    for (int it = blockIdx.x * 512 + tid; it < NTK * RH * 16; it += gridDim.x * 512) {
        const int c = it & 15, th = it >> 4, h = th % RH, tok = th / RH;
        const size_t o = (size_t)tok * RW + h * 64 + 4 * c;
        const float4 v = *(const float4*)(oraw + o);
        const float mean = sum16(v.x + v.y + v.z + v.w) * (1.f / 64.f);
        const float dx = v.x - mean, dy = v.y - mean, dz = v.z - mean, dw = v.w - mean;
        const float var = sum16(dx * dx + dy * dy + dz * dz + dw * dw) * (1.f / 64.f);
        const float rs = rsqrtf(var + GN_EPS);
        const float4 g = *(const float4*)(P.lnx_g + h * 64 + 4 * c), bb = *(const float4*)(P.lnx_b + h * 64 + 4 * c), vv = *(const float4*)(RSB + ((size_t)tok * RH + h) * RSB_BLK + 320 + 4 * c);
        const float rk = RSB[((size_t)tok * RH + h) * RSB_BLK + 386];
        const uint2 gt = *(const uint2*)(gate + (size_t)tok * DM + h * 64 + 4 * c);
        const float r0 = (dx * rs * g.x + bb.x + rk * vv.x) * __uint_as_float(gt.x << 16), r1 = (dy * rs * g.y + bb.y + rk * vv.y) * __uint_as_float(gt.x & 0xffff0000u);
        const float r2 = (dz * rs * g.z + bb.z + rk * vv.z) * __uint_as_float(gt.y << 16), r3 = (dw * rs * g.w + bb.w + rk * vv.w) * __uint_as_float(gt.y & 0xffff0000u);
        uint2 w; w.x = pack2(r0, r1); w.y = pack2(r2, r3);
        *(uint2*)(O + (size_t)tok * DM + h * 64 + 4 * c) = w;
    }
    const float* dpart = (const float*)(P.ws + WS_DPART); const float* dl = (const float*)(P.ws + WS_DL);
    float* coef = lds + wave * 128;
    for (int task = blockIdx.x * 8 + wave; task < DB * SH; task += gridDim.x * 8) {
        const int b = task / SH, h = task % SH;
        const float L0 = dl[(size_t)(b * NPAGES + 2 * lane) * SH + h], L1 = dl[(size_t)(b * NPAGES + 2 * lane + 1) * SH + h];
        float incl = L0 + L1;
#pragma unroll
        for (int off = 1; off < 64; off <<= 1) { const float t = __shfl_down(incl, off); if (lane + off < 64) incl += t; }
        const float excl = incl - (L0 + L1);
        coef[2 * lane] = exp2f(-(excl + L1)); coef[2 * lane + 1] = exp2f(-excl);
        asm volatile("s_waitcnt lgkmcnt(0)" ::: "memory");
        __builtin_amdgcn_wave_barrier();
        float o = 0.f;
#pragma unroll 16
        for (int j = 0; j < NPAGES; ++j) o += coef[j] * dpart[((size_t)(b * NPAGES + j) * SH + h) * HD + lane];
        const size_t row = NTOK + b;
        O[row * DM + 384 + h * 64 + lane] = f2bf(o * bf2f(gate[row * DM + 384 + h * 64 + lane]));
        __builtin_amdgcn_wave_barrier();
    }
    for (int i = blockIdx.x * 512 + tid; i < (ROWS_P - NTK) * DM / 4; i += gridDim.x * 512) *(uint2*)(O + (size_t)NTK * DM + (size_t)i * 4) = make_uint2(0u, 0u);
}

__device__ __forceinline__ void p5_sample_out(const Params& P) {
    const int tid = threadIdx.x, row = tid >> 4, kq = tid & 15;
    const bf16_t* O = (const bf16_t*)(P.ws + WS_O) + (size_t)(NTOK + row) * DM + kq * 64;
    const bf16_t* Bt2 = (const bf16_t*)(P.ws + WS_BT2);
    float* yun = (float*)(P.ws + WS_YUN);
    for (int cb = blockIdx.x; cb < DM / 4; cb += gridDim.x) {
        float acc[4] = {0.f, 0.f, 0.f, 0.f};
#pragma unroll
        for (int k8 = 0; k8 < 8; ++k8) {
            const uint4 ov = *(const uint4*)(O + k8 * 8); const unsigned oo[4] = {ov.x, ov.y, ov.z, ov.w};
#pragma unroll
            for (int c = 0; c < 4; ++c) { const uint4 wv = *(const uint4*)(Bt2 + (size_t)(cb * 4 + c) * DM + kq * 64 + k8 * 8); const unsigned ww[4] = {wv.x, wv.y, wv.z, wv.w};
#pragma unroll
                for (int j = 0; j < 4; ++j) acc[c] += __uint_as_float(oo[j] << 16) * __uint_as_float(ww[j] << 16) + __uint_as_float(oo[j] & 0xffff0000u) * __uint_as_float(ww[j] & 0xffff0000u); }
        }
#pragma unroll
        for (int c = 0; c < 4; ++c) acc[c] = sum16(acc[c]);
        if (kq == 0) { const size_t o = (size_t)(NTOK + row) * DM + cb * 4; const float4 xv = *(const float4*)(P.x_sample + (size_t)row * DM + cb * 4);
            *(float4*)(yun + o) = make_float4(xv.x + acc[0], xv.y + acc[1], xv.z + acc[2], xv.w + acc[3]); }
    }
}

__device__ __forceinline__ void p6_final_norm(const Params& P) {
    const int tid = threadIdx.x, lane = tid & 63, wave = tid >> 6;
    const float* yun = (const float*)(P.ws + WS_YUN);
    const int gw = blockIdx.x * 8 + wave, nw = gridDim.x * 8;
    for (int r0 = gw; r0 < NTK; r0 += 2 * nw) {
        float4 x[2][4]; float ss[2] = {0.f, 0.f}; bool live[2]; float* dsts[2];
#pragma unroll
        for (int q = 0; q < 2; ++q) { const int r = r0 + q * nw; live[q] = r < NTK; const int rr = live[q] ? r : 0;
            dsts[q] = rr < NTOK ? P.out + OUT_Y_P + (size_t)rr * DM : P.out + OUT_Y_S + (size_t)(rr - NTOK) * DM;
#pragma unroll
            for (int j = 0; j < 4; ++j) x[q][j] = *(const float4*)(yun + (size_t)rr * DM + 4 * lane + 256 * j); }
#pragma unroll
        for (int q = 0; q < 2; ++q) {
#pragma unroll
            for (int j = 0; j < 4; ++j) ss[q] += x[q][j].x * x[q][j].x + x[q][j].y * x[q][j].y + x[q][j].z * x[q][j].z + x[q][j].w * x[q][j].w;
            ss[q] = wave_sum_fast(ss[q]); }
#pragma unroll
        for (int q = 0; q < 2; ++q) { if (!live[q]) continue;
            const float rs = rsqrtf(ss[q] * (1.f / DM) + NORM_EPS);
#pragma unroll
            for (int j = 0; j < 4; ++j) { const float4 gg = *(const float4*)(P.final_norm_g + 4 * lane + 256 * j);
                *(float4*)(dsts[q] + 4 * lane + 256 * j) = make_float4(x[q][j].x * rs * gg.x, x[q][j].y * rs * gg.y, x[q][j].z * rs * gg.z, x[q][j].w * rs * gg.w); } }
    }
}

constexpr int NPHASE = 7;
__global__ void __launch_bounds__(512, 2) mk_fwd(Params P) {
    extern __shared__ __attribute__((aligned(16))) unsigned char lds[];
    volatile LAS unsigned* xbw = (volatile LAS unsigned*)((LAS unsigned char*)lds + LDS_CTL);
    if (threadIdx.x < 4) xbw[threadIdx.x] = 0u;
    __syncthreads();
    XcdBarrier bar; bar.bar = (unsigned*)(P.ws + WS_BAR); bar.x = 0; bar.st = xbw;
#if MK_N_LAUNCHES == 1
    bar = xcd_barrier_post((unsigned*)(P.ws + WS_BAR), xbw);
#endif
    const int lo = P.ph_lo, hi = P.ph_hi;
#define IN(k) (lo <= (k) && (k) < hi)
#define SEAM(k) do { if (IN(k) && IN((k) + 1)) xcd_barrier(bar); } while (0)
    float* ldsf = (float*)lds;
    if (IN(0)) { for (int rep = 0; rep < NREP(0); ++rep) p0_prologue(P, ldsf); }
    SEAM(0);
    if (IN(1)) {
        pg8::Gemm g{(const bf16_t*)(P.ws + WS_A1), (const bf16_t*)(P.ws + WS_BT1), MROWS1, NB1, DM};
        pg8::GridOrder S; S.init(65, 15, 8, 65, 15, 2, (int)gridDim.x, (int)((blockIdx.x % 8) * (gridDim.x / 8) + blockIdx.x / 8));
        EpiG1 E{(bf16_t*)(P.ws + WS_PRW), (bf16_t*)(P.ws + WS_QB), (bf16_t*)(P.ws + WS_KB), (bf16_t*)(P.ws + WS_VB), (bf16_t*)(P.ws + WS_XQ), (bf16_t*)(P.ws + WS_GATE), P.out};
        for (int rep = 0; rep < NREP(1); ++rep) pg8::gemm_phase<EpiG1, pg8::GridOrder>((PG8_LAS unsigned char*)lds, g, S, E);
    }
    SEAM(1);
    if (IN(2)) {
        for (int rep = 0; rep < NREP(20); ++rep) p2_rwkv_prep(P, ldsf);
        for (int rep = 0; rep < NREP(21); ++rep) p2_xattn_prompt(P, lds);
        for (int rep = 0; rep < NREP(22); ++rep) p2_xattn_sample(P, ldsf);
    }
    SEAM(2);
    if (IN(3)) { p3_scan_and_sb(P, ldsf); }
    SEAM(3);
    if (IN(4)) { for (int rep = 0; rep < NREP(4); ++rep) p4_combine(P, ldsf); }
    SEAM(4);
    if (IN(5)) {
        pg8::Gemm g{(const bf16_t*)(P.ws + WS_O), (const bf16_t*)(P.ws + WS_BT2), NTOK, DM, DM};
        pg8::GridOrder S; S.init(64, 4, 0, 0, 0, 1, (int)gridDim.x, (int)((blockIdx.x % 8) * (gridDim.x / 8) + blockIdx.x / 8));
        EpiG2 E{P.x_prompt, P.x_sample, (float*)(P.ws + WS_YUN)};
        for (int rep = 0; rep < NREP(5); ++rep) pg8::gemm_phase<EpiG2, pg8::GridOrder>((PG8_LAS unsigned char*)lds, g, S, E);
        p5_sample_out(P);
    }
    SEAM(5);
    if (IN(6)) { for (int rep = 0; rep < NREP(6); ++rep) p6_final_norm(P); }
#undef IN
#undef SEAM
}

extern "C" void kernel_launch(void* const* d_in, const int* in_sizes, int n_in, void* d_out, int out_size, void* d_ws, size_t ws_size, hipStream_t stream) {
    static int grid = 0;
    if (grid == 0) {
        if (n_in != 28 || (size_t)out_size != OUT_END || ws_size < WS_END) { fprintf(stderr, "kernel_launch: unexpected shapes: n_in %d out %d (want %zu) ws %zu (want %zu)\n", n_in, out_size, (size_t)OUT_END, ws_size, (size_t)WS_END); grid = -1; return; }
        int dev = 0, cus = 0, per_cu = 0;
        if (hipGetDevice(&dev) != hipSuccess || hipDeviceGetAttribute(&cus, hipDeviceAttributeMultiprocessorCount, dev) != hipSuccess) { grid = -1; return; }
        if (hipFuncSetAttribute((const void*)mk_fwd, hipFuncAttributeMaxDynamicSharedMemorySize, LDS_BYTES) != hipSuccess) { fprintf(stderr, "kernel_launch: hipFuncSetAttribute failed\n"); grid = -1; return; }
        if (hipOccupancyMaxActiveBlocksPerMultiprocessor(&per_cu, (const void*)mk_fwd, 512, LDS_BYTES) != hipSuccess || per_cu < 1) fprintf(stderr, "kernel_launch: occupancy query says %d\n", per_cu);
        (void)hipGetLastError();
        grid = cus;
        if (grid % 8 != 0) grid -= grid % 8;
    }
    if (grid < 0) return;
    (void)hipMemsetAsync((char*)d_ws + WS_BAR, 0, 16384, stream);
    Params P{};
    P.x_prompt = (const float*)d_in[0]; P.mem_prompt = (const float*)d_in[1]; P.x_sample = (const float*)d_in[2]; P.cache_k = (const float*)d_in[3]; P.cache_v = (const float*)d_in[4];
    P.page_table = (const int*)d_in[5]; P.state_wkv = (const float*)d_in[6]; P.state_shift = (const float*)d_in[7]; P.cmem_k = (const float*)d_in[8]; P.cmem_v = (const float*)d_in[9];
    P.norm_g = (const float*)d_in[10]; P.w_in = (const float*)d_in[11]; P.sb_bias = (const float*)d_in[12]; P.mu_shift = (const float*)d_in[13]; P.w0 = (const float*)d_in[14];
    P.w_lora_b = (const float*)d_in[15]; P.a0 = (const float*)d_in[16]; P.a_lora_b = (const float*)d_in[17]; P.k_k = (const float*)d_in[18]; P.k_a = (const float*)d_in[19]; P.r_k = (const float*)d_in[20];
    P.lnx_g = (const float*)d_in[21]; P.lnx_b = (const float*)d_in[22]; P.mem_norm_g = (const float*)d_in[23]; P.w_mem_k = (const float*)d_in[24]; P.w_mem_v = (const float*)d_in[25];
    P.w_out = (const float*)d_in[26]; P.final_norm_g = (const float*)d_in[27];
    P.out = (float*)d_out; P.ws = (unsigned char*)d_ws;
#if MK_N_LAUNCHES == 1
    P.ph_lo = 0; P.ph_hi = NPHASE;
    hipLaunchKernelGGL(mk_fwd, dim3(grid), dim3(512), LDS_BYTES, stream, P);
#else
    for (int ph = 0; ph < NPHASE; ++ph) { P.ph_lo = ph; P.ph_hi = ph + 1; hipLaunchKernelGGL(mk_fwd, dim3(grid), dim3(512), LDS_BYTES, stream, P); }
#endif
    const hipError_t le = hipPeekAtLastError();
    if (le != hipSuccess) fprintf(stderr, "kernel_launch: launch failed: %s\n", hipGetErrorName(le));
}
```

```cpp
#include <hip/hip_runtime.h>
#include <cstdio>
#include <cstdint>

#ifndef MK_REP
#define MK_REP -1
#endif
#define NREP(id) ((MK_REP) == (id) ? 2 : 1)
#ifndef MK_N_LAUNCHES
#define MK_N_LAUNCHES 1
#endif

constexpr int DM = 1024, NB = 4, SEQ = 4096, NTOK = NB * SEQ, DB = 32, NPAGES = 128, PAGE = 128;
constexpr int HD = 64, RH = 6, SH = 6, XH = 4, NMEM = 256;
constexpr int RW = 384, SBW = 384, XW = 256, RCOLS = 1280, DIN = 3712;
constexpr int NTK = NTOK + DB;
constexpr int ROWS_P = 16640;
constexpr int MEMROW0 = 16640;
constexpr int MROWS1 = 17664;
constexpr int NB1 = 4352;
constexpr float LOG2E = 1.4426950408889634f, QSCALE = 0.125f * 1.4426950408889634f;
constexpr float NORM_EPS = 1e-6f, GN_EPS = 64e-5f, DECAY_SCALE = 0.60653065971263342f;

constexpr size_t OUT_Y_P = 0;
constexpr size_t OUT_Y_S = OUT_Y_P + (size_t)NTOK * DM;
constexpr size_t OUT_SBK_P = OUT_Y_S + (size_t)DB * DM;
constexpr size_t OUT_SBV_P = OUT_SBK_P + (size_t)NTOK * SBW;
constexpr size_t OUT_WKV_P = OUT_SBV_P + (size_t)NTOK * SBW;
constexpr size_t OUT_SHIFT_P = OUT_WKV_P + (size_t)NB * RH * HD * HD;
constexpr size_t OUT_MK_P = OUT_SHIFT_P + (size_t)NB * RCOLS;
constexpr size_t OUT_MV_P = OUT_MK_P + (size_t)NB * NMEM * XW;
constexpr size_t OUT_SBK_S = OUT_MV_P + (size_t)NB * NMEM * XW;
constexpr size_t OUT_SBV_S = OUT_SBK_S + (size_t)DB * SBW;
constexpr size_t OUT_WKV_S = OUT_SBV_S + (size_t)DB * SBW;
constexpr size_t OUT_SHIFT_S = OUT_WKV_S + (size_t)DB * RH * HD * HD;
constexpr size_t OUT_END = OUT_SHIFT_S + (size_t)DB * RCOLS;

constexpr size_t al256(size_t x) { return (x + 255) & ~(size_t)255; }
constexpr size_t WS_BAR = 0;
constexpr size_t WS_A1 = 16384;
constexpr size_t WS_BT1 = WS_A1 + al256((size_t)MROWS1 * DM * 2);
constexpr size_t WS_BT2 = WS_BT1 + al256((size_t)NB1 * DM * 2);
constexpr size_t WS_PRW = WS_BT2 + al256((size_t)DM * DM * 2);
constexpr size_t WS_QB = WS_PRW + al256((size_t)ROWS_P * RCOLS * 2);
constexpr size_t WS_KB = WS_QB + al256((size_t)ROWS_P * SBW * 2);
constexpr size_t WS_VB = WS_KB + al256((size_t)ROWS_P * SBW * 2);
constexpr size_t WS_XQ = WS_VB + al256((size_t)ROWS_P * SBW * 2);
constexpr size_t WS_GATE = WS_XQ + al256((size_t)ROWS_P * XW * 2);
constexpr int RSB_BLK = 388;
constexpr size_t WS_RSB = WS_GATE + al256((size_t)ROWS_P * DM * 2);
constexpr size_t WS_ORAW = WS_RSB + al256((size_t)NTK * RH * RSB_BLK * 4);
constexpr size_t WS_O = WS_ORAW + al256((size_t)NTK * RW * 4);
constexpr size_t WS_YUN = WS_O + al256((size_t)ROWS_P * DM * 2);
constexpr size_t WS_DPART = WS_YUN + al256((size_t)ROWS_P * DM * 4);
constexpr size_t WS_DL = WS_DPART + al256((size_t)DB * NPAGES * SH * HD * 4);
constexpr size_t WS_LFRAG = WS_DL + al256((size_t)DB * NPAGES * SH * 4);
constexpr size_t WS_END = WS_LFRAG + al256((size_t)2 * 2 * 6 * 4 * 2 * 64 * 16);

constexpr int LDS_STAGE = 131072;
constexpr int LDS_CTL = 155648;
constexpr int LDS_BYTES = LDS_CTL + 1024;

typedef unsigned short bf16_t;

#define XB_TMO      128
#define XB_XCNT(j)  (256  + 64 * (j))
#define XB_XSUB(j)  (1280 + 64 * (j))
#define XB_XGEN(j)  (2304 + 64 * (j))
#define XB_TOP      3328
#define XB_TOPGEN   3392
#define XCD_BAR_WORDS 3456
#define XB_SPIN_CAP (1u << 18)
#define LAS __attribute__((address_space(3)))

__device__ __forceinline__ unsigned xb_ld(unsigned* p)              { return __hip_atomic_load(p, __ATOMIC_RELAXED, __HIP_MEMORY_SCOPE_AGENT); }
__device__ __forceinline__ unsigned xb_add(unsigned* p, unsigned v) { return __hip_atomic_fetch_add(p, v, __ATOMIC_RELAXED, __HIP_MEMORY_SCOPE_AGENT); }
__device__ __forceinline__ unsigned xb_xcc_id() { return (unsigned)__builtin_amdgcn_s_getreg((3 << 11) | 20) & 0xFu; }
#define XB_SPIN(cond, bar) do { unsigned _sp = 0; while (cond) { __builtin_amdgcn_s_sleep(1); \
    if ((++_sp & 255u) == 0u) { if (xb_ld(&(bar)[XB_TMO])) break; if (_sp > XB_SPIN_CAP) { atomicAdd(&(bar)[XB_TMO], 1u); break; } } } } while (0)

struct XcdBarrier {
    unsigned* bar; unsigned x;
    volatile LAS unsigned* st;
};
__device__ __forceinline__ XcdBarrier xcd_barrier_post(unsigned* bar, volatile LAS unsigned* st) {
    XcdBarrier b; b.bar = bar; b.x = xb_xcc_id(); b.st = st;
    if (threadIdx.x == 0) (void)xb_add(&bar[XB_XCNT(b.x)], 1u);
    return b;
}
__device__ __forceinline__ void xcd_barrier_complete(unsigned* bar, unsigned x, unsigned& nloc, unsigned& nx) {
    const unsigned G = gridDim.x * gridDim.y * gridDim.z;
    unsigned sum, cnt, mine, sp = 0u;
    for (;;) {
        sum = 0u; cnt = 0u; mine = 0u;
#pragma unroll
        for (unsigned j = 0; j < 16; ++j) { const unsigned c = xb_ld(&bar[XB_XCNT(j)]); sum += c; cnt += (c > 0u) ? 1u : 0u; mine = (j == x) ? c : mine; }
        if (sum == G) break;
        __builtin_amdgcn_s_sleep(1);
        if ((++sp & 255u) == 0u) { if (xb_ld(&bar[XB_TMO])) break; if (sp > XB_SPIN_CAP) { atomicAdd(&bar[XB_TMO], 1u); break; } }
    }
    nloc = mine > 0u ? mine : 1u; nx = cnt > 0u ? cnt : 1u;
}
__device__ __forceinline__ void xcd_barrier(const XcdBarrier& b) {
    asm volatile("s_waitcnt vmcnt(0)" ::: "memory");
    __syncthreads();
    if (threadIdx.x == 0) {
        unsigned* bar = b.bar;
        __builtin_amdgcn_s_waitcnt(0);
        unsigned nloc = b.st[0], nx = b.st[1];
        if (nloc == 0u) { xcd_barrier_complete(bar, b.x, nloc, nx); b.st[0] = nloc; b.st[1] = nx; }
        const unsigned old = xb_add(&bar[XB_XSUB(b.x)], 1u);
        const unsigned gen = old / nloc;
        if (old + 1u == (gen + 1u) * nloc) {
            __builtin_amdgcn_fence(__ATOMIC_RELEASE, "agent");
            asm volatile("s_waitcnt vmcnt(0)" ::: "memory");
            const unsigned og = xb_add(&bar[XB_TOP], 1u);
            const unsigned tg = og / nx;
            if (og + 1u == (tg + 1u) * nx) xb_add(&bar[XB_TOPGEN], 1u);
            else XB_SPIN(xb_ld(&bar[XB_TOPGEN]) == tg, bar);
            __builtin_amdgcn_fence(__ATOMIC_ACQUIRE, "agent");
            xb_add(&bar[XB_XGEN(b.x)], 1u);
            asm volatile("s_waitcnt vmcnt(0)" ::: "memory");
        } else {
            XB_SPIN(xb_ld(&bar[XB_XGEN(b.x)]) == gen, bar);
            __builtin_amdgcn_fence(__ATOMIC_ACQUIRE, "agent");
            asm volatile("s_waitcnt vmcnt(0)" ::: "memory");
        }
    }
    __syncthreads();
}

namespace pg8 {
#define PG8_LAS __attribute__((address_space(3)))
typedef short bf16x8 __attribute__((ext_vector_type(8)));
typedef float f32x4 __attribute__((ext_vector_type(4)));
typedef unsigned u32x4 __attribute__((ext_vector_type(4)));
constexpr int BM = 256, BK = 64, HALF = 128, HTB = HALF * BK * 2, STAGE_BYTES = 8 * HTB, NXCD = 8, WGM = 8;

__host__ __device__ __forceinline__ int lds_byte(int r, int c) { const int st = (r >> 4) * 2 + (c >> 5), rr = r & 15, cc = c & 31, ob = rr * 64 + cc * 2; return st * 1024 + (ob ^ (((ob >> 9) & 1) << 5)); }
__host__ __device__ __forceinline__ void stage_rc(int b, int& R, int& C) { const int st = b / 1024, sb = b % 1024, swz = sb ^ (((sb >> 9) & 1) << 5); R = (st >> 1) * 16 + swz / 64; C = (st & 1) * 32 + (swz % 64) / 2; }
__host__ __device__ __forceinline__ int perm32(int rho) { const int n = rho >> 4, i = rho & 15; return 8 * (i >> 2) + 4 * n + (i & 3); }

struct Unit { int pm, pn; };
struct Gemm { const bf16_t* A; const bf16_t* Bt; int M, N, K; };

struct GridOrder {
    int nM, nN, nmain, nextra, xm0, xn0, xnn, G, c;
    __device__ void init(int nM_, int nN_, int nextra_, int xm0_, int xn0_, int xnn_, int G_, int c_) { nM = nM_; nN = nN_; nmain = nM_ * nN_; nextra = nextra_; xm0 = xm0_; xn0 = xn0_; xnn = xnn_; G = G_; c = c_; }
    __device__ bool next(int i, Unit& u) const {
        const int L = i * G + c; if (L >= nmain + nextra) return false;
        if (L >= nmain) { const int e = L - nmain; u.pm = xm0 + e / xnn; u.pn = xn0 + e % xnn; return true; }
        const int wgid = L;
        const int nig = WGM * nN, gid = wgid / nig, fm = gid * WGM, gsz = (nM - fm) < WGM ? (nM - fm) : WGM;
        u.pm = fm + ((wgid % nig) % gsz); u.pn = (wgid % nig) / gsz; return true;
    }
    __device__ __forceinline__ void a_ready(const Unit&) const {}
    __device__ __forceinline__ void done(const Unit&) const {}
};

template <class Epi, class Sched>
__device__ __forceinline__ void gemm_phase(PG8_LAS unsigned char* lds, const Gemm g, const Sched& S, const Epi& E) {
    const int tid = threadIdx.x, wid = __builtin_amdgcn_readfirstlane(tid >> 6), lane = tid & 63, wr = wid >> 2, wc = wid & 3, fr = lane & 15, fq = lane >> 4;
    const int K = g.K, nt = K / BK;
    unsigned voffA[2], voffB[2];
#pragma unroll
    for (int i = 0; i < 2; ++i) { int R, C; stage_rc(tid * 16 + i * 8192, R, C); const int Rb = Epi::PERM ? ((R & ~31) + perm32(R & 31)) : R;
        voffA[i] = (unsigned)(R * K + C) * 2u; voffB[i] = (unsigned)(Rb * K + C) * 2u; }
    const size_t kstep = (size_t)(BK * 2);
    const size_t hstep = (size_t)HALF * K * 2;
    const size_t tstep = 2 * hstep;
    const unsigned ldsw = (unsigned)wid * 1024u;
    const int aoff = lds_byte(wr * 64 + fr, fq * 8), boff = lds_byte(wc * 32 + fr, fq * 8);
#define PG8_SA(b, h) (((b) * 2 + (h)) * HTB)
#define PG8_SB(b, h) ((4 + (b) * 2 + (h)) * HTB)
#define PG8_STAGE(bufoff, gbase, voff) do { _Pragma("unroll") for (int _i = 0; _i < 2; ++_i) \
        __builtin_amdgcn_global_load_lds((const unsigned*)((const char*)(gbase) + (voff)[_i]), (PG8_LAS unsigned*)(lds + (bufoff) + ldsw + _i * 8192), 16, 0, 0); } while (0)
#define PG8_LDA(dst, b, h) do { _Pragma("unroll") for (int m = 0; m < 4; ++m) _Pragma("unroll") for (int k = 0; k < 2; ++k) dst[m][k] = *(const PG8_LAS bf16x8*)(lds + PG8_SA(b, h) + aoff + m * 2048 + k * 1024); } while (0)
#define PG8_LDB(dst, b, h) do { _Pragma("unroll") for (int n = 0; n < 2; ++n) _Pragma("unroll") for (int k = 0; k < 2; ++k) dst[n][k] = *(const PG8_LAS bf16x8*)(lds + PG8_SB(b, h) + boff + n * 2048 + k * 1024); } while (0)
#define PG8_MMA(ai, bj, At, Bt) do { __builtin_amdgcn_s_setprio(1); _Pragma("unroll") for (int m = 0; m < 4; ++m) _Pragma("unroll") for (int n = 0; n < 2; ++n) _Pragma("unroll") for (int k = 0; k < 2; ++k) \
        acc[ai][bj][m][n] = __builtin_amdgcn_mfma_f32_16x16x32_bf16(Bt[n][k], At[m][k], acc[ai][bj][m][n], 0, 0, 0); __builtin_amdgcn_s_setprio(0); } while (0)
#define PG8_WAIT_V(n) asm volatile("s_waitcnt vmcnt(" #n ")" ::: "memory")
#define PG8_WAIT_L(n) asm volatile("s_waitcnt lgkmcnt(" #n ")" ::: "memory")
#define PG8_BAR __builtin_amdgcn_s_barrier()
#define PG8_SCHED __builtin_amdgcn_sched_barrier(0)
    Unit cur, nxt; int ui = 0;
    if (!S.next(0, cur)) return;
    f32x4 acc[2][2][4][2];
#pragma unroll
    for (int a = 0; a < 2; ++a)
#pragma unroll
        for (int b = 0; b < 2; ++b)
#pragma unroll
            for (int m = 0; m < 4; ++m)
#pragma unroll
                for (int n = 0; n < 2; ++n) acc[a][b][m][n] = (f32x4){0.f, 0.f, 0.f, 0.f};
    bf16x8 At[4][2], B0[2][2], B1[2][2];
    const char* cA = (const char*)g.A + (size_t)cur.pm * tstep; const char* cB = (const char*)g.Bt + (size_t)cur.pn * tstep;
    S.a_ready(cur);
    PG8_STAGE(PG8_SB(0, 0), cB, voffB); PG8_STAGE(PG8_SA(0, 0), cA, voffA); PG8_STAGE(PG8_SB(0, 1), cB + hstep, voffB); PG8_STAGE(PG8_SA(0, 1), cA + hstep, voffA);
    if (wr == 1) PG8_BAR;
    PG8_WAIT_V(4); PG8_BAR;
    PG8_STAGE(PG8_SB(1, 0), cB + kstep, voffB); PG8_STAGE(PG8_SA(1, 0), cA + kstep, voffA); PG8_STAGE(PG8_SB(1, 1), cB + hstep + kstep, voffB);
    PG8_WAIT_V(6); PG8_BAR;
    for (;;) {
        const bool has_next = S.next(ui + 1, nxt);
        const char* nA = has_next ? (const char*)g.A + (size_t)nxt.pm * tstep : cA; const char* nB = has_next ? (const char*)g.Bt + (size_t)nxt.pn * tstep : cB;
        for (int t = 0; t < nt; t += 2) {
            const bool last = (t == nt - 2);
            const char* a1 = cA + (size_t)(t + 1) * kstep;
            const char* a2 = last ? nA : cA + (size_t)(t + 2) * kstep; const char* b2 = last ? nB : cB + (size_t)(t + 2) * kstep;
            const char* a3 = a2 + kstep; const char* b3 = b2 + kstep;
            if (last && has_next) S.a_ready(nxt);
            PG8_LDB(B0, 0, 0); PG8_SCHED; PG8_LDA(At, 0, 0); PG8_STAGE(PG8_SA(1, 1), a1 + hstep, voffA);
            PG8_WAIT_L(8); PG8_BAR; PG8_WAIT_L(0); PG8_MMA(0, 0, At, B0); PG8_BAR; PG8_SCHED;
            PG8_LDB(B1, 0, 1); PG8_STAGE(PG8_SB(0, 0), b2, voffB);
            PG8_BAR; PG8_WAIT_L(0); PG8_MMA(0, 1, At, B1); PG8_BAR;
            PG8_LDA(At, 0, 1); PG8_STAGE(PG8_SA(0, 0), a2, voffA);
            PG8_BAR; PG8_WAIT_L(0); PG8_MMA(1, 0, At, B0); PG8_BAR; PG8_SCHED;
            PG8_STAGE(PG8_SB(0, 1), b2 + hstep, voffB);
            PG8_WAIT_V(6); PG8_BAR; PG8_MMA(1, 1, At, B1); PG8_BAR;
            PG8_LDB(B0, 1, 0); PG8_SCHED; PG8_LDA(At, 1, 0); PG8_STAGE(PG8_SA(0, 1), a2 + hstep, voffA);
            PG8_WAIT_L(8); PG8_BAR; PG8_WAIT_L(0); PG8_MMA(0, 0, At, B0); PG8_BAR; PG8_SCHED;
            PG8_LDB(B1, 1, 1); PG8_STAGE(PG8_SB(1, 0), b3, voffB);
            PG8_BAR; PG8_WAIT_L(0); PG8_MMA(0, 1, At, B1); PG8_BAR;
            PG8_LDA(At, 1, 1); PG8_STAGE(PG8_SA(1, 0), a3, voffA);
            PG8_BAR; PG8_WAIT_L(0); PG8_MMA(1, 0, At, B0); PG8_BAR; PG8_SCHED;
            PG8_STAGE(PG8_SB(1, 1), b3 + hstep, voffB);
            PG8_WAIT_V(6); PG8_BAR; PG8_MMA(1, 1, At, B1); PG8_BAR;
        }
        E(acc, cur, wr, wc, fr, fq); S.done(cur);
        if (!has_next) break;
#pragma unroll
        for (int a = 0; a < 2; ++a)
#pragma unroll
            for (int b = 0; b < 2; ++b)
#pragma unroll
                for (int m = 0; m < 4; ++m)
#pragma unroll
                    for (int n = 0; n < 2; ++n) acc[a][b][m][n] = (f32x4){0.f, 0.f, 0.f, 0.f};
        cur = nxt; cA = nA; cB = nB; ++ui;
    }
    PG8_WAIT_V(0);
    if (wr == 0) PG8_BAR;
    PG8_BAR;
#undef PG8_SA
#undef PG8_SB
#undef PG8_STAGE
#undef PG8_LDA
#undef PG8_LDB
#undef PG8_MMA
#undef PG8_WAIT_V
#undef PG8_WAIT_L
#undef PG8_BAR
#undef PG8_SCHED
}
}

typedef float f32x4 __attribute__((ext_vector_type(4)));
__device__ __forceinline__ float bf2f(bf16_t b) { return __uint_as_float(((unsigned)b) << 16); }
__device__ __forceinline__ bf16_t f2bf(float f) { unsigned u = __float_as_uint(f); u += 0x7FFFu + ((u >> 16) & 1u); return (bf16_t)(u >> 16); }
typedef __bf16 bf16x2_t __attribute__((ext_vector_type(2)));
typedef float f32x2_t __attribute__((ext_vector_type(2)));
__device__ __forceinline__ unsigned pack2(float lo, float hi) { const f32x2_t v = {lo, hi}; return __builtin_bit_cast(unsigned, __builtin_convertvector(v, bf16x2_t)); }
__device__ __forceinline__ float wave_sum(float v) {
#pragma unroll
    for (int o = 32; o >= 1; o >>= 1) v += __shfl_xor(v, o);
    return v;
}
__device__ __forceinline__ float wave_max(float v) {
#pragma unroll
    for (int o = 32; o >= 1; o >>= 1) v = fmaxf(v, __shfl_xor(v, o));
    return v;
}
template <int CTRL> __device__ __forceinline__ float dpp_f(float x) { return __builtin_bit_cast(float, __builtin_amdgcn_update_dpp(0, __builtin_bit_cast(int, x), CTRL, 0xF, 0xF, true)); }
__device__ __forceinline__ float sum16(float v) {
    v += dpp_f<0xB1>(v);
    v += dpp_f<0x4E>(v);
    v += dpp_f<0x124>(v);
    v += dpp_f<0x128>(v);
    return v;
}
__device__ __forceinline__ float wave_sum_fast(float v) {
    v = sum16(v);
    { const auto s = __builtin_amdgcn_permlane16_swap(__float_as_uint(v), __float_as_uint(v), false, false); v = __uint_as_float(s[0]) + __uint_as_float(s[1]); }
    { const auto s = __builtin_amdgcn_permlane32_swap(__float_as_uint(v), __float_as_uint(v), false, false); v = __uint_as_float(s[0]) + __uint_as_float(s[1]); }
    return v;
}
__device__ __forceinline__ float sigmoidf_(float x) { return 1.f / (1.f + __expf(-x)); }
__device__ __forceinline__ float softplusf_(float z) { return fmaxf(z, 0.f) + log1pf(__expf(-fabsf(z))); }
__device__ __forceinline__ float softplus2_(float z2) { return fmaxf(z2, 0.f) + log1pf(exp2f(-fabsf(z2))) * LOG2E; }

struct Params {
    const float *x_prompt, *mem_prompt, *x_sample, *cache_k, *cache_v; const int* page_table;
    const float *state_wkv, *state_shift, *cmem_k, *cmem_v, *norm_g, *w_in, *sb_bias, *mu_shift, *w0, *w_lora_b, *a0, *a_lora_b, *k_k, *k_a, *r_k,
        *lnx_g, *lnx_b, *mem_norm_g, *w_mem_k, *w_mem_v, *w_out, *final_norm_g;
    float* out; unsigned char* ws;
    int ph_lo, ph_hi;
};

struct EpiG1 {
    static constexpr bool PERM = true;
    bf16_t* prw; bf16_t *qb, *kb, *vb, *xq, *gate; float* out;
    __device__ __forceinline__ void operator()(const pg8::f32x4 (&acc)[2][2][4][2], const pg8::Unit& u, int wr, int wc, int fr, int fq) const {
        if (u.pm >= 65) {
            float* dst = out + (u.pn == 15 ? OUT_MK_P : OUT_MV_P);
#pragma unroll
            for (int ai = 0; ai < 2; ++ai)
#pragma unroll
                for (int m = 0; m < 4; ++m) { const int row = (u.pm - 65) * 256 + ai * 128 + wr * 64 + m * 16 + fr;
#pragma unroll
                    for (int bj = 0; bj < 2; ++bj) { const int col = bj * 128 + wc * 32 + 8 * fq;
                        *(pg8::f32x4*)(dst + (size_t)row * 256 + col) = acc[ai][bj][m][0]; *(pg8::f32x4*)(dst + (size_t)row * 256 + col + 4) = acc[ai][bj][m][1]; } }
            return;
        }
#pragma unroll
        for (int bj = 0; bj < 2; ++bj) {
            const int cb = u.pn * 256 + bj * 128;
            if (cb >= DIN) continue;
#pragma unroll
            for (int ai = 0; ai < 2; ++ai)
#pragma unroll
                for (int m = 0; m < 4; ++m) { const int row = u.pm * 256 + ai * 128 + wr * 64 + m * 16 + fr;
                    if (row >= NTK) continue;
                    const int col = cb + wc * 32 + 8 * fq; const pg8::f32x4 v0 = acc[ai][bj][m][0], v1 = acc[ai][bj][m][1];
                    if (cb < 1280) {
                        *(uint4*)(prw + (size_t)row * RCOLS + col) = make_uint4(pack2(v0[0], v0[1]), pack2(v0[2], v0[3]), pack2(v1[0], v1[1]), pack2(v1[2], v1[3]));
                        if (row >= NTOK) { float* e = out + OUT_SHIFT_S + (size_t)(row - NTOK) * RCOLS + col; *(pg8::f32x4*)e = v0; *(pg8::f32x4*)(e + 4) = v1; }
                        else if ((row & (SEQ - 1)) == SEQ - 1) { float* e = out + OUT_SHIFT_P + (size_t)(row >> 12) * RCOLS + col; *(pg8::f32x4*)e = v0; *(pg8::f32x4*)(e + 4) = v1; }
                    } else if (cb < 1664) {
                        *(uint4*)(qb + (size_t)row * SBW + (col - 1280)) = make_uint4(pack2(v0[0] * QSCALE, v0[1] * QSCALE), pack2(v0[2] * QSCALE, v0[3] * QSCALE), pack2(v1[0] * QSCALE, v1[1] * QSCALE), pack2(v1[2] * QSCALE, v1[3] * QSCALE));
                    } else if (cb < 2048) {
                        const int c2 = col - 1664;
                        *(uint4*)(kb + (size_t)row * SBW + c2) = make_uint4(pack2(v0[0], v0[1]), pack2(v0[2], v0[3]), pack2(v1[0], v1[1]), pack2(v1[2], v1[3]));
                        float* e = row < NTOK ? out + OUT_SBK_P + (size_t)row * SBW + c2 : out + OUT_SBK_S + (size_t)(row - NTOK) * SBW + c2; *(pg8::f32x4*)e = v0; *(pg8::f32x4*)(e + 4) = v1;
                    } else if (cb < 2432) {
                        const int c2 = col - 2048;
                        *(uint4*)(vb + (size_t)row * SBW + c2) = make_uint4(pack2(v0[0], v0[1]), pack2(v0[2], v0[3]), pack2(v1[0], v1[1]), pack2(v1[2], v1[3]));
                        float* e = row < NTOK ? out + OUT_SBV_P + (size_t)row * SBW + c2 : out + OUT_SBV_S + (size_t)(row - NTOK) * SBW + c2; *(pg8::f32x4*)e = v0; *(pg8::f32x4*)(e + 4) = v1;
                    } else if (cb < 2688) {
                        *(uint4*)(xq + (size_t)row * XW + (col - 2432)) = make_uint4(pack2(v0[0] * QSCALE, v0[1] * QSCALE), pack2(v0[2] * QSCALE, v0[3] * QSCALE), pack2(v1[0] * QSCALE, v1[1] * QSCALE), pack2(v1[2] * QSCALE, v1[3] * QSCALE));
                    } else {
                        *(uint4*)(gate + (size_t)row * DM + (col - 2688)) = make_uint4(pack2(v0[0] * sigmoidf_(v0[0]), v0[1] * sigmoidf_(v0[1])), pack2(v0[2] * sigmoidf_(v0[2]), v0[3] * sigmoidf_(v0[3])),
                                                                                    pack2(v1[0] * sigmoidf_(v1[0]), v1[1] * sigmoidf_(v1[1])), pack2(v1[2] * sigmoidf_(v1[2]), v1[3] * sigmoidf_(v1[3])));
                    }
                }
        }
    }
};
struct EpiG2 {
    static constexpr bool PERM = true;
    const float* xp; const float* xs; float* yun;
    __device__ __forceinline__ void operator()(const pg8::f32x4 (&acc)[2][2][4][2], const pg8::Unit& u, int wr, int wc, int fr, int fq) const {
#pragma unroll
        for (int ai = 0; ai < 2; ++ai) {
            pg8::f32x4 xv[4][2][2];
#pragma unroll
            for (int m = 0; m < 4; ++m) { const size_t ro = (size_t)(u.pm * 256 + ai * 128 + wr * 64 + m * 16 + fr) * DM;
#pragma unroll
                for (int bj = 0; bj < 2; ++bj) { const int col = u.pn * 256 + bj * 128 + wc * 32 + 8 * fq;
                    xv[m][bj][0] = *(const pg8::f32x4*)(xp + ro + col); xv[m][bj][1] = *(const pg8::f32x4*)(xp + ro + col + 4); } }
#pragma unroll
            for (int m = 0; m < 4; ++m) { const size_t ro = (size_t)(u.pm * 256 + ai * 128 + wr * 64 + m * 16 + fr) * DM;
#pragma unroll
                for (int bj = 0; bj < 2; ++bj) { const int col = u.pn * 256 + bj * 128 + wc * 32 + 8 * fq;
                    *(pg8::f32x4*)(yun + ro + col) = acc[ai][bj][m][0] + xv[m][bj][0]; *(pg8::f32x4*)(yun + ro + col + 4) = acc[ai][bj][m][1] + xv[m][bj][1]; } }
        }
    }
};


typedef short prep_bf16x8 __attribute__((ext_vector_type(8)));
typedef float prep_f32x4 __attribute__((ext_vector_type(4)));
__device__ __forceinline__ void split8(const float (&x)[8], prep_bf16x8& hi, prep_bf16x8& lo) {
    unsigned h[4], l[4];
#pragma unroll
    for (int q = 0; q < 4; ++q) { h[q] = pack2(x[2 * q], x[2 * q + 1]);
        const float r0 = x[2 * q] - __uint_as_float(h[q] << 16), r1 = x[2 * q + 1] - __uint_as_float(h[q] & 0xffff0000u); l[q] = pack2(r0, r1); }
    typedef unsigned u4 __attribute__((ext_vector_type(4)));
    const u4 hv = {h[0], h[1], h[2], h[3]}, lv = {l[0], l[1], l[2], l[3]};
    hi = __builtin_bit_cast(prep_bf16x8, hv); lo = __builtin_bit_cast(prep_bf16x8, lv);
}
__device__ __forceinline__ void p0_prologue(const Params& P, float* lds) {
    const int tid = threadIdx.x, lane = tid & 63, wave = tid >> 6;
    bf16_t* A1 = (bf16_t*)(P.ws + WS_A1); bf16_t* Bt1 = (bf16_t*)(P.ws + WS_BT1); bf16_t* Bt2 = (bf16_t*)(P.ws + WS_BT2);
    const int gw = blockIdx.x * 8 + wave, nw = gridDim.x * 8;
    for (int r0 = gw; r0 < MROWS1; r0 += 2 * nw) {
        const float* srcs[2]; const float* gs[2]; bf16_t* dsts[2]; bool live[2];
#pragma unroll
        for (int q = 0; q < 2; ++q) { const int r = r0 + q * nw; live[q] = r < MROWS1; const int rr = live[q] ? r : 0;
            dsts[q] = A1 + (size_t)rr * DM; srcs[q] = nullptr; gs[q] = P.norm_g;
            if (rr < NTOK) srcs[q] = P.x_prompt + (size_t)rr * DM;
            else if (rr < NTK) srcs[q] = P.x_sample + (size_t)(rr - NTOK) * DM;
            else if (rr >= MEMROW0) { srcs[q] = P.mem_prompt + (size_t)(rr - MEMROW0) * DM; gs[q] = P.mem_norm_g; } }
        float4 x[2][4]; float ss[2] = {0.f, 0.f};
#pragma unroll
        for (int q = 0; q < 2; ++q)
#pragma unroll
            for (int j = 0; j < 4; ++j) x[q][j] = (live[q] && srcs[q]) ? *(const float4*)(srcs[q] + 4 * lane + 256 * j) : make_float4(0.f, 0.f, 0.f, 0.f);
#pragma unroll
        for (int q = 0; q < 2; ++q) {
#pragma unroll
            for (int j = 0; j < 4; ++j) ss[q] += x[q][j].x * x[q][j].x + x[q][j].y * x[q][j].y + x[q][j].z * x[q][j].z + x[q][j].w * x[q][j].w;
            ss[q] = wave_sum_fast(ss[q]); }
#pragma unroll
        for (int q = 0; q < 2; ++q) { if (!live[q]) continue;
            const float rs = rsqrtf(ss[q] * (1.f / DM) + NORM_EPS);
#pragma unroll
            for (int j = 0; j < 4; ++j) { const float4 gg = *(const float4*)(gs[q] + 4 * lane + 256 * j);
                uint2 w; w.x = pack2(x[q][j].x * rs * gg.x, x[q][j].y * rs * gg.y); w.y = pack2(x[q][j].z * rs * gg.z, x[q][j].w * rs * gg.w);
                *(uint2*)(dsts[q] + 4 * lane + 256 * j) = w; } }
    }
    for (int i = blockIdx.x * 512 + tid; i < 128 * DM / 4; i += gridDim.x * 512) *(uint2*)(Bt1 + (size_t)DIN * DM + (size_t)i * 4) = make_uint2(0u, 0u);
    for (int task = blockIdx.x; task < 1312; task += gridDim.x) {
        const float* src; int ld; bf16_t* dst; int k0;
        if (task < 928) { const int kt = task / 58, nt = task % 58; src = P.w_in + (size_t)kt * 64 * DIN + nt * 64; ld = DIN; dst = Bt1 + (size_t)(nt * 64) * DM; k0 = kt * 64; }
        else if (task < 992) { const int e = task - 928, kt = e / 4, nt = e % 4; src = P.w_mem_k + (size_t)kt * 64 * XW + nt * 64; ld = XW; dst = Bt1 + (size_t)(3840 + nt * 64) * DM; k0 = kt * 64; }
        else if (task < 1056) { const int e = task - 992, kt = e / 4, nt = e % 4; src = P.w_mem_v + (size_t)kt * 64 * XW + nt * 64; ld = XW; dst = Bt1 + (size_t)(4096 + nt * 64) * DM; k0 = kt * 64; }
        else { const int e = task - 1056, kt = e / 16, nt = e % 16; src = P.w_out + (size_t)kt * 64 * DM + nt * 64; ld = DM; dst = Bt2 + (size_t)(nt * 64) * DM; k0 = kt * 64; }
        __syncthreads();
#pragma unroll
        for (int p = 0; p < 8; ++p) { const int i = p * 8 + wave; lds[i * 65 + lane] = src[(size_t)i * ld + lane]; }
        __syncthreads();
        {
            const int jj = tid >> 3, kc = tid & 7;
            unsigned w[4];
#pragma unroll
            for (int q = 0; q < 4; ++q) w[q] = pack2(lds[(kc * 8 + 2 * q) * 65 + jj], lds[(kc * 8 + 2 * q + 1) * 65 + jj]);
            *(uint4*)(dst + (size_t)jj * DM + k0 + kc * 8) = make_uint4(w[0], w[1], w[2], w[3]);
        }
    }
    for (int idx = blockIdx.x * 512 + tid; idx < 2 * 6 * 4 * 2 * 64; idx += gridDim.x * 512) {
        const int l = idx & 63, s = (idx >> 6) & 1, nt = (idx >> 7) & 3, w = (idx >> 9) % 6, mt = idx / (512 * 6);
        const float* W = mt ? P.a_lora_b : P.w_lora_b; float x[8];
#pragma unroll
        for (int j = 0; j < 8; ++j) x[j] = W[(size_t)(32 * s + 8 * (l >> 4) + j) * RW + 64 * w + 16 * nt + (l & 15)];
        prep_bf16x8 hi, lo; split8(x, hi, lo);
        prep_bf16x8* LF = (prep_bf16x8*)(P.ws + WS_LFRAG);
        LF[idx] = hi; LF[2 * 6 * 4 * 2 * 64 + idx] = lo;
    }
    __syncthreads();
}

__device__ __forceinline__ void prep_produce(const Params& P, const bf16_t* __restrict__ prw, int ch, float* buf, int j, float mux) {
    constexpr int CT = 8;
    const int tok0 = ch * CT;
    float pv = 0.f;
    if (tok0 < NTOK && (tok0 & (SEQ - 1))) pv = bf2f(prw[(size_t)(tok0 - 1) * RCOLS + 1152 + j]);
    float cur[CT];
#pragma unroll
    for (int tk = 0; tk < CT; ++tk) cur[tk] = bf2f(prw[(size_t)(tok0 + tk) * RCOLS + 1152 + j]);
#pragma unroll
    for (int tk = 0; tk < CT; ++tk) {
        const int tok = tok0 + tk;
        if (tok >= NTOK) pv = P.state_shift[(size_t)(tok - NTOK) * RCOLS + 1152 + j];
        float x = cur[tk] + (pv - cur[tk]) * mux;
        if (j < 64) x = tanhf(x);
        buf[tk * 128 + j] = x;
        pv = cur[tk];
    }
}
__device__ __forceinline__ void p2_rwkv_prep(const Params& P, float* lds) {
    const int tid = threadIdx.x, lane = tid & 63, wave = tid >> 6;
    const bf16_t* prw = (const bf16_t*)(P.ws + WS_PRW);
    float* RSB = (float*)(P.ws + WS_RSB);
    constexpr int CT = 8, NCHK = NTK / CT;
    float* xbuf = lds;
    float* yt = lds + 2 * CT * 128 + wave * (2 * CT * 64);
    float* ot = lds + 2 * CT * 128 + 8 * (2 * CT * 64) + wave * 768;
    prep_bf16x8 wbh[2][4][2], wbl[2][4][2];
    float w0c = 0.f, a0c = 0.f, kkc = 0.f, kac = 0.f, rkc = 0.f, mur = 0.f, muk = 0.f, muv = 0.f, mux = 0.f;
    if (tid < RW) {
        const prep_bf16x8* LF = (const prep_bf16x8*)(P.ws + WS_LFRAG);
#pragma unroll
        for (int mt = 0; mt < 2; ++mt)
#pragma unroll
            for (int nt = 0; nt < 4; ++nt)
#pragma unroll
                for (int s = 0; s < 2; ++s) { const int fi = (((mt * 6 + wave) * 4 + nt) * 2 + s) * 64 + lane; wbh[mt][nt][s] = LF[fi]; wbl[mt][nt][s] = LF[2 * 6 * 4 * 2 * 64 + fi]; }
        w0c = P.w0[tid]; a0c = P.a0[tid]; kkc = P.k_k[tid]; kac = P.k_a[tid]; rkc = P.r_k[tid];
        mur = P.mu_shift[tid]; muk = P.mu_shift[RW + tid]; muv = P.mu_shift[2 * RW + tid];
    } else {
#pragma unroll
        for (int mt = 0; mt < 2; ++mt)
#pragma unroll
            for (int nt = 0; nt < 4; ++nt)
#pragma unroll
                for (int s = 0; s < 2; ++s)
#pragma unroll
                    for (int j = 0; j < 8; ++j) { wbh[mt][nt][s][j] = 0; wbl[mt][nt][s][j] = 0; }
        mux = P.mu_shift[1152 + (tid - RW)];
    }
    int ch = blockIdx.x;
    if (tid >= RW && ch < NCHK) prep_produce(P, prw, ch, xbuf, tid - RW, mux);
    for (int it = 0; ch < NCHK; ch += gridDim.x, ++it) {
        const int tok0 = ch * CT;
        float* bufc = xbuf + (it & 1) * (CT * 128); float* bufn = xbuf + ((it + 1) & 1) * (CT * 128);
        float nr[4], nk[4], nv[4], qr = 0.f, qk = 0.f, qv = 0.f;
        if (tid < RW) {
#pragma unroll
            for (int q = 0; q < 4; ++q) { const bf16_t* p = prw + (size_t)(tok0 + q) * RCOLS + tid; nr[q] = bf2f(p[0]); nk[q] = bf2f(p[RW]); nv[q] = bf2f(p[2 * RW]); }
            if (tok0 < NTOK && (tok0 & (SEQ - 1))) { const bf16_t* p = prw + (size_t)(tok0 - 1) * RCOLS + tid; qr = bf2f(p[0]); qk = bf2f(p[RW]); qv = bf2f(p[2 * RW]); }
        }
        asm volatile("s_waitcnt lgkmcnt(0)" ::: "memory");
        __builtin_amdgcn_s_barrier(); asm volatile("" ::: "memory");
        if (tid >= RW) { if (ch + (int)gridDim.x < NCHK) prep_produce(P, prw, ch + gridDim.x, bufn, tid - RW, mux); }
        else {
            const int c = tid, h = tid >> 6, cc = c & 63;
            {
                prep_bf16x8 ah[2][2], al_[2][2];
#pragma unroll
                for (int mt = 0; mt < 2; ++mt)
#pragma unroll
                    for (int s = 0; s < 2; ++s) { float x[8];
                        const float* xp = bufc + (lane & 7) * 128 + mt * 64 + 32 * s + 8 * (lane >> 4);
                        const float4 x0 = *(const float4*)xp, x1 = *(const float4*)(xp + 4);
                        const bool real = (lane & 15) < CT;
                        x[0] = real ? x0.x : 0.f; x[1] = real ? x0.y : 0.f; x[2] = real ? x0.z : 0.f; x[3] = real ? x0.w : 0.f;
                        x[4] = real ? x1.x : 0.f; x[5] = real ? x1.y : 0.f; x[6] = real ? x1.z : 0.f; x[7] = real ? x1.w : 0.f;
                        split8(x, ah[mt][s], al_[mt][s]); }
#pragma unroll
                for (int mt = 0; mt < 2; ++mt)
#pragma unroll
                    for (int nt = 0; nt < 4; ++nt) { prep_f32x4 acc = {0.f, 0.f, 0.f, 0.f};
#pragma unroll
                        for (int s = 0; s < 2; ++s) {
                            acc = __builtin_amdgcn_mfma_f32_16x16x32_bf16(al_[mt][s], wbh[mt][nt][s], acc, 0, 0, 0);
                            acc = __builtin_amdgcn_mfma_f32_16x16x32_bf16(ah[mt][s], wbl[mt][nt][s], acc, 0, 0, 0);
                            acc = __builtin_amdgcn_mfma_f32_16x16x32_bf16(ah[mt][s], wbh[mt][nt][s], acc, 0, 0, 0); }
                        if ((lane >> 4) < 2) {
#pragma unroll
                            for (int r = 0; r < 4; ++r) yt[(mt * CT + 4 * (lane >> 4) + r) * 64 + 16 * nt + (lane & 15)] = acc[r]; } }
                asm volatile("s_waitcnt lgkmcnt(0)" ::: "memory");
                __builtin_amdgcn_wave_barrier();
            }
#pragma unroll
            for (int tk = 0; tk < CT; ++tk) {
                const int tok = tok0 + tk;
                if (tok >= NTOK) { const float* p = P.state_shift + (size_t)(tok - NTOK) * RCOLS + tid; qr = p[0]; qk = p[RW]; qv = p[2 * RW]; }
                const float cr = nr[tk & 3], ck = nk[tk & 3], cv = nv[tk & 3];
                if (tk + 4 < CT) { const bf16_t* p = prw + (size_t)(tok + 4) * RCOLS + tid; nr[tk & 3] = bf2f(p[0]); nk[tk & 3] = bf2f(p[RW]); nv[tk & 3] = bf2f(p[2 * RW]); }
                const float r = cr + (qr - cr) * mur, kraw = ck + (qk - ck) * muk, v = cv + (qv - cv) * muv;
                qr = cr; qk = ck; qv = cv;
                const float aw = w0c + yt[tk * 64 + cc], aa = a0c + yt[(CT + tk) * 64 + cc];
                float* blk = RSB + ((size_t)tok * RH + h) * RSB_BLK;
                const float w = __expf(-DECAY_SCALE * sigmoidf_(aw)), a = sigmoidf_(aa);
                const float kkv = kraw * kkc;
                const float n2 = wave_sum_fast(kkv * kkv);
                const float kk = kkv * rsqrtf(fmaxf(n2, 1e-12f));
                const float kmod = kraw * (1.f + (a - 1.f) * kac);
                const float rk = wave_sum_fast(r * kmod * rkc);
                const float bb = kk * a;
                const float br = wave_sum_fast(bb * r), kr = wave_sum_fast(kmod * r);
                float* oq = ot + (tk & 1) * 384;
                oq[cc] = kk; oq[64 + cc] = w; oq[128 + cc] = bb; oq[192 + cc] = kmod; oq[256 + cc] = w * r; oq[320 + cc] = v;
                __builtin_amdgcn_wave_barrier();
                *(float4*)(blk + 4 * lane) = *(const float4*)(oq + 4 * lane);
                if (lane < 32) *(float4*)(blk + 256 + 4 * lane) = *(const float4*)(oq + 256 + 4 * lane);
                if (lane == 0) *(float4*)(blk + 384) = make_float4(br, kr, rk, 0.f);
                __builtin_amdgcn_wave_barrier();
            }
            __builtin_amdgcn_wave_barrier();
        }
    }
    __syncthreads();
}

__device__ __forceinline__ void p2_xattn_sample(const Params& P, float* lds) {
    const int tid = threadIdx.x, lane = tid & 63, wave = tid >> 6;
    const bf16_t* xq = (const bf16_t*)(P.ws + WS_XQ); const bf16_t* gate = (const bf16_t*)(P.ws + WS_GATE); bf16_t* O = (bf16_t*)(P.ws + WS_O);
    float* zl = lds + wave * 64; float* part = lds + 512;
    const int c = lane & 15, g = lane >> 4;
    for (int task = (int)blockIdx.x - 128; task >= 0 && task < DB * XH; task += 128) {
        const int b = task >> 2, h = task & 3; const size_t row = NTOK + b;
        const bf16_t* qp = xq + row * XW + h * 64 + 4 * c;
        const float q0 = bf2f(qp[0]), q1 = bf2f(qp[1]), q2 = bf2f(qp[2]), q3 = bf2f(qp[3]);
        const float* Kp = P.cmem_k + (((size_t)b * NMEM + wave * 32) * XH + h) * HD + 4 * c; const float* Vp = P.cmem_v + (((size_t)b * NMEM + wave * 32) * XH + h) * HD + 4 * c;
        __syncthreads();
        float4 k4[8], v4[8];
#pragma unroll
        for (int i = 0; i < 8; ++i) { k4[i] = *(const float4*)(Kp + (size_t)(4 * i + g) * (XH * HD)); v4[i] = *(const float4*)(Vp + (size_t)(4 * i + g) * (XH * HD)); }
#pragma unroll
        for (int i = 0; i < 8; ++i) { float p = q0 * k4[i].x + q1 * k4[i].y + q2 * k4[i].z + q3 * k4[i].w; p = sum16(p); if (c == 0) zl[4 * i + g] = p; }
        asm volatile("s_waitcnt lgkmcnt(0)" ::: "memory");
        __builtin_amdgcn_wave_barrier();
        const float z = zl[lane & 31];
        const float mx = wave_max(z);
        const float p = (lane < 32) ? exp2f(z - mx) : 0.f;
        const float ls = wave_sum_fast(p);
        __builtin_amdgcn_wave_barrier();
        if (lane < 32) zl[lane] = p;
        asm volatile("s_waitcnt lgkmcnt(0)" ::: "memory");
        __builtin_amdgcn_wave_barrier();
        float4 o4 = make_float4(0.f, 0.f, 0.f, 0.f);
#pragma unroll
        for (int i = 0; i < 8; ++i) { const float w = zl[4 * i + g]; o4.x += w * v4[i].x; o4.y += w * v4[i].y; o4.z += w * v4[i].z; o4.w += w * v4[i].w; }
#pragma unroll
        for (int off = 16; off < 64; off <<= 1) { o4.x += __shfl_xor(o4.x, off); o4.y += __shfl_xor(o4.y, off); o4.z += __shfl_xor(o4.z, off); o4.w += __shfl_xor(o4.w, off); }
        if (g == 0) *(float4*)(part + wave * 68 + 4 * c) = o4;
        if (lane == 0) { part[wave * 68 + 64] = mx; part[wave * 68 + 65] = ls; }
        __syncthreads();
        if (wave == 0) {
            float M = part[64];
#pragma unroll
            for (int w = 1; w < 8; ++w) M = fmaxf(M, part[w * 68 + 64]);
            float L = 0.f, o = 0.f;
#pragma unroll
            for (int w = 0; w < 8; ++w) { const float sc = exp2f(part[w * 68 + 64] - M); L += part[w * 68 + 65] * sc; o += part[w * 68 + lane] * sc; }
            O[row * DM + 768 + h * 64 + lane] = f2bf(o / L * bf2f(gate[row * DM + 768 + h * 64 + lane]));
        }
    }
    __syncthreads();
}

constexpr int DEC_NTASK = DB * NPAGES * SH, DEC_LDS_OFF = 144384;
constexpr int QW_SB = 3584, QW_DEC = 3648;
__device__ __forceinline__ void sb_decode_task(const Params& P, float* lds, int task) {
    const int tid = threadIdx.x, lane = tid & 63, wave = tid >> 6;
    const bf16_t* qb = (const bf16_t*)(P.ws + WS_QB);
    float* dpart = (float*)(P.ws + WS_DPART); float* dl = (float*)(P.ws + WS_DL);
    float* zl = lds + DEC_LDS_OFF / 4 + wave * 256; float* wl = zl + 128;
    const int c = lane & 15, g = lane >> 4;
    {
        const int h = task % SH, bj = task / SH, b = bj / NPAGES;
        const int page = P.page_table[bj];
        const float* Kp = P.cache_k + ((size_t)page * PAGE * SH + h) * HD;
        const float* Vp = P.cache_v + ((size_t)page * PAGE * SH + h) * HD;
        const bf16_t* qp = qb + (size_t)(NTOK + b) * SBW + h * 64 + 4 * c;
        const float q0 = bf2f(qp[0]), q1 = bf2f(qp[1]), q2 = bf2f(qp[2]), q3 = bf2f(qp[3]);
        const float bias = P.sb_bias[h] * LOG2E;
        float4 kv[16];
#pragma unroll
        for (int i = 0; i < 16; ++i) kv[i] = *(const float4*)(Kp + (size_t)(4 * i + g) * (SH * HD) + 4 * c);
#pragma unroll
        for (int hb = 0; hb < 2; ++hb) {
            float4 nx[16];
            if (hb == 0) {
#pragma unroll
                for (int i = 0; i < 16; ++i) nx[i] = *(const float4*)(Kp + (size_t)(64 + 4 * i + g) * (SH * HD) + 4 * c);
            } else {
#pragma unroll
                for (int i = 0; i < 16; ++i) nx[i] = *(const float4*)(Vp + (size_t)(4 * i + g) * (SH * HD) + 4 * c);
            }
#pragma unroll
            for (int i = 0; i < 16; ++i) { const int s = 64 * hb + 4 * i + g;
                float part = q0 * kv[i].x + q1 * kv[i].y + q2 * kv[i].z + q3 * kv[i].w; part = sum16(part);
                if (c == 0) zl[s] = part + bias; }
#pragma unroll
            for (int i = 0; i < 16; ++i) kv[i] = nx[i];
        }
        asm volatile("s_waitcnt lgkmcnt(0)" ::: "memory");
        __builtin_amdgcn_wave_barrier();
        const float z0 = zl[2 * lane], z1 = zl[2 * lane + 1];
        const float sp0 = softplus2_(z0), sp1 = softplus2_(z1);
        float incl = sp0 + sp1;
#pragma unroll
        for (int off = 1; off < 64; off <<= 1) { const float t = __shfl_down(incl, off); if (lane + off < 64) incl += t; }
        const float excl = incl - (sp0 + sp1);
        wl[2 * lane] = exp2f(z0 - sp0 - (excl + sp1));
        wl[2 * lane + 1] = exp2f(z1 - sp1 - excl);
        const float Ltot = __shfl(incl, 0);
        asm volatile("s_waitcnt lgkmcnt(0)" ::: "memory");
        __builtin_amdgcn_wave_barrier();
        float4 o4 = make_float4(0.f, 0.f, 0.f, 0.f);
        {
            float4 nx[16];
#pragma unroll
            for (int i = 0; i < 16; ++i) nx[i] = *(const float4*)(Vp + (size_t)(64 + 4 * i + g) * (SH * HD) + 4 * c);
#pragma unroll
            for (int i = 0; i < 16; ++i) { const float w = wl[4 * i + g]; o4.x += w * kv[i].x; o4.y += w * kv[i].y; o4.z += w * kv[i].z; o4.w += w * kv[i].w; }
#pragma unroll
            for (int i = 0; i < 16; ++i) { const float w = wl[64 + 4 * i + g]; o4.x += w * nx[i].x; o4.y += w * nx[i].y; o4.z += w * nx[i].z; o4.w += w * nx[i].w; }
        }
#pragma unroll
        for (int off = 16; off < 64; off <<= 1) { o4.x += __shfl_xor(o4.x, off); o4.y += __shfl_xor(o4.y, off); o4.z += __shfl_xor(o4.z, off); o4.w += __shfl_xor(o4.w, off); }
        if (g == 0) *(float4*)(dpart + (size_t)task * HD + 4 * c) = o4;
        if (lane == 0) dl[task] = Ltot;
        __builtin_amdgcn_wave_barrier();
    }
}

__device__ __forceinline__ void sb_decode_wave_loop(const Params& P, float* lds) {
    unsigned* qd = (unsigned*)(P.ws + WS_BAR) + QW_DEC;
    const int lane = threadIdx.x & 63;
    unsigned nxt = 0u;
    if (lane == 0) nxt = atomicAdd(qd, 2u);
    for (;;) {
        const int t = __builtin_amdgcn_readfirstlane((int)nxt);
        if (t >= DEC_NTASK) break;
        if (lane == 0) nxt = atomicAdd(qd, 2u);
        sb_decode_task(P, lds, t); sb_decode_task(P, lds, t + 1);
    }
}

struct StepIn { float4 kk, w, b, k, wr; float v; float2 sc; };
__device__ __forceinline__ void load_step(StepIn& s, const float* __restrict__ p, int c0, int rl) {
    s.kk = *(const float4*)(p + c0); s.w = *(const float4*)(p + 64 + c0); s.b = *(const float4*)(p + 128 + c0); s.k = *(const float4*)(p + 192 + c0); s.wr = *(const float4*)(p + 256 + c0);
    s.v = p[320 + rl]; s.sc = *(const float2*)(p + 384);
}
__device__ __forceinline__ void scan_step(float4& S, const StepIn& s, float* __restrict__ op) {
    float d1 = S.x * s.kk.x + S.y * s.kk.y + S.z * s.kk.z + S.w * s.kk.w;
    float d2 = S.x * s.wr.x + S.y * s.wr.y + S.z * s.wr.z + S.w * s.wr.w;
    d1 = sum16(d1); d2 = sum16(d2);
    S.x = S.x * s.w.x - d1 * s.b.x + s.v * s.k.x; S.y = S.y * s.w.y - d1 * s.b.y + s.v * s.k.y; S.z = S.z * s.w.z - d1 * s.b.z + s.v * s.k.z; S.w = S.w * s.w.w - d1 * s.b.w + s.v * s.k.w;
    *op = d2 - d1 * s.sc.x + s.v * s.sc.y;
}
__device__ __forceinline__ float scan_step_asm(float4& S, const StepIn& s) {
    float o, d1, d2, t;
    asm volatile(
        "v_mul_f32 %5, %0, %8\n\t"  "v_mul_f32 %6, %0, %12\n\t"
        "v_fmac_f32 %5, %1, %9\n\t" "v_fmac_f32 %6, %1, %13\n\t"
        "v_fmac_f32 %5, %2, %10\n\t" "v_fmac_f32 %6, %2, %14\n\t"
        "v_fmac_f32 %5, %3, %11\n\t" "v_fmac_f32 %6, %3, %15\n\t"
        "v_mul_f32 %0, %0, %16\n\t" "v_mul_f32 %1, %1, %17\n\t"
        "v_add_f32_dpp %5, %5, %5 quad_perm:[1,0,3,2] row_mask:0xf bank_mask:0xf\n\t"
        "v_add_f32_dpp %6, %6, %6 quad_perm:[1,0,3,2] row_mask:0xf bank_mask:0xf\n\t"
        "v_mul_f32 %2, %2, %18\n\t" "v_mul_f32 %3, %3, %19\n\t"
        "v_add_f32_dpp %5, %5, %5 quad_perm:[2,3,0,1] row_mask:0xf bank_mask:0xf\n\t"
        "v_add_f32_dpp %6, %6, %6 quad_perm:[2,3,0,1] row_mask:0xf bank_mask:0xf\n\t"
        "v_fmac_f32 %0, %28, %20\n\t" "v_fmac_f32 %1, %28, %21\n\t"
        "v_add_f32_dpp %5, %5, %5 row_ror:4 row_mask:0xf bank_mask:0xf\n\t"
        "v_add_f32_dpp %6, %6, %6 row_ror:4 row_mask:0xf bank_mask:0xf\n\t"
        "v_fmac_f32 %2, %28, %22\n\t" "v_fmac_f32 %3, %28, %23\n\t"
        "v_add_f32_dpp %5, %5, %5 row_ror:8 row_mask:0xf bank_mask:0xf\n\t"
        "v_add_f32_dpp %6, %6, %6 row_ror:8 row_mask:0xf bank_mask:0xf\n\t"
        "v_mul_f32 %7, %28, %30\n\t"
        "v_fma_f32 %0, -%5, %24, %0\n\t" "v_fma_f32 %1, -%5, %25, %1\n\t" "v_fma_f32 %2, -%5, %26, %2\n\t" "v_fma_f32 %3, -%5, %27, %3\n\t"
        "v_add_f32 %4, %6, %7\n\t"
        "v_fma_f32 %4, -%5, %29, %4\n\t"
        "s_nop 0"
        : "+v"(S.x), "+v"(S.y), "+v"(S.z), "+v"(S.w), "=&v"(o), "=&v"(d1), "=&v"(d2), "=&v"(t)
        : "v"(s.kk.x), "v"(s.kk.y), "v"(s.kk.z), "v"(s.kk.w), "v"(s.wr.x), "v"(s.wr.y), "v"(s.wr.z), "v"(s.wr.w),
          "v"(s.w.x), "v"(s.w.y), "v"(s.w.z), "v"(s.w.w), "v"(s.k.x), "v"(s.k.y), "v"(s.k.z), "v"(s.k.w),
          "v"(s.b.x), "v"(s.b.y), "v"(s.b.z), "v"(s.b.w), "v"(s.v), "v"(s.sc.x), "v"(s.sc.y));
    return o;
}
__device__ __forceinline__ void scan_rows(const Params& P, int tok0, int T, int h, int row0, const float* S0, float* Sout, int lane) {
    const int rl = row0 + (lane >> 4), c0 = (lane & 15) * 4;
    const float* p = (const float*)(P.ws + WS_RSB) + ((size_t)tok0 * RH + h) * RSB_BLK;
    float* op = (float*)(P.ws + WS_ORAW) + (size_t)tok0 * RW + h * 64 + rl;
    constexpr int PST = RH * RSB_BLK;
    float4 S = S0 ? *(const float4*)(S0 + rl * 64 + c0) : make_float4(0.f, 0.f, 0.f, 0.f);
    if (T >= 16) {
        StepIn ring[8];
#pragma unroll
        for (int j = 0; j < 8; ++j) load_step(ring[j], p + (size_t)j * PST, c0, rl);
        for (int t0 = 0; t0 < T - 8; t0 += 8) {
#pragma unroll
            for (int j = 0; j < 8; ++j) { scan_step(S, ring[j], op + (size_t)j * RW); load_step(ring[j], p + (size_t)(8 + j) * PST, c0, rl); }
            p += 8 * PST; op += 8 * RW;
        }
#pragma unroll
        for (int j = 0; j < 8; ++j) scan_step(S, ring[j], op + (size_t)j * RW);
    } else {
        for (int t = 0; t < T; ++t) { StepIn s; load_step(s, p + (size_t)t * PST, c0, rl); scan_step(S, s, op + (size_t)t * RW); }
    }
    *(float4*)(Sout + rl * 64 + c0) = S;
}

constexpr int SCH = 16, SC_NPIECE = SCH * 97, SC_NP64 = (SC_NPIECE + 63) / 64, SC_BUF = 28672, SC_NB = 5;
__device__ __forceinline__ void lds_load_step(StepIn& s, const float* p, int c0, int rl) {
    s.kk = *(const float4*)(p + c0); s.w = *(const float4*)(p + 64 + c0); s.b = *(const float4*)(p + 128 + c0); s.k = *(const float4*)(p + 192 + c0); s.wr = *(const float4*)(p + 256 + c0);
    s.v = p[320 + rl]; s.sc = *(const float2*)(p + 384);
}
#ifndef SC_FREE_WAVES
#define SC_FREE_WAVES 2
#endif
constexpr int SC_CTL_OFF = SC_NB * 28672;
__device__ __forceinline__ void scan_prompt_wave(const Params& P, unsigned char* lds, int b, int h, int quarter) {
    const int tid = threadIdx.x, lane = tid & 63; const int wave = __builtin_amdgcn_readfirstlane(tid >> 6);
    constexpr int PST = RH * RSB_BLK, NCH = SEQ / SCH;
    volatile LAS unsigned* scw = (volatile LAS unsigned*)((LAS unsigned char*)lds + SC_CTL_OFF);
    if (wave == 4) {
        const float* g0 = (const float*)(P.ws + WS_RSB) + ((size_t)(b * SEQ) * RH + h) * RSB_BLK;
        LAS unsigned char* l3 = (LAS unsigned char*)lds;
        int soff[SC_NP64];
#pragma unroll
        for (int j = 0; j < SC_NP64; ++j) { const int i = j * 64 + lane; const int ii = i < SC_NPIECE ? i : SC_NPIECE - 1; soff[j] = (ii / 97) * PST + (ii % 97) * 4; }
        for (int c = 0; c < NCH; ++c) {
            if (c >= SC_NB) {
                for (;;) { const unsigned d0 = scw[1], d1 = scw[2], d2 = scw[3], d3 = scw[4]; const unsigned m01 = d0 < d1 ? d0 : d1, m23 = d2 < d3 ? d2 : d3;
                    if ((m01 < m23 ? m01 : m23) >= (unsigned)(c - SC_NB + 1)) break; __builtin_amdgcn_s_sleep(1); }
            }
            const float* g_ = g0 + (size_t)c * SCH * PST;
#pragma unroll
            for (int j = 0; j < SC_NP64; ++j) {
                if (j * 64 + lane < SC_NPIECE) __builtin_amdgcn_global_load_lds((const unsigned*)(g_ + soff[j]), (LAS unsigned*)(l3 + (c % SC_NB) * SC_BUF + j * 1024), 16, 0, 0);
            }
            if (c >= 1) { asm volatile("s_waitcnt vmcnt(25)" ::: "memory"); if (lane == 0) scw[0] = (unsigned)c; }
        }
        asm volatile("s_waitcnt vmcnt(0)" ::: "memory");
        if (lane == 0) scw[0] = (unsigned)NCH;
    } else if (wave < 4) {
        const int rl = quarter * 16 + wave * 4 + (lane >> 4), cl = lane & 15, c0 = cl * 4;
        float* op = (float*)(P.ws + WS_ORAW) + (size_t)(b * SEQ) * RW + h * 64 + rl;
        float4 S = make_float4(0.f, 0.f, 0.f, 0.f);
        while (scw[0] < 1u) __builtin_amdgcn_s_sleep(1);
        asm volatile("" ::: "memory");
        StepIn r[4];
        lds_load_step(r[0], (const float*)lds, c0, rl); lds_load_step(r[1], (const float*)lds + RSB_BLK, c0, rl); lds_load_step(r[2], (const float*)lds + 2 * RSB_BLK, c0, rl);
        for (int c = 0; c < NCH; ++c) {
            const float* bp = (const float*)(lds + (c % SC_NB) * SC_BUF); const float* bpn = (const float*)(lds + ((c + 1) % SC_NB) * SC_BUF);
            float ov = 0.f;
#pragma unroll
            for (int s = 0; s < SCH; ++s) {
                if (s == SCH - 3 && c + 1 < NCH) { while (scw[0] < (unsigned)(c + 2)) __builtin_amdgcn_s_sleep(1); asm volatile("" ::: "memory"); }
                lds_load_step(r[(s + 3) & 3], (s + 3 < SCH) ? bp + (s + 3) * RSB_BLK : bpn + (s + 3 - SCH) * RSB_BLK, c0, rl); __builtin_amdgcn_sched_barrier(0);
                const float o = scan_step_asm(S, r[s & 3]); __builtin_amdgcn_sched_barrier(0);
                ov = (cl == s) ? o : ov;
            }
            op[(size_t)cl * RW] = ov;
            op += (size_t)SCH * RW;
            if (lane == 0) scw[1 + wave] = (unsigned)(c + 1);
        }
        *(float4*)(P.out + OUT_WKV_P + ((size_t)(b * RH + h) * HD + rl) * HD + c0) = S;
    }
}

namespace sba {
typedef short bf16x8 __attribute__((ext_vector_type(8)));
typedef short s16x4 __attribute__((ext_vector_type(4)));
typedef float f32x16 __attribute__((ext_vector_type(16)));
typedef unsigned u32x4 __attribute__((ext_vector_type(4)));
typedef __attribute__((address_space(3))) const unsigned char* lds_cptr;
constexpr int SLOT = 16384;
#define SBA_MFMA(a, b, c) __builtin_amdgcn_mfma_f32_32x32x16_bf16(a, b, c, 0, 0, 0)
__device__ __forceinline__ unsigned cvtpk(float lo, float hi) { return pack2(lo, hi); }
__device__ __forceinline__ bf16x8 pack8(const f32x16& x, int base) {
    u32x4 w; w[0] = cvtpk(x[base], x[base + 1]); w[1] = cvtpk(x[base + 2], x[base + 3]); w[2] = cvtpk(x[base + 4], x[base + 5]); w[3] = cvtpk(x[base + 6], x[base + 7]);
    return __builtin_bit_cast(bf16x8, w);
}
__device__ __forceinline__ int crow(int r, int hi) { return (r & 3) + 8 * (r >> 2) + 4 * hi; }
__device__ __forceinline__ bf16x8 vfrag(lds_cptr p) {
    const s16x4 a = __builtin_bit_cast(s16x4, __builtin_amdgcn_ds_read_tr16_b64_v4i16((__attribute__((address_space(3))) s16x4*)p));
    const s16x4 b = __builtin_bit_cast(s16x4, __builtin_amdgcn_ds_read_tr16_b64_v4i16((__attribute__((address_space(3))) s16x4*)(p + 8 * 64)));
    bf16x8 r; r[0] = a[0]; r[1] = a[1]; r[2] = a[2]; r[3] = a[3]; r[4] = b[0]; r[5] = b[1]; r[6] = b[2]; r[7] = b[3]; return r;
}

template <bool MASK>
__device__ __forceinline__ void tile(lds_cptr kp0, lds_cptr vp0, const bf16x8 (&qr)[4], const f32x16& biasv, const bf16x8& ut0, const bf16x8& ut1, const bf16x8& uon,
                                     f32x16& o0, f32x16& o1, float& R, int kbase, int trel, int hi) {
    f32x16 p0 = biasv, p1 = biasv;
#pragma unroll
    for (int d0 = 0; d0 < 4; ++d0) {
        const bf16x8 ka = *(const __attribute__((address_space(3))) bf16x8*)(kp0 + d0 * 2048);
        const bf16x8 kb = *(const __attribute__((address_space(3))) bf16x8*)(kp0 + d0 * 2048 + 512);
        p0 = SBA_MFMA(ka, qr[d0], p0); p1 = SBA_MFMA(kb, qr[d0], p1);
    }
    f32x16 s0, s1;
#pragma unroll
    for (int r = 0; r < 16; ++r) {
        s0[r] = __builtin_amdgcn_logf(1.f + __builtin_amdgcn_exp2f(p0[r]));
        s1[r] = __builtin_amdgcn_logf(1.f + __builtin_amdgcn_exp2f(p1[r]));
        if (MASK) { const int k0 = kbase + crow(r, hi); if (k0 >= trel) s0[r] = 0.f; if (k0 + 32 >= trel) s1[r] = 0.f; }
    }
    const bf16x8 b00 = pack8(s0, 0), b01 = pack8(s0, 8), b10 = pack8(s1, 0), b11 = pack8(s1, 8);
    f32x16 c0, c1;
#pragma unroll
    for (int r = 0; r < 16; ++r) { c0[r] = p0[r] - R; c1[r] = p1[r] - R; }
    const float top = c0[0];
    c0 = SBA_MFMA(ut0, b00, c0); c0 = SBA_MFMA(ut1, b01, c0); c0 = SBA_MFMA(uon, b10, c0); c0 = SBA_MFMA(uon, b11, c0);
    c1 = SBA_MFMA(ut0, b10, c1); c1 = SBA_MFMA(ut1, b11, c1);
    const float tot_l = top - c0[0];
    const auto sw = __builtin_amdgcn_permlane32_swap(__float_as_uint(tot_l), __float_as_uint(tot_l), false, false);
    const float tot = __uint_as_float(sw[0]);
#pragma unroll
    for (int r = 0; r < 16; ++r) {
        c0[r] = __builtin_amdgcn_exp2f(c0[r]); c1[r] = __builtin_amdgcn_exp2f(c1[r]);
        if (MASK) { const int k0 = kbase + crow(r, hi); if (k0 >= trel) c0[r] = 0.f; if (k0 + 32 >= trel) c1[r] = 0.f; }
    }
    const bf16x8 a00 = pack8(c0, 0), a01 = pack8(c0, 8), a10 = pack8(c1, 0), a11 = pack8(c1, 8);
    o0 = SBA_MFMA(vfrag(vp0 + 0 * 1024), a00, o0); o1 = SBA_MFMA(vfrag(vp0 + 4096 + 0 * 1024), a00, o1);
    o0 = SBA_MFMA(vfrag(vp0 + 1 * 1024), a01, o0); o1 = SBA_MFMA(vfrag(vp0 + 4096 + 1 * 1024), a01, o1);
    o0 = SBA_MFMA(vfrag(vp0 + 2 * 1024), a10, o0); o1 = SBA_MFMA(vfrag(vp0 + 4096 + 2 * 1024), a10, o1);
    o0 = SBA_MFMA(vfrag(vp0 + 3 * 1024), a11, o0); o1 = SBA_MFMA(vfrag(vp0 + 4096 + 3 * 1024), a11, o1);
    R += tot;
}

__device__ __forceinline__ void unit(const Params& P, unsigned char* lds, int b, int h, int qb) {
    const int tid = threadIdx.x, lane = tid & 63, r32 = lane & 31, hi = lane >> 5; const int wid = __builtin_amdgcn_readfirstlane(tid >> 6);
    const bf16_t* Q = (const bf16_t*)(P.ws + WS_QB); const bf16_t* K = (const bf16_t*)(P.ws + WS_KB); const bf16_t* V = (const bf16_t*)(P.ws + WS_VB);
    const bf16_t* gate = (const bf16_t*)(P.ws + WS_GATE); bf16_t* O = (bf16_t*)(P.ws + WS_O);
    const size_t rowbase = (size_t)b * SEQ; const int q0 = qb * 256, NT = (q0 + 256) / 64;
    const int trel = wid * 32 + r32;
    const size_t qrow = rowbase + q0 + trel;
    bf16x8 qr[4];
#pragma unroll
    for (int d0 = 0; d0 < 4; ++d0) qr[d0] = *(const bf16x8*)(Q + qrow * SBW + h * 64 + d0 * 16 + hi * 8);
    const bf16_t* ksrc = K + (rowbase + lane) * SBW + h * 64 + wid * 8;
    const bf16_t* vsrc = V + (rowbase + 16 * (wid & 3) + (lane >> 2)) * SBW + h * 64 + (wid >> 2) * 32 + (lane & 3) * 8;
    LAS unsigned char* l3 = (LAS unsigned char*)lds;
#define SBA_DMA(t, slot) do { __builtin_amdgcn_global_load_lds((const unsigned*)(ksrc + (size_t)(t) * 64 * SBW), (LAS unsigned*)(l3 + (slot) + wid * 1024), 16, 0, 0); \
        __builtin_amdgcn_global_load_lds((const unsigned*)(vsrc + (size_t)(t) * 64 * SBW), (LAS unsigned*)(l3 + (slot) + 8192 + wid * 1024), 16, 0, 0); } while (0)
    const int koff = hi * 1024 + r32 * 16;
    const int voff = 8192 + ((lane >> 4) & 1) * 32 + (lane & 3) * 8 + (4 * hi + ((lane & 15) >> 2)) * 64;
    bf16x8 ut0, ut1, uon;
#pragma unroll
    for (int jj = 0; jj < 8; ++jj) { const int kj = 8 * (jj >> 2) + 4 * hi + (jj & 3);
        ut0[jj] = (kj >= r32) ? (short)0xBF80 : (short)0; ut1[jj] = (16 + kj >= r32) ? (short)0xBF80 : (short)0; uon[jj] = (short)0xBF80; }
    f32x16 biasv; { const float b2 = P.sb_bias[h] * LOG2E;
#pragma unroll
        for (int r = 0; r < 16; ++r) biasv[r] = b2; }
    f32x16 o0, o1;
#pragma unroll
    for (int r = 0; r < 16; ++r) { o0[r] = 0.f; o1[r] = 0.f; }
    float R = 0.f;
    __syncthreads();
    SBA_DMA(NT - 1, ((NT - 1) & 1) * SLOT);
    asm volatile("s_waitcnt vmcnt(0)" ::: "memory");
    __syncthreads();
    for (int t = NT - 1; t >= 0; --t) {
        const int slot = (t & 1) * SLOT;
        if (t > 0) SBA_DMA(t - 1, slot ^ SLOT);
        const int jb = t - (NT - 4);
        const lds_cptr kp0 = (lds_cptr)l3 + slot + koff, vp0 = (lds_cptr)l3 + slot + voff;
        if (jb < 0) tile<false>(kp0, vp0, qr, biasv, ut0, ut1, uon, o0, o1, R, 0, 0, hi);
        else if (64 * jb < wid * 32 + 31) {
            if (64 * jb + 63 >= wid * 32) tile<true>(kp0, vp0, qr, biasv, ut0, ut1, uon, o0, o1, R, 64 * jb, trel, hi);
            else tile<false>(kp0, vp0, qr, biasv, ut0, ut1, uon, o0, o1, R, 0, 0, hi);
        }
        asm volatile("s_waitcnt vmcnt(0)" ::: "memory");
        __syncthreads();
    }
#undef SBA_DMA
    const bf16_t* gr = gate + qrow * DM + 384 + h * 64; bf16_t* orow = O + qrow * DM + 384 + h * 64;
#pragma unroll
    for (int half = 0; half < 2; ++half)
#pragma unroll
        for (int g = 0; g < 4; ++g) { const int d = 32 * half + 8 * g + 4 * hi; const uint2 gt = *(const uint2*)(gr + d);
            const f32x16& o = half ? o1 : o0;
            uint2 w; w.x = cvtpk(o[4 * g] * __uint_as_float(gt.x << 16), o[4 * g + 1] * __uint_as_float(gt.x & 0xffff0000u));
            w.y = cvtpk(o[4 * g + 2] * __uint_as_float(gt.y << 16), o[4 * g + 3] * __uint_as_float(gt.y & 0xffff0000u));
            *(uint2*)(orow + d) = w; }
}
}

__device__ __forceinline__ void p2_xattn_prompt(const Params& P, unsigned char* lds) {
    using namespace sba;
    const int tid = threadIdx.x, lane = tid & 63, r32 = lane & 31, hi = lane >> 5; const int wid = __builtin_amdgcn_readfirstlane(tid >> 6);
    const bf16_t* xq = (const bf16_t*)(P.ws + WS_XQ); const bf16_t* gate = (const bf16_t*)(P.ws + WS_GATE); bf16_t* O = (bf16_t*)(P.ws + WS_O);
    const float* MK = P.out + OUT_MK_P; const float* MV = P.out + OUT_MV_P;
    for (int task = blockIdx.x; task < NB * XH * 16; task += gridDim.x) {
        const int qblk = task & 15, h = (task >> 4) & 3, b = task >> 6;
        __syncthreads();
        for (int it = tid; it < 2048; it += 512) {
            const int key = it & 255, ch = it >> 8;
            const float* s = MK + ((size_t)(b * NMEM + key)) * XW + h * 64 + ch * 8;
            const float4 a = *(const float4*)s, c = *(const float4*)(s + 4);
            *(uint4*)(lds + (key >> 6) * 8192 + ch * 1024 + (key & 63) * 16) = make_uint4(pack2(a.x, a.y), pack2(a.z, a.w), pack2(c.x, c.y), pack2(c.z, c.w));
        }
        for (int it = tid; it < 2048; it += 512) {
            const int pl = it & 3, key = (it >> 2) & 255, ph = it >> 10;
            const float* s = MV + ((size_t)(b * NMEM + key)) * XW + h * 64 + ph * 32 + pl * 8;
            const float4 a = *(const float4*)s, c = *(const float4*)(s + 4);
            *(uint4*)(lds + 32768 + (key >> 6) * 8192 + ph * 4096 + (key & 63) * 64 + pl * 16) = make_uint4(pack2(a.x, a.y), pack2(a.z, a.w), pack2(c.x, c.y), pack2(c.z, c.w));
        }
        __syncthreads();
        const size_t row = (size_t)b * SEQ + qblk * 256 + wid * 32 + r32;
        bf16x8 qr[4];
#pragma unroll
        for (int d0 = 0; d0 < 4; ++d0) qr[d0] = *(const bf16x8*)(xq + row * XW + h * 64 + d0 * 16 + hi * 8);
        f32x16 p[8];
#pragma unroll
        for (int i = 0; i < 8; ++i)
#pragma unroll
            for (int r = 0; r < 16; ++r) p[i][r] = 0.f;
        const lds_cptr kp = (lds_cptr)(LAS unsigned char*)lds + hi * 1024 + r32 * 16;
#pragma unroll
        for (int tl = 0; tl < 4; ++tl)
#pragma unroll
            for (int d0 = 0; d0 < 4; ++d0) {
                const bf16x8 ka = *(const __attribute__((address_space(3))) bf16x8*)(kp + tl * 8192 + d0 * 2048);
                const bf16x8 kb = *(const __attribute__((address_space(3))) bf16x8*)(kp + tl * 8192 + d0 * 2048 + 512);
                p[2 * tl] = SBA_MFMA(ka, qr[d0], p[2 * tl]); p[2 * tl + 1] = SBA_MFMA(kb, qr[d0], p[2 * tl + 1]);
            }
        float m = p[0][0];
#pragma unroll
        for (int i = 0; i < 8; ++i)
#pragma unroll
            for (int r = 0; r < 16; ++r) m = fmaxf(m, p[i][r]);
        { const auto sw = __builtin_amdgcn_permlane32_swap(__float_as_uint(m), __float_as_uint(m), false, false); m = fmaxf(__uint_as_float(sw[0]), __uint_as_float(sw[1])); }
        float l = 0.f;
#pragma unroll
        for (int i = 0; i < 8; ++i)
#pragma unroll
            for (int r = 0; r < 16; ++r) { p[i][r] = __builtin_amdgcn_exp2f(p[i][r] - m); l += p[i][r]; }
        { const auto sw = __builtin_amdgcn_permlane32_swap(__float_as_uint(l), __float_as_uint(l), false, false); l = __uint_as_float(sw[0]) + __uint_as_float(sw[1]); }
        f32x16 o0, o1;
#pragma unroll
        for (int r = 0; r < 16; ++r) { o0[r] = 0.f; o1[r] = 0.f; }
        const lds_cptr vp = (lds_cptr)(LAS unsigned char*)lds + 32768 + ((lane >> 4) & 1) * 32 + (lane & 3) * 8 + (4 * hi + ((lane & 15) >> 2)) * 64;
#pragma unroll
        for (int tl = 0; tl < 4; ++tl)
#pragma unroll
            for (int X = 0; X < 4; ++X) {
                const bf16x8 a = pack8(p[2 * tl + (X >> 1)], (X & 1) * 8);
                o0 = SBA_MFMA(vfrag(vp + tl * 8192 + X * 1024), a, o0); o1 = SBA_MFMA(vfrag(vp + tl * 8192 + 4096 + X * 1024), a, o1);
            }
        const float inv = 1.f / l;
        const bf16_t* gr = gate + row * DM + 768 + h * 64; bf16_t* orow = O + row * DM + 768 + h * 64;
#pragma unroll
        for (int half = 0; half < 2; ++half)
#pragma unroll
            for (int g = 0; g < 4; ++g) { const int d = 32 * half + 8 * g + 4 * hi; const uint2 gt = *(const uint2*)(gr + d);
                const f32x16& o = half ? o1 : o0;
                uint2 w; w.x = pack2(o[4 * g] * inv * __uint_as_float(gt.x << 16), o[4 * g + 1] * inv * __uint_as_float(gt.x & 0xffff0000u));
                w.y = pack2(o[4 * g + 2] * inv * __uint_as_float(gt.y << 16), o[4 * g + 3] * inv * __uint_as_float(gt.y & 0xffff0000u));
                *(uint2*)(orow + d) = w; }
    }
    __syncthreads();
}

__device__ __forceinline__ void p3_scan_and_sb(const Params& P, float* lds) {
    const int tid = threadIdx.x, lane = tid & 63, wave = tid >> 6;
    for (int task = blockIdx.x * 8 + wave; task < DB * RH * 16; task += gridDim.x * 8) {
        const int rg = task & 15, bh = task >> 4, b = bh / RH, h = bh % RH;
        scan_rows(P, NTOK + b, 1, h, rg * 4, P.state_wkv + (size_t)bh * HD * HD, P.out + OUT_WKV_S + (size_t)bh * HD * HD, lane);
    }
    if (blockIdx.x < 96) {
        const int bh = blockIdx.x >> 2, quarter = blockIdx.x & 3, b = bh / RH, h = bh % RH;
        volatile LAS unsigned* scw = (volatile LAS unsigned*)((LAS unsigned char*)lds + SC_CTL_OFF);
        if (tid < 5) scw[tid] = 0u;
        __syncthreads();
        scan_prompt_wave(P, (unsigned char*)lds, b, h, quarter);
        if (wave >= 5 + SC_FREE_WAVES) {
            constexpr unsigned NCHU = SEQ / SCH;
            while (scw[1] < NCHU || scw[2] < NCHU || scw[3] < NCHU || scw[4] < NCHU) __builtin_amdgcn_s_sleep(32);
        }
    } else {
        volatile LAS unsigned* qw = (volatile LAS unsigned*)((LAS unsigned char*)lds + LDS_CTL + 16);
        unsigned* qhead = (unsigned*)(P.ws + WS_BAR) + QW_SB;
        unsigned nxt = 0u;
        if (tid == 0) nxt = atomicAdd(qhead, 1u);
        for (;;) {
            if (tid == 0) qw[0] = nxt;
            __syncthreads();
            const unsigned u = qw[0];
            __syncthreads();
            if (u >= 384u) break;
            if (tid == 0) nxt = atomicAdd(qhead, 1u);
            const int qb = 15 - (int)(u / 24u), bh = (int)(u % 24u);
            sba::unit(P, (unsigned char*)lds, bh / SH, bh % SH, qb);
        }
    }
    sb_decode_wave_loop(P, lds);
    __syncthreads();
}

__device__ __forceinline__ void p4_combine(const Params& P, float* lds) {
    const int tid = threadIdx.x, lane = tid & 63, wave = tid >> 6;
    const float* oraw = (const float*)(P.ws + WS_ORAW); const float* RSB = (const float*)(P.ws + WS_RSB);
    const bf16_t* gate = (const bf16_t*)(P.ws + WS_GATE); bf16_t* O = (bf16_t*)(P.ws + WS_O);
    for (int it = blockIdx.x * 512 + tid; it < NTK * RH * 16; it += gridDim.x * 512) {
        const int c = it & 15, th = it >> 4, h = th % RH, tok = th / RH;
        const size_t o = (size_t)tok * RW + h * 64 + 4 * c;
        const float4 v = *(const float4*)(oraw + o);
        const float mean = sum16(v.x + v.y + v.z + v.w) * (1.f / 64.f);
        const float dx = v.x - mean, dy = v.y - mean, dz = v.z - mean, dw = v.w - mean;
        const float var = sum16(dx * dx + dy * dy + dz * dz + dw * dw) * (1.f / 64.f);
        const float rs = rsqrtf(var + GN_EPS);
        const float4 g = *(const float4*)(P.lnx_g + h * 64 + 4 * c), bb = *(const float4*)(P.lnx_b + h * 64 + 4 * c), vv = *(const float4*)(RSB + ((size_t)tok * RH + h) * RSB_BLK + 320 + 4 * c);
        const float rk = RSB[((size_t)tok * RH + h) * RSB_BLK + 386];
        const uint2 gt = *(const uint2*)(gate + (size_t)tok * DM + h * 64 + 4 * c);
        const float r0 = (dx * rs * g.x + bb.x + rk * vv.x) * __uint_as_float(gt.x << 16), r1 = (dy * rs * g.y + bb.y + rk * vv.y) * __uint_as_float(gt.x & 0xffff0000u);
        const float r2 = (dz * rs * g.z + bb.z + rk * vv.z) * __uint_as_float(gt.y << 16), r3 = (dw * rs * g.w + bb.w + rk * vv.w) * __uint_as_float(gt.y & 0xffff0000u);
        uint2 w; w.x = pack2(r0, r1); w.y = pack2(r2, r3);
        *(uint2*)(O + (size_t)tok * DM + h * 64 + 4 * c) = w;
    }
    const float* dpart = (const float*)(P.ws + WS_DPART); const float* dl = (const float*)(P.ws + WS_DL);
    float* coef = lds + wave * 128;
    for (int task = blockIdx.x * 8 + wave; task < DB * SH; task += gridDim.x * 8) {
        const int b = task / SH, h = task % SH;
        const float L0 = dl[(size_t)(b * NPAGES + 2 * lane) * SH + h], L1 = dl[(size_t)(b * NPAGES + 2 * lane + 1) * SH + h];
        float incl = L0 + L1;
#pragma unroll
        for (int off = 1; off < 64; off <<= 1) { const float t = __shfl_down(incl, off); if (lane + off < 64) incl += t; }
        const float excl = incl - (L0 + L1);
        coef[2 * lane] = exp2f(-(excl + L1)); coef[2 * lane + 1] = exp2f(-excl);
        asm volatile("s_waitcnt lgkmcnt(0)" ::: "memory");
        __builtin_amdgcn_wave_barrier();
        float o = 0.f;
#pragma unroll 16
        for (int j = 0; j < NPAGES; ++j) o += coef[j] * dpart[((size_t)(b * NPAGES + j) * SH + h) * HD + lane];
        const size_t row = NTOK + b;
        O[row * DM + 384 + h * 64 + lane] = f2bf(o * bf2f(gate[row * DM + 384 + h * 64 + lane]));
        __builtin_amdgcn_wave_barrier();
    }
    for (int i = blockIdx.x * 512 + tid; i < (ROWS_P - NTK) * DM / 4; i += gridDim.x * 512) *(uint2*)(O + (size_t)NTK * DM + (size_t)i * 4) = make_uint2(0u, 0u);
}

__device__ __forceinline__ void p5_sample_out(const Params& P) {
    const int tid = threadIdx.x, row = tid >> 4, kq = tid & 15;
    const bf16_t* O = (const bf16_t*)(P.ws + WS_O) + (size_t)(NTOK + row) * DM + kq * 64;
    const bf16_t* Bt2 = (const bf16_t*)(P.ws + WS_BT2);
    float* yun = (float*)(P.ws + WS_YUN);
    for (int cb = blockIdx.x; cb < DM / 4; cb += gridDim.x) {
        float acc[4] = {0.f, 0.f, 0.f, 0.f};
#pragma unroll
        for (int k8 = 0; k8 < 8; ++k8) {
            const uint4 ov = *(const uint4*)(O + k8 * 8); const unsigned oo[4] = {ov.x, ov.y, ov.z, ov.w};
#pragma unroll
            for (int c = 0; c < 4; ++c) { const uint4 wv = *(const uint4*)(Bt2 + (size_t)(cb * 4 + c) * DM + kq * 64 + k8 * 8); const unsigned ww[4] = {wv.x, wv.y, wv.z, wv.w};
#pragma unroll
                for (int j = 0; j < 4; ++j) acc[c] += __uint_as_float(oo[j] << 16) * __uint_as_float(ww[j] << 16) + __uint_as_float(oo[j] & 0xffff0000u) * __uint_as_float(ww[j] & 0xffff0000u); }
        }
#pragma unroll
        for (int c = 0; c < 4; ++c) acc[c] = sum16(acc[c]);
        if (kq == 0) { const size_t o = (size_t)(NTOK + row) * DM + cb * 4; const float4 xv = *(const float4*)(P.x_sample + (size_t)row * DM + cb * 4);
            *(float4*)(yun + o) = make_float4(xv.x + acc[0], xv.y + acc[1], xv.z + acc[2], xv.w + acc[3]); }
    }
}

__device__ __forceinline__ void p6_final_norm(const Params& P) {
    const int tid = threadIdx.x, lane = tid & 63, wave = tid >> 6;
    const float* yun = (const float*)(P.ws + WS_YUN);
    const int gw = blockIdx.x * 8 + wave, nw = gridDim.x * 8;
    for (int r0 = gw; r0 < NTK; r0 += 2 * nw) {
        float4 x[2][4]; float ss[2] = {0.f, 0.f}; bool live[2]; float* dsts[2];
#pragma unroll
        for (int q = 0; q < 2; ++q) { const int r = r0 + q * nw; live[q] = r < NTK; const int rr = live[q] ? r : 0;
            dsts[q] = rr < NTOK ? P.out + OUT_Y_P + (size_t)rr * DM : P.out + OUT_Y_S + (size_t)(rr - NTOK) * DM;
#pragma unroll
            for (int j = 0; j < 4; ++j) x[q][j] = *(const float4*)(yun + (size_t)rr * DM + 4 * lane + 256 * j); }
#pragma unroll
        for (int q = 0; q < 2; ++q) {
#pragma unroll
            for (int j = 0; j < 4; ++j) ss[q] += x[q][j].x * x[q][j].x + x[q][j].y * x[q][j].y + x[q][j].z * x[q][j].z + x[q][j].w * x[q][j].w;
            ss[q] = wave_sum_fast(ss[q]); }
#pragma unroll
        for (int q = 0; q < 2; ++q) { if (!live[q]) continue;
            const float rs = rsqrtf(ss[q] * (1.f / DM) + NORM_EPS);
#pragma unroll
            for (int j = 0; j < 4; ++j) { const float4 gg = *(const float4*)(P.final_norm_g + 4 * lane + 256 * j);
                *(float4*)(dsts[q] + 4 * lane + 256 * j) = make_float4(x[q][j].x * rs * gg.x, x[q][j].y * rs * gg.y, x[q][j].z * rs * gg.z, x[q][j].w * rs * gg.w); } }
    }
}

constexpr int NPHASE = 7;
__global__ void __launch_bounds__(512, 2) mk_fwd(Params P) {
    extern __shared__ __attribute__((aligned(16))) unsigned char lds[];
    volatile LAS unsigned* xbw = (volatile LAS unsigned*)((LAS unsigned char*)lds + LDS_CTL);
    if (threadIdx.x < 4) xbw[threadIdx.x] = 0u;
    __syncthreads();
    XcdBarrier bar; bar.bar = (unsigned*)(P.ws + WS_BAR); bar.x = 0; bar.st = xbw;
#if MK_N_LAUNCHES == 1
    bar = xcd_barrier_post((unsigned*)(P.ws + WS_BAR), xbw);
#endif
    const int lo = P.ph_lo, hi = P.ph_hi;
#define IN(k) (lo <= (k) && (k) < hi)
#define SEAM(k) do { if (IN(k) && IN((k) + 1)) xcd_barrier(bar); } while (0)
    float* ldsf = (float*)lds;
    if (IN(0)) { for (int rep = 0; rep < NREP(0); ++rep) p0_prologue(P, ldsf); }
    SEAM(0);
    if (IN(1)) {
        pg8::Gemm g{(const bf16_t*)(P.ws + WS_A1), (const bf16_t*)(P.ws + WS_BT1), MROWS1, NB1, DM};
        pg8::GridOrder S; S.init(65, 15, 8, 65, 15, 2, (int)gridDim.x, (int)((blockIdx.x % 8) * (gridDim.x / 8) + blockIdx.x / 8));
        EpiG1 E{(bf16_t*)(P.ws + WS_PRW), (bf16_t*)(P.ws + WS_QB), (bf16_t*)(P.ws + WS_KB), (bf16_t*)(P.ws + WS_VB), (bf16_t*)(P.ws + WS_XQ), (bf16_t*)(P.ws + WS_GATE), P.out};
        for (int rep = 0; rep < NREP(1); ++rep) pg8::gemm_phase<EpiG1, pg8::GridOrder>((PG8_LAS unsigned char*)lds, g, S, E);
    }
    SEAM(1);
    if (IN(2)) {
        for (int rep = 0; rep < NREP(20); ++rep) p2_rwkv_prep(P, ldsf);
        for (int rep = 0; rep < NREP(21); ++rep) p2_xattn_prompt(P, lds);
        for (int rep = 0; rep < NREP(22); ++rep) p2_xattn_sample(P, ldsf);
    }
    SEAM(2);
    if (IN(3)) { p3_scan_and_sb(P, ldsf); }
    SEAM(3);
    if (IN(4)) { for (int rep = 0; rep < NREP(4); ++rep) p4_combine(P, ldsf); }
    SEAM(4);
    if (IN(5)) {
        pg8::Gemm g{(const bf16_t*)(P.ws + WS_O), (const bf16_t*)(P.ws + WS_BT2), NTOK, DM, DM};
        pg8::GridOrder S; S.init(64, 4, 0, 0, 0, 1, (int)gridDim.x, (int)((blockIdx.x % 8) * (gridDim.x / 8) + blockIdx.x / 8));
        EpiG2 E{P.x_prompt, P.x_sample, (float*)(P.ws + WS_YUN)};
        for (int rep = 0; rep < NREP(5); ++rep) pg8::gemm_phase<EpiG2, pg8::GridOrder>((PG8_LAS unsigned char*)lds, g, S, E);
        p5_sample_out(P);
    }
    SEAM(5);
    if (IN(6)) { for (int rep = 0; rep < NREP(6); ++rep) p6_final_norm(P); }
#undef IN
#undef SEAM
}

extern "C" void kernel_launch(void* const* d_in, const int* in_sizes, int n_in, void* d_out, int out_size, void* d_ws, size_t ws_size, hipStream_t stream) {
    static int grid = 0;
    if (grid == 0) {
        if (n_in != 28 || (size_t)out_size != OUT_END || ws_size < WS_END) { fprintf(stderr, "kernel_launch: unexpected shapes: n_in %d out %d (want %zu) ws %zu (want %zu)\n", n_in, out_size, (size_t)OUT_END, ws_size, (size_t)WS_END); grid = -1; return; }
        int dev = 0, cus = 0, per_cu = 0;
        if (hipGetDevice(&dev) != hipSuccess || hipDeviceGetAttribute(&cus, hipDeviceAttributeMultiprocessorCount, dev) != hipSuccess) { grid = -1; return; }
        if (hipFuncSetAttribute((const void*)mk_fwd, hipFuncAttributeMaxDynamicSharedMemorySize, LDS_BYTES) != hipSuccess) { fprintf(stderr, "kernel_launch: hipFuncSetAttribute failed\n"); grid = -1; return; }
        if (hipOccupancyMaxActiveBlocksPerMultiprocessor(&per_cu, (const void*)mk_fwd, 512, LDS_BYTES) != hipSuccess || per_cu < 1) fprintf(stderr, "kernel_launch: occupancy query says %d\n", per_cu);
        (void)hipGetLastError();
        grid = cus;
        if (grid % 8 != 0) grid -= grid % 8;
    }
    if (grid < 0) return;
    (void)hipMemsetAsync((char*)d_ws + WS_BAR, 0, 16384, stream);
    Params P{};
    P.x_prompt = (const float*)d_in[0]; P.mem_prompt = (const float*)d_in[1]; P.x_sample = (const float*)d_in[2]; P.cache_k = (const float*)d_in[3]; P.cache_v = (const float*)d_in[4];
    P.page_table = (const int*)d_in[5]; P.state_wkv = (const float*)d_in[6]; P.state_shift = (const float*)d_in[7]; P.cmem_k = (const float*)d_in[8]; P.cmem_v = (const float*)d_in[9];
    P.norm_g = (const float*)d_in[10]; P.w_in = (const float*)d_in[11]; P.sb_bias = (const float*)d_in[12]; P.mu_shift = (const float*)d_in[13]; P.w0 = (const float*)d_in[14];
    P.w_lora_b = (const float*)d_in[15]; P.a0 = (const float*)d_in[16]; P.a_lora_b = (const float*)d_in[17]; P.k_k = (const float*)d_in[18]; P.k_a = (const float*)d_in[19]; P.r_k = (const float*)d_in[20];
    P.lnx_g = (const float*)d_in[21]; P.lnx_b = (const float*)d_in[22]; P.mem_norm_g = (const float*)d_in[23]; P.w_mem_k = (const float*)d_in[24]; P.w_mem_v = (const float*)d_in[25];
    P.w_out = (const float*)d_in[26]; P.final_norm_g = (const float*)d_in[27];
    P.out = (float*)d_out; P.ws = (unsigned char*)d_ws;
#if MK_N_LAUNCHES == 1
    P.ph_lo = 0; P.ph_hi = NPHASE;
    hipLaunchKernelGGL(mk_fwd, dim3(grid), dim3(512), LDS_BYTES, stream, P);
#else
    for (int ph = 0; ph < NPHASE; ++ph) { P.ph_lo = ph; P.ph_hi = ph + 1; hipLaunchKernelGGL(mk_fwd, dim3(grid), dim3(512), LDS_BYTES, stream, P); }
#endif
    const hipError_t le = hipPeekAtLastError();
    if (le != hipSuccess) fprintf(stderr, "kernel_launch: launch failed: %s\n", hipGetErrorName(le));
}
```

```cpp
#include <hip/hip_runtime.h>
#include <cstdio>
#include <cstdint>

#ifndef MK_REP
#define MK_REP -1
#endif
#define NREP(id) ((MK_REP) == (id) ? 2 : 1)
#ifndef MK_N_LAUNCHES
#define MK_N_LAUNCHES 1
#endif

constexpr int DM = 1024, NB = 4, SEQ = 4096, NTOK = NB * SEQ, DB = 32, NPAGES = 128, PAGE = 128;
constexpr int HD = 64, RH = 6, SH = 6, XH = 4, NMEM = 256;
constexpr int RW = 384, SBW = 384, XW = 256, RCOLS = 1280, DIN = 3712;
constexpr int NTK = NTOK + DB;
constexpr int ROWS_P = 16640;
constexpr int MEMROW0 = 16640;
constexpr int MROWS1 = 17664;
constexpr int NB1 = 4352;
constexpr float LOG2E = 1.4426950408889634f, QSCALE = 0.125f * 1.4426950408889634f;
constexpr float NORM_EPS = 1e-6f, GN_EPS = 64e-5f, DECAY_SCALE = 0.60653065971263342f;

constexpr size_t OUT_Y_P = 0;
constexpr size_t OUT_Y_S = OUT_Y_P + (size_t)NTOK * DM;
constexpr size_t OUT_SBK_P = OUT_Y_S + (size_t)DB * DM;
constexpr size_t OUT_SBV_P = OUT_SBK_P + (size_t)NTOK * SBW;
constexpr size_t OUT_WKV_P = OUT_SBV_P + (size_t)NTOK * SBW;
constexpr size_t OUT_SHIFT_P = OUT_WKV_P + (size_t)NB * RH * HD * HD;
constexpr size_t OUT_MK_P = OUT_SHIFT_P + (size_t)NB * RCOLS;
constexpr size_t OUT_MV_P = OUT_MK_P + (size_t)NB * NMEM * XW;
constexpr size_t OUT_SBK_S = OUT_MV_P + (size_t)NB * NMEM * XW;
constexpr size_t OUT_SBV_S = OUT_SBK_S + (size_t)DB * SBW;
constexpr size_t OUT_WKV_S = OUT_SBV_S + (size_t)DB * SBW;
constexpr size_t OUT_SHIFT_S = OUT_WKV_S + (size_t)DB * RH * HD * HD;
constexpr size_t OUT_END = OUT_SHIFT_S + (size_t)DB * RCOLS;

constexpr size_t al256(size_t x) { return (x + 255) & ~(size_t)255; }
constexpr size_t WS_BAR = 0;
constexpr size_t WS_A1 = 16384;
constexpr size_t WS_BT1 = WS_A1 + al256((size_t)MROWS1 * DM * 2);
constexpr size_t WS_BT2 = WS_BT1 + al256((size_t)NB1 * DM * 2);
constexpr size_t WS_PRW = WS_BT2 + al256((size_t)DM * DM * 2);
constexpr size_t WS_QB = WS_PRW + al256((size_t)ROWS_P * RCOLS * 2);
constexpr size_t WS_KB = WS_QB + al256((size_t)ROWS_P * SBW * 2);
constexpr size_t WS_VB = WS_KB + al256((size_t)ROWS_P * SBW * 2);
constexpr size_t WS_XQ = WS_VB + al256((size_t)ROWS_P * SBW * 2);
constexpr size_t WS_GATE = WS_XQ + al256((size_t)ROWS_P * XW * 2);
constexpr int RSB_BLK = 388;
constexpr size_t WS_RSB = WS_GATE + al256((size_t)ROWS_P * DM * 2);
constexpr size_t WS_ORAW = WS_RSB + al256((size_t)NTK * RH * RSB_BLK * 4);
constexpr size_t WS_O = WS_ORAW + al256((size_t)NTK * RW * 4);
constexpr size_t WS_YUN = WS_O + al256((size_t)ROWS_P * DM * 2);
constexpr size_t WS_DPART = WS_YUN + al256((size_t)ROWS_P * DM * 4);
constexpr size_t WS_DL = WS_DPART + al256((size_t)DB * NPAGES * SH * HD * 4);
constexpr size_t WS_LFRAG = WS_DL + al256((size_t)DB * NPAGES * SH * 4);
constexpr size_t WS_END = WS_LFRAG + al256((size_t)2 * 2 * 6 * 4 * 2 * 64 * 16);

constexpr int LDS_STAGE = 131072;
constexpr int LDS_CTL = 155648;
constexpr int LDS_BYTES = LDS_CTL + 1024;

typedef unsigned short bf16_t;

#define XB_TMO      128
#define XB_XCNT(j)  (256  + 64 * (j))
#define XB_XSUB(j)  (1280 + 64 * (j))
#define XB_XGEN(j)  (2304 + 64 * (j))
#define XB_TOP      3328
#define XB_TOPGEN   3392
#define XCD_BAR_WORDS 3456
#define XB_SPIN_CAP (1u << 18)
#define LAS __attribute__((address_space(3)))

__device__ __forceinline__ unsigned xb_ld(unsigned* p)              { return __hip_atomic_load(p, __ATOMIC_RELAXED, __HIP_MEMORY_SCOPE_AGENT); }
__device__ __forceinline__ unsigned xb_add(unsigned* p, unsigned v) { return __hip_atomic_fetch_add(p, v, __ATOMIC_RELAXED, __HIP_MEMORY_SCOPE_AGENT); }
__device__ __forceinline__ unsigned xb_xcc_id() { return (unsigned)__builtin_amdgcn_s_getreg((3 << 11) | 20) & 0xFu; }
#define XB_SPIN(cond, bar) do { unsigned _sp = 0; while (cond) { __builtin_amdgcn_s_sleep(1); \
    if ((++_sp & 255u) == 0u) { if (xb_ld(&(bar)[XB_TMO])) break; if (_sp > XB_SPIN_CAP) { atomicAdd(&(bar)[XB_TMO], 1u); break; } } } } while (0)

struct XcdBarrier {
    unsigned* bar; unsigned x;
    volatile LAS unsigned* st;
};
__device__ __forceinline__ XcdBarrier xcd_barrier_post(unsigned* bar, volatile LAS unsigned* st) {
    XcdBarrier b; b.bar = bar; b.x = xb_xcc_id(); b.st = st;
    if (threadIdx.x == 0) (void)xb_add(&bar[XB_XCNT(b.x)], 1u);
    return b;
}
__device__ __forceinline__ void xcd_barrier_complete(unsigned* bar, unsigned x, unsigned& nloc, unsigned& nx) {
    const unsigned G = gridDim.x * gridDim.y * gridDim.z;
    unsigned sum, cnt, mine, sp = 0u;
    for (;;) {
        sum = 0u; cnt = 0u; mine = 0u;
#pragma unroll
        for (unsigned j = 0; j < 16; ++j) { const unsigned c = xb_ld(&bar[XB_XCNT(j)]); sum += c; cnt += (c > 0u) ? 1u : 0u; mine = (j == x) ? c : mine; }
        if (sum == G) break;
        __builtin_amdgcn_s_sleep(1);
        if ((++sp & 255u) == 0u) { if (xb_ld(&bar[XB_TMO])) break; if (sp > XB_SPIN_CAP) { atomicAdd(&bar[XB_TMO], 1u); break; } }
    }
    nloc = mine > 0u ? mine : 1u; nx = cnt > 0u ? cnt : 1u;
}
__device__ __forceinline__ void xcd_barrier(const XcdBarrier& b) {
    asm volatile("s_waitcnt vmcnt(0)" ::: "memory");
    __syncthreads();
    if (threadIdx.x == 0) {
        unsigned* bar = b.bar;
        __builtin_amdgcn_s_waitcnt(0);
        unsigned nloc = b.st[0], nx = b.st[1];
        if (nloc == 0u) { xcd_barrier_complete(bar, b.x, nloc, nx); b.st[0] = nloc; b.st[1] = nx; }
        const unsigned old = xb_add(&bar[XB_XSUB(b.x)], 1u);
        const unsigned gen = old / nloc;
        if (old + 1u == (gen + 1u) * nloc) {
            __builtin_amdgcn_fence(__ATOMIC_RELEASE, "agent");
            asm volatile("s_waitcnt vmcnt(0)" ::: "memory");
            const unsigned og = xb_add(&bar[XB_TOP], 1u);
            const unsigned tg = og / nx;
            if (og + 1u == (tg + 1u) * nx) xb_add(&bar[XB_TOPGEN], 1u);
            else XB_SPIN(xb_ld(&bar[XB_TOPGEN]) == tg, bar);
            __builtin_amdgcn_fence(__ATOMIC_ACQUIRE, "agent");
            xb_add(&bar[XB_XGEN(b.x)], 1u);
            asm volatile("s_waitcnt vmcnt(0)" ::: "memory");
        } else {
            XB_SPIN(xb_ld(&bar[XB_XGEN(b.x)]) == gen, bar);
            __builtin_amdgcn_fence(__ATOMIC_ACQUIRE, "agent");
            asm volatile("s_waitcnt vmcnt(0)" ::: "memory");
        }
    }
    __syncthreads();
}

namespace pg8 {
#define PG8_LAS __attribute__((address_space(3)))
typedef short bf16x8 __attribute__((ext_vector_type(8)));
typedef float f32x4 __attribute__((ext_vector_type(4)));
typedef unsigned u32x4 __attribute__((ext_vector_type(4)));
constexpr int BM = 256, BK = 64, HALF = 128, HTB = HALF * BK * 2, STAGE_BYTES = 8 * HTB, NXCD = 8, WGM = 8;

__host__ __device__ __forceinline__ int lds_byte(int r, int c) { const int st = (r >> 4) * 2 + (c >> 5), rr = r & 15, cc = c & 31, ob = rr * 64 + cc * 2; return st * 1024 + (ob ^ (((ob >> 9) & 1) << 5)); }
__host__ __device__ __forceinline__ void stage_rc(int b, int& R, int& C) { const int st = b / 1024, sb = b % 1024, swz = sb ^ (((sb >> 9) & 1) << 5); R = (st >> 1) * 16 + swz / 64; C = (st & 1) * 32 + (swz % 64) / 2; }
__host__ __device__ __forceinline__ int perm32(int rho) { const int n = rho >> 4, i = rho & 15; return 8 * (i >> 2) + 4 * n + (i & 3); }

struct Unit { int pm, pn; };
struct Gemm { const bf16_t* A; const bf16_t* Bt; int M, N, K; };

struct GridOrder {
    int nM, nN, nmain, nextra, xm0, xn0, xnn, G, c;
    __device__ void init(int nM_, int nN_, int nextra_, int xm0_, int xn0_, int xnn_, int G_, int c_) { nM = nM_; nN = nN_; nmain = nM_ * nN_; nextra = nextra_; xm0 = xm0_; xn0 = xn0_; xnn = xnn_; G = G_; c = c_; }
    __device__ bool next(int i, Unit& u) const {
        const int L = i * G + c; if (L >= nmain + nextra) return false;
        if (L >= nmain) { const int e = L - nmain; u.pm = xm0 + e / xnn; u.pn = xn0 + e % xnn; return true; }
        const int wgid = L;
        const int nig = WGM * nN, gid = wgid / nig, fm = gid * WGM, gsz = (nM - fm) < WGM ? (nM - fm) : WGM;
        u.pm = fm + ((wgid % nig) % gsz); u.pn = (wgid % nig) / gsz; return true;
    }
    __device__ __forceinline__ void a_ready(const Unit&) const {}
    __device__ __forceinline__ void done(const Unit&) const {}
};

template <class Epi, class Sched>
__device__ __forceinline__ void gemm_phase(PG8_LAS unsigned char* lds, const Gemm g, const Sched& S, const Epi& E) {
    const int tid = threadIdx.x, wid = __builtin_amdgcn_readfirstlane(tid >> 6), lane = tid & 63, wr = wid >> 2, wc = wid & 3, fr = lane & 15, fq = lane >> 4;
    const int K = g.K, nt = K / BK;
    unsigned voffA[2], voffB[2];
#pragma unroll
    for (int i = 0; i < 2; ++i) { int R, C; stage_rc(tid * 16 + i * 8192, R, C); const int Rb = Epi::PERM ? ((R & ~31) + perm32(R & 31)) : R;
        voffA[i] = (unsigned)(R * K + C) * 2u; voffB[i] = (unsigned)(Rb * K + C) * 2u; }
    const size_t kstep = (size_t)(BK * 2);
    const size_t hstep = (size_t)HALF * K * 2;
    const size_t tstep = 2 * hstep;
    const unsigned ldsw = (unsigned)wid * 1024u;
    const int aoff = lds_byte(wr * 64 + fr, fq * 8), boff = lds_byte(wc * 32 + fr, fq * 8);
#define PG8_SA(b, h) (((b) * 2 + (h)) * HTB)
#define PG8_SB(b, h) ((4 + (b) * 2 + (h)) * HTB)
#define PG8_STAGE(bufoff, gbase, voff) do { _Pragma("unroll") for (int _i = 0; _i < 2; ++_i) \
        __builtin_amdgcn_global_load_lds((const unsigned*)((const char*)(gbase) + (voff)[_i]), (PG8_LAS unsigned*)(lds + (bufoff) + ldsw + _i * 8192), 16, 0, 0); } while (0)
#define PG8_LDA(dst, b, h) do { _Pragma("unroll") for (int m = 0; m < 4; ++m) _Pragma("unroll") for (int k = 0; k < 2; ++k) dst[m][k] = *(const PG8_LAS bf16x8*)(lds + PG8_SA(b, h) + aoff + m * 2048 + k * 1024); } while (0)
#define PG8_LDB(dst, b, h) do { _Pragma("unroll") for (int n = 0; n < 2; ++n) _Pragma("unroll") for (int k = 0; k < 2; ++k) dst[n][k] = *(const PG8_LAS bf16x8*)(lds + PG8_SB(b, h) + boff + n * 2048 + k * 1024); } while (0)
#define PG8_MMA(ai, bj, At, Bt) do { __builtin_amdgcn_s_setprio(1); _Pragma("unroll") for (int m = 0; m < 4; ++m) _Pragma("unroll") for (int n = 0; n < 2; ++n) _Pragma("unroll") for (int k = 0; k < 2; ++k) \
        acc[ai][bj][m][n] = __builtin_amdgcn_mfma_f32_16x16x32_bf16(Bt[n][k], At[m][k], acc[ai][bj][m][n], 0, 0, 0); __builtin_amdgcn_s_setprio(0); } while (0)
#define PG8_WAIT_V(n) asm volatile("s_waitcnt vmcnt(" #n ")" ::: "memory")
#define PG8_WAIT_L(n) asm volatile("s_waitcnt lgkmcnt(" #n ")" ::: "memory")
#define PG8_BAR __builtin_amdgcn_s_barrier()
#define PG8_SCHED __builtin_amdgcn_sched_barrier(0)
    Unit cur, nxt; int ui = 0;
    if (!S.next(0, cur)) return;
    f32x4 acc[2][2][4][2];
#pragma unroll
    for (int a = 0; a < 2; ++a)
#pragma unroll
        for (int b = 0; b < 2; ++b)
#pragma unroll
            for (int m = 0; m < 4; ++m)
#pragma unroll
                for (int n = 0; n < 2; ++n) acc[a][b][m][n] = (f32x4){0.f, 0.f, 0.f, 0.f};
    bf16x8 At[4][2], B0[2][2], B1[2][2];
    const char* cA = (const char*)g.A + (size_t)cur.pm * tstep; const char* cB = (const char*)g.Bt + (size_t)cur.pn * tstep;
    S.a_ready(cur);
    PG8_STAGE(PG8_SB(0, 0), cB, voffB); PG8_STAGE(PG8_SA(0, 0), cA, voffA); PG8_STAGE(PG8_SB(0, 1), cB + hstep, voffB); PG8_STAGE(PG8_SA(0, 1), cA + hstep, voffA);
    if (wr == 1) PG8_BAR;
    PG8_WAIT_V(4); PG8_BAR;
    PG8_STAGE(PG8_SB(1, 0), cB + kstep, voffB); PG8_STAGE(PG8_SA(1, 0), cA + kstep, voffA); PG8_STAGE(PG8_SB(1, 1), cB + hstep + kstep, voffB);
    PG8_WAIT_V(6); PG8_BAR;
    for (;;) {
        const bool has_next = S.next(ui + 1, nxt);
        const char* nA = has_next ? (const char*)g.A + (size_t)nxt.pm * tstep : cA; const char* nB = has_next ? (const char*)g.Bt + (size_t)nxt.pn * tstep : cB;
        for (int t = 0; t < nt; t += 2) {
            const bool last = (t == nt - 2);
            const char* a1 = cA + (size_t)(t + 1) * kstep;
            const char* a2 = last ? nA : cA + (size_t)(t + 2) * kstep; const char* b2 = last ? nB : cB + (size_t)(t + 2) * kstep;
            const char* a3 = a2 + kstep; const char* b3 = b2 + kstep;
            if (last && has_next) S.a_ready(nxt);
            PG8_LDB(B0, 0, 0); PG8_SCHED; PG8_LDA(At, 0, 0); PG8_STAGE(PG8_SA(1, 1), a1 + hstep, voffA);
            PG8_WAIT_L(8); PG8_BAR; PG8_WAIT_L(0); PG8_MMA(0, 0, At, B0); PG8_BAR; PG8_SCHED;
            PG8_LDB(B1, 0, 1); PG8_STAGE(PG8_SB(0, 0), b2, voffB);
            PG8_BAR; PG8_WAIT_L(0); PG8_MMA(0, 1, At, B1); PG8_BAR;
            PG8_LDA(At, 0, 1); PG8_STAGE(PG8_SA(0, 0), a2, voffA);
            PG8_BAR; PG8_WAIT_L(0); PG8_MMA(1, 0, At, B0); PG8_BAR; PG8_SCHED;
            PG8_STAGE(PG8_SB(0, 1), b2 + hstep, voffB);
            PG8_WAIT_V(6); PG8_BAR; PG8_MMA(1, 1, At, B1); PG8_BAR;
            PG8_LDB(B0, 1, 0); PG8_SCHED; PG8_LDA(At, 1, 0); PG8_STAGE(PG8_SA(0, 1), a2 + hstep, voffA);
            PG8_WAIT_L(8); PG8_BAR; PG8_WAIT_L(0); PG8_MMA(0, 0, At, B0); PG8_BAR; PG8_SCHED;
            PG8_LDB(B1, 1, 1); PG8_STAGE(PG8_SB(1, 0), b3, voffB);
            PG8_BAR; PG8_WAIT_L(0); PG8_MMA(0, 1, At, B1); PG8_BAR;
            PG8_LDA(At, 1, 1); PG8_STAGE(PG8_SA(1, 0), a3, voffA);
            PG8_BAR; PG8_WAIT_L(0); PG8_MMA(1, 0, At, B0); PG8_BAR; PG8_SCHED;
            PG8_STAGE(PG8_SB(1, 1), b3 + hstep, voffB);
            PG8_WAIT_V(6); PG8_BAR; PG8_MMA(1, 1, At, B1); PG8_BAR;
        }
        E(acc, cur, wr, wc, fr, fq); S.done(cur);
        if (!has_next) break;
#pragma unroll
        for (int a = 0; a < 2; ++a)
#pragma unroll
            for (int b = 0; b < 2; ++b)
#pragma unroll
                for (int m = 0; m < 4; ++m)
#pragma unroll
                    for (int n = 0; n < 2; ++n) acc[a][b][m][n] = (f32x4){0.f, 0.f, 0.f, 0.f};
        cur = nxt; cA = nA; cB = nB; ++ui;
    }
    PG8_WAIT_V(0);
    if (wr == 0) PG8_BAR;
    PG8_BAR;
#undef PG8_SA
#undef PG8_SB
#undef PG8_STAGE
#undef PG8_LDA
#undef PG8_LDB
#undef PG8_MMA
#undef PG8_WAIT_V
#undef PG8_WAIT_L
#undef PG8_BAR
#undef PG8_SCHED
}
}

typedef float f32x4 __attribute__((ext_vector_type(4)));
__device__ __forceinline__ float bf2f(bf16_t b) { return __uint_as_float(((unsigned)b) << 16); }
__device__ __forceinline__ bf16_t f2bf(float f) { unsigned u = __float_as_uint(f); u += 0x7FFFu + ((u >> 16) & 1u); return (bf16_t)(u >> 16); }
typedef __bf16 bf16x2_t __attribute__((ext_vector_type(2)));
typedef float f32x2_t __attribute__((ext_vector_type(2)));
__device__ __forceinline__ unsigned pack2(float lo, float hi) { const f32x2_t v = {lo, hi}; return __builtin_bit_cast(unsigned, __builtin_convertvector(v, bf16x2_t)); }
__device__ __forceinline__ float wave_sum(float v) {
#pragma unroll
    for (int o = 32; o >= 1; o >>= 1) v += __shfl_xor(v, o);
    return v;
}
__device__ __forceinline__ float wave_max(float v) {
#pragma unroll
    for (int o = 32; o >= 1; o >>= 1) v = fmaxf(v, __shfl_xor(v, o));
    return v;
}
template <int CTRL> __device__ __forceinline__ float dpp_f(float x) { return __builtin_bit_cast(float, __builtin_amdgcn_update_dpp(0, __builtin_bit_cast(int, x), CTRL, 0xF, 0xF, true)); }
__device__ __forceinline__ float sum16(float v) {
    v += dpp_f<0xB1>(v);
    v += dpp_f<0x4E>(v);
    v += dpp_f<0x124>(v);
    v += dpp_f<0x128>(v);
    return v;
}
__device__ __forceinline__ float wave_sum_fast(float v) {
    v = sum16(v);
    { const auto s = __builtin_amdgcn_permlane16_swap(__float_as_uint(v), __float_as_uint(v), false, false); v = __uint_as_float(s[0]) + __uint_as_float(s[1]); }
    { const auto s = __builtin_amdgcn_permlane32_swap(__float_as_uint(v), __float_as_uint(v), false, false); v = __uint_as_float(s[0]) + __uint_as_float(s[1]); }
    return v;
}
__device__ __forceinline__ float sigmoidf_(float x) { return 1.f / (1.f + __expf(-x)); }
__device__ __forceinline__ float softplusf_(float z) { return fmaxf(z, 0.f) + log1pf(__expf(-fabsf(z))); }
__device__ __forceinline__ float softplus2_(float z2) { return fmaxf(z2, 0.f) + log1pf(exp2f(-fabsf(z2))) * LOG2E; }

struct Params {
    const float *x_prompt, *mem_prompt, *x_sample, *cache_k, *cache_v; const int* page_table;
    const float *state_wkv, *state_shift, *cmem_k, *cmem_v, *norm_g, *w_in, *sb_bias, *mu_shift, *w0, *w_lora_b, *a0, *a_lora_b, *k_k, *k_a, *r_k,
        *lnx_g, *lnx_b, *mem_norm_g, *w_mem_k, *w_mem_v, *w_out, *final_norm_g;
    float* out; unsigned char* ws;
    int ph_lo, ph_hi;
};

struct EpiG1 {
    static constexpr bool PERM = true;
    bf16_t* prw; bf16_t *qb, *kb, *vb, *xq, *gate; float* out;
    __device__ __forceinline__ void operator()(const pg8::f32x4 (&acc)[2][2][4][2], const pg8::Unit& u, int wr, int wc, int fr, int fq) const {
        if (u.pm >= 65) {
            float* dst = out + (u.pn == 15 ? OUT_MK_P : OUT_MV_P);
#pragma unroll
            for (int ai = 0; ai < 2; ++ai)
#pragma unroll
                for (int m = 0; m < 4; ++m) { const int row = (u.pm - 65) * 256 + ai * 128 + wr * 64 + m * 16 + fr;
#pragma unroll
                    for (int bj = 0; bj < 2; ++bj) { const int col = bj * 128 + wc * 32 + 8 * fq;
                        *(pg8::f32x4*)(dst + (size_t)row * 256 + col) = acc[ai][bj][m][0]; *(pg8::f32x4*)(dst + (size_t)row * 256 + col + 4) = acc[ai][bj][m][1]; } }
            return;
        }
#pragma unroll
        for (int bj = 0; bj < 2; ++bj) {
            const int cb = u.pn * 256 + bj * 128;
            if (cb >= DIN) continue;
#pragma unroll
            for (int ai = 0; ai < 2; ++ai)
#pragma unroll
                for (int m = 0; m < 4; ++m) { const int row = u.pm * 256 + ai * 128 + wr * 64 + m * 16 + fr;
                    if (row >= NTK) continue;
                    const int col = cb + wc * 32 + 8 * fq; const pg8::f32x4 v0 = acc[ai][bj][m][0], v1 = acc[ai][bj][m][1];
                    if (cb < 1280) {
                        *(uint4*)(prw + (size_t)row * RCOLS + col) = make_uint4(pack2(v0[0], v0[1]), pack2(v0[2], v0[3]), pack2(v1[0], v1[1]), pack2(v1[2], v1[3]));
                        if (row >= NTOK) { float* e = out + OUT_SHIFT_S + (size_t)(row - NTOK) * RCOLS + col; *(pg8::f32x4*)e = v0; *(pg8::f32x4*)(e + 4) = v1; }
                        else if ((row & (SEQ - 1)) == SEQ - 1) { float* e = out + OUT_SHIFT_P + (size_t)(row >> 12) * RCOLS + col; *(pg8::f32x4*)e = v0; *(pg8::f32x4*)(e + 4) = v1; }
                    } else if (cb < 1664) {
                        *(uint4*)(qb + (size_t)row * SBW + (col - 1280)) = make_uint4(pack2(v0[0] * QSCALE, v0[1] * QSCALE), pack2(v0[2] * QSCALE, v0[3] * QSCALE), pack2(v1[0] * QSCALE, v1[1] * QSCALE), pack2(v1[2] * QSCALE, v1[3] * QSCALE));
                    } else if (cb < 2048) {
                        const int c2 = col - 1664;
                        *(uint4*)(kb + (size_t)row * SBW + c2) = make_uint4(pack2(v0[0], v0[1]), pack2(v0[2], v0[3]), pack2(v1[0], v1[1]), pack2(v1[2], v1[3]));
                        float* e = row < NTOK ? out + OUT_SBK_P + (size_t)row * SBW + c2 : out + OUT_SBK_S + (size_t)(row - NTOK) * SBW + c2; *(pg8::f32x4*)e = v0; *(pg8::f32x4*)(e + 4) = v1;
                    } else if (cb < 2432) {
                        const int c2 = col - 2048;
                        *(uint4*)(vb + (size_t)row * SBW + c2) = make_uint4(pack2(v0[0], v0[1]), pack2(v0[2], v0[3]), pack2(v1[0], v1[1]), pack2(v1[2], v1[3]));
                        float* e = row < NTOK ? out + OUT_SBV_P + (size_t)row * SBW + c2 : out + OUT_SBV_S + (size_t)(row - NTOK) * SBW + c2; *(pg8::f32x4*)e = v0; *(pg8::f32x4*)(e + 4) = v1;
                    } else if (cb < 2688) {
                        *(uint4*)(xq + (size_t)row * XW + (col - 2432)) = make_uint4(pack2(v0[0] * QSCALE, v0[1] * QSCALE), pack2(v0[2] * QSCALE, v0[3] * QSCALE), pack2(v1[0] * QSCALE, v1[1] * QSCALE), pack2(v1[2] * QSCALE, v1[3] * QSCALE));
                    } else {
                        *(uint4*)(gate + (size_t)row * DM + (col - 2688)) = make_uint4(pack2(v0[0] * sigmoidf_(v0[0]), v0[1] * sigmoidf_(v0[1])), pack2(v0[2] * sigmoidf_(v0[2]), v0[3] * sigmoidf_(v0[3])),
                                                                                    pack2(v1[0] * sigmoidf_(v1[0]), v1[1] * sigmoidf_(v1[1])), pack2(v1[2] * sigmoidf_(v1[2]), v1[3] * sigmoidf_(v1[3])));
                    }
                }
        }
    }
};
struct EpiG2 {
    static constexpr bool PERM = true;
    const float* xp; const float* xs; float* yun;
    __device__ __forceinline__ void operator()(const pg8::f32x4 (&acc)[2][2][4][2], const pg8::Unit& u, int wr, int wc, int fr, int fq) const {
#pragma unroll
        for (int ai = 0; ai < 2; ++ai) {
            pg8::f32x4 xv[4][2][2];
#pragma unroll
            for (int m = 0; m < 4; ++m) { const size_t ro = (size_t)(u.pm * 256 + ai * 128 + wr * 64 + m * 16 + fr) * DM;
#pragma unroll
                for (int bj = 0; bj < 2; ++bj) { const int col = u.pn * 256 + bj * 128 + wc * 32 + 8 * fq;
                    xv[m][bj][0] = *(const pg8::f32x4*)(xp + ro + col); xv[m][bj][1] = *(const pg8::f32x4*)(xp + ro + col + 4); } }
#pragma unroll
            for (int m = 0; m < 4; ++m) { const size_t ro = (size_t)(u.pm * 256 + ai * 128 + wr * 64 + m * 16 + fr) * DM;
#pragma unroll
                for (int bj = 0; bj < 2; ++bj) { const int col = u.pn * 256 + bj * 128 + wc * 32 + 8 * fq;
                    *(pg8::f32x4*)(yun + ro + col) = acc[ai][bj][m][0] + xv[m][bj][0]; *(pg8::f32x4*)(yun + ro + col + 4) = acc[ai][bj][m][1] + xv[m][bj][1]; } }
        }
    }
};


typedef short prep_bf16x8 __attribute__((ext_vector_type(8)));
typedef float prep_f32x4 __attribute__((ext_vector_type(4)));
__device__ __forceinline__ void split8(const float (&x)[8], prep_bf16x8& hi, prep_bf16x8& lo) {
    unsigned h[4], l[4];
#pragma unroll
    for (int q = 0; q < 4; ++q) { h[q] = pack2(x[2 * q], x[2 * q + 1]);
        const float r0 = x[2 * q] - __uint_as_float(h[q] << 16), r1 = x[2 * q + 1] - __uint_as_float(h[q] & 0xffff0000u); l[q] = pack2(r0, r1); }
    typedef unsigned u4 __attribute__((ext_vector_type(4)));
    const u4 hv = {h[0], h[1], h[2], h[3]}, lv = {l[0], l[1], l[2], l[3]};
    hi = __builtin_bit_cast(prep_bf16x8, hv); lo = __builtin_bit_cast(prep_bf16x8, lv);
}
__device__ __forceinline__ void p0_prologue(const Params& P, float* lds) {
    const int tid = threadIdx.x, lane = tid & 63, wave = tid >> 6;
    bf16_t* A1 = (bf16_t*)(P.ws + WS_A1); bf16_t* Bt1 = (bf16_t*)(P.ws + WS_BT1); bf16_t* Bt2 = (bf16_t*)(P.ws + WS_BT2);
    const int gw = blockIdx.x * 8 + wave, nw = gridDim.x * 8;
    for (int r0 = gw; r0 < MROWS1; r0 += 2 * nw) {
        const float* srcs[2]; const float* gs[2]; bf16_t* dsts[2]; bool live[2];
#pragma unroll
        for (int q = 0; q < 2; ++q) { const int r = r0 + q * nw; live[q] = r < MROWS1; const int rr = live[q] ? r : 0;
            dsts[q] = A1 + (size_t)rr * DM; srcs[q] = nullptr; gs[q] = P.norm_g;
            if (rr < NTOK) srcs[q] = P.x_prompt + (size_t)rr * DM;
            else if (rr < NTK) srcs[q] = P.x_sample + (size_t)(rr - NTOK) * DM;
            else if (rr >= MEMROW0) { srcs[q] = P.mem_prompt + (size_t)(rr - MEMROW0) * DM; gs[q] = P.mem_norm_g; } }
        float4 x[2][4]; float ss[2] = {0.f, 0.f};
#pragma unroll
        for (int q = 0; q < 2; ++q)
#pragma unroll
            for (int j = 0; j < 4; ++j) x[q][j] = (live[q] && srcs[q]) ? *(const float4*)(srcs[q] + 4 * lane + 256 * j) : make_float4(0.f, 0.f, 0.f, 0.f);
#pragma unroll
        for (int q = 0; q < 2; ++q) {
#pragma unroll
            for (int j = 0; j < 4; ++j) ss[q] += x[q][j].x * x[q][j].x + x[q][j].y * x[q][j].y + x[q][j].z * x[q][j].z + x[q][j].w * x[q][j].w;
            ss[q] = wave_sum_fast(ss[q]); }
#pragma unroll
        for (int q = 0; q < 2; ++q) { if (!live[q]) continue;
            const float rs = rsqrtf(ss[q] * (1.f / DM) + NORM_EPS);
#pragma unroll
            for (int j = 0; j < 4; ++j) { const float4 gg = *(const float4*)(gs[q] + 4 * lane + 256 * j);
                uint2 w; w.x = pack2(x[q][j].x * rs * gg.x, x[q][j].y * rs * gg.y); w.y = pack2(x[q][j].z * rs * gg.z, x[q][j].w * rs * gg.w);
                *(uint2*)(dsts[q] + 4 * lane + 256 * j) = w; } }
    }
    for (int i = blockIdx.x * 512 + tid; i < 128 * DM / 4; i += gridDim.x * 512) *(uint2*)(Bt1 + (size_t)DIN * DM + (size_t)i * 4) = make_uint2(0u, 0u);
    {
        float* tl = lds + wave * (64 * 65);
        for (int task = gw; task < 1312; task += nw) {
            const float* src; int ld; bf16_t* dst; int k0;
            if (task < 928) { const int kt = task / 58, nt = task % 58; src = P.w_in + (size_t)kt * 64 * DIN + nt * 64; ld = DIN; dst = Bt1 + (size_t)(nt * 64) * DM; k0 = kt * 64; }
            else if (task < 992) { const int e = task - 928, kt = e / 4, nt = e % 4; src = P.w_mem_k + (size_t)kt * 64 * XW + nt * 64; ld = XW; dst = Bt1 + (size_t)(3840 + nt * 64) * DM; k0 = kt * 64; }
            else if (task < 1056) { const int e = task - 992, kt = e / 4, nt = e % 4; src = P.w_mem_v + (size_t)kt * 64 * XW + nt * 64; ld = XW; dst = Bt1 + (size_t)(4096 + nt * 64) * DM; k0 = kt * 64; }
            else { const int e = task - 1056, kt = e / 16, nt = e % 16; src = P.w_out + (size_t)kt * 64 * DM + nt * 64; ld = DM; dst = Bt2 + (size_t)(nt * 64) * DM; k0 = kt * 64; }
            float v[64];
#pragma unroll
            for (int i = 0; i < 64; ++i) v[i] = src[(size_t)i * ld + lane];
#pragma unroll
            for (int i = 0; i < 64; ++i) tl[i * 65 + lane] = v[i];
            __builtin_amdgcn_wave_barrier();
#pragma unroll
            for (int q = 0; q < 8; ++q) { const int p = lane + 64 * q, jj = p >> 3, kc = p & 7;
                unsigned w[4];
#pragma unroll
                for (int t = 0; t < 4; ++t) w[t] = pack2(tl[(kc * 8 + 2 * t) * 65 + jj], tl[(kc * 8 + 2 * t + 1) * 65 + jj]);
                *(uint4*)(dst + (size_t)jj * DM + k0 + kc * 8) = make_uint4(w[0], w[1], w[2], w[3]); }
            __builtin_amdgcn_wave_barrier();
        }
    }
    for (int idx = blockIdx.x * 512 + tid; idx < 2 * 6 * 4 * 2 * 64; idx += gridDim.x * 512) {
        const int l = idx & 63, s = (idx >> 6) & 1, nt = (idx >> 7) & 3, w = (idx >> 9) % 6, mt = idx / (512 * 6);
        const float* W = mt ? P.a_lora_b : P.w_lora_b; float x[8];
#pragma unroll
        for (int j = 0; j < 8; ++j) x[j] = W[(size_t)(32 * s + 8 * (l >> 4) + j) * RW + 64 * w + 16 * nt + (l & 15)];
        prep_bf16x8 hi, lo; split8(x, hi, lo);
        prep_bf16x8* LF = (prep_bf16x8*)(P.ws + WS_LFRAG);
        LF[idx] = hi; LF[2 * 6 * 4 * 2 * 64 + idx] = lo;
    }
    __syncthreads();
}

__device__ __forceinline__ void prep_produce(const Params& P, const bf16_t* __restrict__ prw, int ch, float* buf, int j, float mux) {
    constexpr int CT = 8;
    const int tok0 = ch * CT;
    float pv = 0.f;
    if (tok0 < NTOK && (tok0 & (SEQ - 1))) pv = bf2f(prw[(size_t)(tok0 - 1) * RCOLS + 1152 + j]);
    float cur[CT];
#pragma unroll
    for (int tk = 0; tk < CT; ++tk) cur[tk] = bf2f(prw[(size_t)(tok0 + tk) * RCOLS + 1152 + j]);
#pragma unroll
    for (int tk = 0; tk < CT; ++tk) {
        const int tok = tok0 + tk;
        if (tok >= NTOK) pv = P.state_shift[(size_t)(tok - NTOK) * RCOLS + 1152 + j];
        float x = cur[tk] + (pv - cur[tk]) * mux;
        if (j < 64) x = tanhf(x);
        buf[tk * 128 + j] = x;
        pv = cur[tk];
    }
}
__device__ __forceinline__ void p2_rwkv_prep(const Params& P, float* lds) {
    const int tid = threadIdx.x, lane = tid & 63, wave = tid >> 6;
    const bf16_t* prw = (const bf16_t*)(P.ws + WS_PRW);
    float* RSB = (float*)(P.ws + WS_RSB);
    constexpr int CT = 8, NCHK = NTK / CT;
    float* xbuf = lds;
    float* yt = lds + 2 * CT * 128 + wave * (2 * CT * 64);
    float* ot = lds + 2 * CT * 128 + 8 * (2 * CT * 64) + wave * 768;
    prep_bf16x8 wbh[2][4][2], wbl[2][4][2];
    float w0c = 0.f, a0c = 0.f, kkc = 0.f, kac = 0.f, rkc = 0.f, mur = 0.f, muk = 0.f, muv = 0.f, mux = 0.f;
    if (tid < RW) {
        const prep_bf16x8* LF = (const prep_bf16x8*)(P.ws + WS_LFRAG);
#pragma unroll
        for (int mt = 0; mt < 2; ++mt)
#pragma unroll
            for (int nt = 0; nt < 4; ++nt)
#pragma unroll
                for (int s = 0; s < 2; ++s) { const int fi = (((mt * 6 + wave) * 4 + nt) * 2 + s) * 64 + lane; wbh[mt][nt][s] = LF[fi]; wbl[mt][nt][s] = LF[2 * 6 * 4 * 2 * 64 + fi]; }
        w0c = P.w0[tid]; a0c = P.a0[tid]; kkc = P.k_k[tid]; kac = P.k_a[tid]; rkc = P.r_k[tid];
        mur = P.mu_shift[tid]; muk = P.mu_shift[RW + tid]; muv = P.mu_shift[2 * RW + tid];
    } else {
#pragma unroll
        for (int mt = 0; mt < 2; ++mt)
#pragma unroll
            for (int nt = 0; nt < 4; ++nt)
#pragma unroll
                for (int s = 0; s < 2; ++s)
#pragma unroll
                    for (int j = 0; j < 8; ++j) { wbh[mt][nt][s][j] = 0; wbl[mt][nt][s][j] = 0; }
        mux = P.mu_shift[1152 + (tid - RW)];
    }
    int ch = blockIdx.x;
    if (tid >= RW && ch < NCHK) prep_produce(P, prw, ch, xbuf, tid - RW, mux);
    for (int it = 0; ch < NCHK; ch += gridDim.x, ++it) {
        const int tok0 = ch * CT;
        float* bufc = xbuf + (it & 1) * (CT * 128); float* bufn = xbuf + ((it + 1) & 1) * (CT * 128);
        float nr[4], nk[4], nv[4], qr = 0.f, qk = 0.f, qv = 0.f;
        if (tid < RW) {
#pragma unroll
            for (int q = 0; q < 4; ++q) { const bf16_t* p = prw + (size_t)(tok0 + q) * RCOLS + tid; nr[q] = bf2f(p[0]); nk[q] = bf2f(p[RW]); nv[q] = bf2f(p[2 * RW]); }
            if (tok0 < NTOK && (tok0 & (SEQ - 1))) { const bf16_t* p = prw + (size_t)(tok0 - 1) * RCOLS + tid; qr = bf2f(p[0]); qk = bf2f(p[RW]); qv = bf2f(p[2 * RW]); }
        }
        asm volatile("s_waitcnt lgkmcnt(0)" ::: "memory");
        __builtin_amdgcn_s_barrier(); asm volatile("" ::: "memory");
        if (tid >= RW) { if (ch + (int)gridDim.x < NCHK) prep_produce(P, prw, ch + gridDim.x, bufn, tid - RW, mux); }
        else {
            const int c = tid, h = tid >> 6, cc = c & 63;
            {
                prep_bf16x8 ah[2][2], al_[2][2];
#pragma unroll
                for (int mt = 0; mt < 2; ++mt)
#pragma unroll
                    for (int s = 0; s < 2; ++s) { float x[8];
                        const float* xp = bufc + (lane & 7) * 128 + mt * 64 + 32 * s + 8 * (lane >> 4);
                        const float4 x0 = *(const float4*)xp, x1 = *(const float4*)(xp + 4);
                        const bool real = (lane & 15) < CT;
                        x[0] = real ? x0.x : 0.f; x[1] = real ? x0.y : 0.f; x[2] = real ? x0.z : 0.f; x[3] = real ? x0.w : 0.f;
                        x[4] = real ? x1.x : 0.f; x[5] = real ? x1.y : 0.f; x[6] = real ? x1.z : 0.f; x[7] = real ? x1.w : 0.f;
                        split8(x, ah[mt][s], al_[mt][s]); }
#pragma unroll
                for (int mt = 0; mt < 2; ++mt)
#pragma unroll
                    for (int nt = 0; nt < 4; ++nt) { prep_f32x4 acc = {0.f, 0.f, 0.f, 0.f};
#pragma unroll
                        for (int s = 0; s < 2; ++s) {
                            acc = __builtin_amdgcn_mfma_f32_16x16x32_bf16(al_[mt][s], wbh[mt][nt][s], acc, 0, 0, 0);
                            acc = __builtin_amdgcn_mfma_f32_16x16x32_bf16(ah[mt][s], wbl[mt][nt][s], acc, 0, 0, 0);
                            acc = __builtin_amdgcn_mfma_f32_16x16x32_bf16(ah[mt][s], wbh[mt][nt][s], acc, 0, 0, 0); }
                        if ((lane >> 4) < 2) {
#pragma unroll
                            for (int r = 0; r < 4; ++r) yt[(mt * CT + 4 * (lane >> 4) + r) * 64 + 16 * nt + (lane & 15)] = acc[r]; } }
                asm volatile("s_waitcnt lgkmcnt(0)" ::: "memory");
                __builtin_amdgcn_wave_barrier();
            }
#pragma unroll
            for (int tk = 0; tk < CT; ++tk) {
                const int tok = tok0 + tk;
                if (tok >= NTOK) { const float* p = P.state_shift + (size_t)(tok - NTOK) * RCOLS + tid; qr = p[0]; qk = p[RW]; qv = p[2 * RW]; }
                const float cr = nr[tk & 3], ck = nk[tk & 3], cv = nv[tk & 3];
                if (tk + 4 < CT) { const bf16_t* p = prw + (size_t)(tok + 4) * RCOLS + tid; nr[tk & 3] = bf2f(p[0]); nk[tk & 3] = bf2f(p[RW]); nv[tk & 3] = bf2f(p[2 * RW]); }
                const float r = cr + (qr - cr) * mur, kraw = ck + (qk - ck) * muk, v = cv + (qv - cv) * muv;
                qr = cr; qk = ck; qv = cv;
                const float aw = w0c + yt[tk * 64 + cc], aa = a0c + yt[(CT + tk) * 64 + cc];
                float* blk = RSB + ((size_t)tok * RH + h) * RSB_BLK;
                const float w = __expf(-DECAY_SCALE * sigmoidf_(aw)), a = sigmoidf_(aa);
                const float kkv = kraw * kkc;
                const float n2 = wave_sum_fast(kkv * kkv);
                const float kk = kkv * rsqrtf(fmaxf(n2, 1e-12f));
                const float kmod = kraw * (1.f + (a - 1.f) * kac);
                const float rk = wave_sum_fast(r * kmod * rkc);
                const float bb = kk * a;
                const float br = wave_sum_fast(bb * r), kr = wave_sum_fast(kmod * r);
                float* oq = ot + (tk & 1) * 384;
                oq[cc] = kk; oq[64 + cc] = w; oq[128 + cc] = bb; oq[192 + cc] = kmod; oq[256 + cc] = w * r; oq[320 + cc] = v;
                __builtin_amdgcn_wave_barrier();
                *(float4*)(blk + 4 * lane) = *(const float4*)(oq + 4 * lane);
                if (lane < 32) *(float4*)(blk + 256 + 4 * lane) = *(const float4*)(oq + 256 + 4 * lane);
                if (lane == 0) *(float4*)(blk + 384) = make_float4(br, kr, rk, 0.f);
                __builtin_amdgcn_wave_barrier();
            }
            __builtin_amdgcn_wave_barrier();
        }
    }
    __syncthreads();
}

__device__ __forceinline__ void p2_xattn_sample(const Params& P, float* lds) {
    const int tid = threadIdx.x, lane = tid & 63, wave = tid >> 6;
    const bf16_t* xq = (const bf16_t*)(P.ws + WS_XQ); const bf16_t* gate = (const bf16_t*)(P.ws + WS_GATE); bf16_t* O = (bf16_t*)(P.ws + WS_O);
    float* zl = lds + wave * 64; float* part = lds + 512;
    const int c = lane & 15, g = lane >> 4;
    for (int task = (int)blockIdx.x - 128; task >= 0 && task < DB * XH; task += 128) {
        const int b = task >> 2, h = task & 3; const size_t row = NTOK + b;
        const bf16_t* qp = xq + row * XW + h * 64 + 4 * c;
        const float q0 = bf2f(qp[0]), q1 = bf2f(qp[1]), q2 = bf2f(qp[2]), q3 = bf2f(qp[3]);
        const float* Kp = P.cmem_k + (((size_t)b * NMEM + wave * 32) * XH + h) * HD + 4 * c; const float* Vp = P.cmem_v + (((size_t)b * NMEM + wave * 32) * XH + h) * HD + 4 * c;
        __syncthreads();
        float4 k4[8], v4[8];
#pragma unroll
        for (int i = 0; i < 8; ++i) { k4[i] = *(const float4*)(Kp + (size_t)(4 * i + g) * (XH * HD)); v4[i] = *(const float4*)(Vp + (size_t)(4 * i + g) * (XH * HD)); }
#pragma unroll
        for (int i = 0; i < 8; ++i) { float p = q0 * k4[i].x + q1 * k4[i].y + q2 * k4[i].z + q3 * k4[i].w; p = sum16(p); if (c == 0) zl[4 * i + g] = p; }
        asm volatile("s_waitcnt lgkmcnt(0)" ::: "memory");
        __builtin_amdgcn_wave_barrier();
        const float z = zl[lane & 31];
        const float mx = wave_max(z);
        const float p = (lane < 32) ? exp2f(z - mx) : 0.f;
        const float ls = wave_sum_fast(p);
        __builtin_amdgcn_wave_barrier();
        if (lane < 32) zl[lane] = p;
        asm volatile("s_waitcnt lgkmcnt(0)" ::: "memory");
        __builtin_amdgcn_wave_barrier();
        float4 o4 = make_float4(0.f, 0.f, 0.f, 0.f);
#pragma unroll
        for (int i = 0; i < 8; ++i) { const float w = zl[4 * i + g]; o4.x += w * v4[i].x; o4.y += w * v4[i].y; o4.z += w * v4[i].z; o4.w += w * v4[i].w; }
#pragma unroll
        for (int off = 16; off < 64; off <<= 1) { o4.x += __shfl_xor(o4.x, off); o4.y += __shfl_xor(o4.y, off); o4.z += __shfl_xor(o4.z, off); o4.w += __shfl_xor(o4.w, off); }
        if (g == 0) *(float4*)(part + wave * 68 + 4 * c) = o4;
        if (lane == 0) { part[wave * 68 + 64] = mx; part[wave * 68 + 65] = ls; }
        __syncthreads();
        if (wave == 0) {
            float M = part[64];
#pragma unroll
            for (int w = 1; w < 8; ++w) M = fmaxf(M, part[w * 68 + 64]);
            float L = 0.f, o = 0.f;
#pragma unroll
            for (int w = 0; w < 8; ++w) { const float sc = exp2f(part[w * 68 + 64] - M); L += part[w * 68 + 65] * sc; o += part[w * 68 + lane] * sc; }
            O[row * DM + 768 + h * 64 + lane] = f2bf(o / L * bf2f(gate[row * DM + 768 + h * 64 + lane]));
        }
    }
    __syncthreads();
}

constexpr int DEC_NTASK = DB * NPAGES * SH, DEC_LDS_OFF = 144384;
constexpr int QW_SB = 3584, QW_DEC = 3648;
__device__ __forceinline__ void sb_decode_task(const Params& P, float* lds, int task) {
    const int tid = threadIdx.x, lane = tid & 63, wave = tid >> 6;
    const bf16_t* qb = (const bf16_t*)(P.ws + WS_QB);
    float* dpart = (float*)(P.ws + WS_DPART); float* dl = (float*)(P.ws + WS_DL);
    float* zl = lds + DEC_LDS_OFF / 4 + wave * 256; float* wl = zl + 128;
    const int c = lane & 15, g = lane >> 4;
    {
        const int h = task % SH, bj = task / SH, b = bj / NPAGES;
        const int page = P.page_table[bj];
        const float* Kp = P.cache_k + ((size_t)page * PAGE * SH + h) * HD;
        const float* Vp = P.cache_v + ((size_t)page * PAGE * SH + h) * HD;
        const bf16_t* qp = qb + (size_t)(NTOK + b) * SBW + h * 64 + 4 * c;
        const float q0 = bf2f(qp[0]), q1 = bf2f(qp[1]), q2 = bf2f(qp[2]), q3 = bf2f(qp[3]);
        const float bias = P.sb_bias[h] * LOG2E;
        float4 kv[16];
#pragma unroll
        for (int i = 0; i < 16; ++i) kv[i] = *(const float4*)(Kp + (size_t)(4 * i + g) * (SH * HD) + 4 * c);
#pragma unroll
        for (int hb = 0; hb < 2; ++hb) {
            float4 nx[16];
            if (hb == 0) {
#pragma unroll
                for (int i = 0; i < 16; ++i) nx[i] = *(const float4*)(Kp + (size_t)(64 + 4 * i + g) * (SH * HD) + 4 * c);
            } else {
#pragma unroll
                for (int i = 0; i < 16; ++i) nx[i] = *(const float4*)(Vp + (size_t)(4 * i + g) * (SH * HD) + 4 * c);
            }
#pragma unroll
            for (int i = 0; i < 16; ++i) { const int s = 64 * hb + 4 * i + g;
                float part = q0 * kv[i].x + q1 * kv[i].y + q2 * kv[i].z + q3 * kv[i].w; part = sum16(part);
                if (c == 0) zl[s] = part + bias; }
#pragma unroll
            for (int i = 0; i < 16; ++i) kv[i] = nx[i];
        }
        asm volatile("s_waitcnt lgkmcnt(0)" ::: "memory");
        __builtin_amdgcn_wave_barrier();
        const float z0 = zl[2 * lane], z1 = zl[2 * lane + 1];
        const float sp0 = softplus2_(z0), sp1 = softplus2_(z1);
        float incl = sp0 + sp1;
#pragma unroll
        for (int off = 1; off < 64; off <<= 1) { const float t = __shfl_down(incl, off); if (lane + off < 64) incl += t; }
        const float excl = incl - (sp0 + sp1);
        wl[2 * lane] = exp2f(z0 - sp0 - (excl + sp1));
        wl[2 * lane + 1] = exp2f(z1 - sp1 - excl);
        const float Ltot = __shfl(incl, 0);
        asm volatile("s_waitcnt lgkmcnt(0)" ::: "memory");
        __builtin_amdgcn_wave_barrier();
        float4 o4 = make_float4(0.f, 0.f, 0.f, 0.f);
        {
            float4 nx[16];
#pragma unroll
            for (int i = 0; i < 16; ++i) nx[i] = *(const float4*)(Vp + (size_t)(64 + 4 * i + g) * (SH * HD) + 4 * c);
#pragma unroll
            for (int i = 0; i < 16; ++i) { const float w = wl[4 * i + g]; o4.x += w * kv[i].x; o4.y += w * kv[i].y; o4.z += w * kv[i].z; o4.w += w * kv[i].w; }
#pragma unroll
            for (int i = 0; i < 16; ++i) { const float w = wl[64 + 4 * i + g]; o4.x += w * nx[i].x; o4.y += w * nx[i].y; o4.z += w * nx[i].z; o4.w += w * nx[i].w; }
        }
#pragma unroll
        for (int off = 16; off < 64; off <<= 1) { o4.x += __shfl_xor(o4.x, off); o4.y += __shfl_xor(o4.y, off); o4.z += __shfl_xor(o4.z, off); o4.w += __shfl_xor(o4.w, off); }
        if (g == 0) *(float4*)(dpart + (size_t)task * HD + 4 * c) = o4;
        if (lane == 0) dl[task] = Ltot;
        __builtin_amdgcn_wave_barrier();
    }
}

__device__ __forceinline__ void sb_decode_wave_loop(const Params& P, float* lds) {
    unsigned* qd = (unsigned*)(P.ws + WS_BAR) + QW_DEC;
    const int lane = threadIdx.x & 63;
    unsigned nxt = 0u;
    if (lane == 0) nxt = atomicAdd(qd, 2u);
    for (;;) {
        const int t = __builtin_amdgcn_readfirstlane((int)nxt);
        if (t >= DEC_NTASK) break;
        if (lane == 0) nxt = atomicAdd(qd, 2u);
        sb_decode_task(P, lds, t); sb_decode_task(P, lds, t + 1);
    }
}

struct StepIn { float4 kk, w, b, k, wr; float v; float2 sc; };
__device__ __forceinline__ void load_step(StepIn& s, const float* __restrict__ p, int c0, int rl) {
    s.kk = *(const float4*)(p + c0); s.w = *(const float4*)(p + 64 + c0); s.b = *(const float4*)(p + 128 + c0); s.k = *(const float4*)(p + 192 + c0); s.wr = *(const float4*)(p + 256 + c0);
    s.v = p[320 + rl]; s.sc = *(const float2*)(p + 384);
}
__device__ __forceinline__ void scan_step(float4& S, const StepIn& s, float* __restrict__ op) {
    float d1 = S.x * s.kk.x + S.y * s.kk.y + S.z * s.kk.z + S.w * s.kk.w;
    float d2 = S.x * s.wr.x + S.y * s.wr.y + S.z * s.wr.z + S.w * s.wr.w;
    d1 = sum16(d1); d2 = sum16(d2);
    S.x = S.x * s.w.x - d1 * s.b.x + s.v * s.k.x; S.y = S.y * s.w.y - d1 * s.b.y + s.v * s.k.y; S.z = S.z * s.w.z - d1 * s.b.z + s.v * s.k.z; S.w = S.w * s.w.w - d1 * s.b.w + s.v * s.k.w;
    *op = d2 - d1 * s.sc.x + s.v * s.sc.y;
}
__device__ __forceinline__ float scan_step_asm(float4& S, const StepIn& s) {
    float o, d1, d2, t;
    asm volatile(
        "v_mul_f32 %5, %0, %8\n\t"  "v_mul_f32 %6, %0, %12\n\t"
        "v_fmac_f32 %5, %1, %9\n\t" "v_fmac_f32 %6, %1, %13\n\t"
        "v_fmac_f32 %5, %2, %10\n\t" "v_fmac_f32 %6, %2, %14\n\t"
        "v_fmac_f32 %5, %3, %11\n\t" "v_fmac_f32 %6, %3, %15\n\t"
        "v_mul_f32 %0, %0, %16\n\t" "v_mul_f32 %1, %1, %17\n\t"
        "v_add_f32_dpp %5, %5, %5 quad_perm:[1,0,3,2] row_mask:0xf bank_mask:0xf\n\t"
        "v_add_f32_dpp %6, %6, %6 quad_perm:[1,0,3,2] row_mask:0xf bank_mask:0xf\n\t"
        "v_mul_f32 %2, %2, %18\n\t" "v_mul_f32 %3, %3, %19\n\t"
        "v_add_f32_dpp %5, %5, %5 quad_perm:[2,3,0,1] row_mask:0xf bank_mask:0xf\n\t"
        "v_add_f32_dpp %6, %6, %6 quad_perm:[2,3,0,1] row_mask:0xf bank_mask:0xf\n\t"
        "v_fmac_f32 %0, %28, %20\n\t" "v_fmac_f32 %1, %28, %21\n\t"
        "v_add_f32_dpp %5, %5, %5 row_ror:4 row_mask:0xf bank_mask:0xf\n\t"
        "v_add_f32_dpp %6, %6, %6 row_ror:4 row_mask:0xf bank_mask:0xf\n\t"
        "v_fmac_f32 %2, %28, %22\n\t" "v_fmac_f32 %3, %28, %23\n\t"
        "v_add_f32_dpp %5, %5, %5 row_ror:8 row_mask:0xf bank_mask:0xf\n\t"
        "v_add_f32_dpp %6, %6, %6 row_ror:8 row_mask:0xf bank_mask:0xf\n\t"
        "v_mul_f32 %7, %28, %30\n\t"
        "v_fma_f32 %0, -%5, %24, %0\n\t" "v_fma_f32 %1, -%5, %25, %1\n\t" "v_fma_f32 %2, -%5, %26, %2\n\t" "v_fma_f32 %3, -%5, %27, %3\n\t"
        "v_add_f32 %4, %6, %7\n\t"
        "v_fma_f32 %4, -%5, %29, %4\n\t"
        "s_nop 0"
        : "+v"(S.x), "+v"(S.y), "+v"(S.z), "+v"(S.w), "=&v"(o), "=&v"(d1), "=&v"(d2), "=&v"(t)
        : "v"(s.kk.x), "v"(s.kk.y), "v"(s.kk.z), "v"(s.kk.w), "v"(s.wr.x), "v"(s.wr.y), "v"(s.wr.z), "v"(s.wr.w),
          "v"(s.w.x), "v"(s.w.y), "v"(s.w.z), "v"(s.w.w), "v"(s.k.x), "v"(s.k.y), "v"(s.k.z), "v"(s.k.w),
          "v"(s.b.x), "v"(s.b.y), "v"(s.b.z), "v"(s.b.w), "v"(s.v), "v"(s.sc.x), "v"(s.sc.y));
    return o;
}
__device__ __forceinline__ void scan_rows(const Params& P, int tok0, int T, int h, int row0, const float* S0, float* Sout, int lane) {
    const int rl = row0 + (lane >> 4), c0 = (lane & 15) * 4;
    const float* p = (const float*)(P.ws + WS_RSB) + ((size_t)tok0 * RH + h) * RSB_BLK;
    float* op = (float*)(P.ws + WS_ORAW) + (size_t)tok0 * RW + h * 64 + rl;
    constexpr int PST = RH * RSB_BLK;
    float4 S = S0 ? *(const float4*)(S0 + rl * 64 + c0) : make_float4(0.f, 0.f, 0.f, 0.f);
    if (T >= 16) {
        StepIn ring[8];
#pragma unroll
        for (int j = 0; j < 8; ++j) load_step(ring[j], p + (size_t)j * PST, c0, rl);
        for (int t0 = 0; t0 < T - 8; t0 += 8) {
#pragma unroll
            for (int j = 0; j < 8; ++j) { scan_step(S, ring[j], op + (size_t)j * RW); load_step(ring[j], p + (size_t)(8 + j) * PST, c0, rl); }
            p += 8 * PST; op += 8 * RW;
        }
#pragma unroll
        for (int j = 0; j < 8; ++j) scan_step(S, ring[j], op + (size_t)j * RW);
    } else {
        for (int t = 0; t < T; ++t) { StepIn s; load_step(s, p + (size_t)t * PST, c0, rl); scan_step(S, s, op + (size_t)t * RW); }
    }
    *(float4*)(Sout + rl * 64 + c0) = S;
}

constexpr int SCH = 16, SC_NPIECE = SCH * 97, SC_NP64 = (SC_NPIECE + 63) / 64, SC_BUF = 28672, SC_NB = 5;
__device__ __forceinline__ void lds_load_step(StepIn& s, const float* p, int c0, int rl) {
    s.kk = *(const float4*)(p + c0); s.w = *(const float4*)(p + 64 + c0); s.b = *(const float4*)(p + 128 + c0); s.k = *(const float4*)(p + 192 + c0); s.wr = *(const float4*)(p + 256 + c0);
    s.v = p[320 + rl]; s.sc = *(const float2*)(p + 384);
}
#ifndef SC_FREE_WAVES
#define SC_FREE_WAVES 2
#endif
constexpr int SC_CTL_OFF = SC_NB * 28672;
__device__ __forceinline__ void scan_prompt_wave(const Params& P, unsigned char* lds, int b, int h, int quarter) {
    const int tid = threadIdx.x, lane = tid & 63; const int wave = __builtin_amdgcn_readfirstlane(tid >> 6);
    constexpr int PST = RH * RSB_BLK, NCH = SEQ / SCH;
    volatile LAS unsigned* scw = (volatile LAS unsigned*)((LAS unsigned char*)lds + SC_CTL_OFF);
    if (wave == 4) {
        const float* g0 = (const float*)(P.ws + WS_RSB) + ((size_t)(b * SEQ) * RH + h) * RSB_BLK;
        LAS unsigned char* l3 = (LAS unsigned char*)lds;
        int soff[SC_NP64];
#pragma unroll
        for (int j = 0; j < SC_NP64; ++j) { const int i = j * 64 + lane; const int ii = i < SC_NPIECE ? i : SC_NPIECE - 1; soff[j] = (ii / 97) * PST + (ii % 97) * 4; }
        for (int c = 0; c < NCH; ++c) {
            if (c >= SC_NB) {
                for (;;) { const unsigned d0 = scw[1], d1 = scw[2], d2 = scw[3], d3 = scw[4]; const unsigned m01 = d0 < d1 ? d0 : d1, m23 = d2 < d3 ? d2 : d3;
                    if ((m01 < m23 ? m01 : m23) >= (unsigned)(c - SC_NB + 1)) break; __builtin_amdgcn_s_sleep(1); }
            }
            const float* g_ = g0 + (size_t)c * SCH * PST;
#pragma unroll
            for (int j = 0; j < SC_NP64; ++j) {
                if (j * 64 + lane < SC_NPIECE) __builtin_amdgcn_global_load_lds((const unsigned*)(g_ + soff[j]), (LAS unsigned*)(l3 + (c % SC_NB) * SC_BUF + j * 1024), 16, 0, 0);
            }
            if (c >= 1) { asm volatile("s_waitcnt vmcnt(25)" ::: "memory"); if (lane == 0) scw[0] = (unsigned)c; }
        }
        asm volatile("s_waitcnt vmcnt(0)" ::: "memory");
        if (lane == 0) scw[0] = (unsigned)NCH;
    } else if (wave < 4) {
        const int rl = quarter * 16 + wave * 4 + (lane >> 4), cl = lane & 15, c0 = cl * 4;
        float* op = (float*)(P.ws + WS_ORAW) + (size_t)(b * SEQ) * RW + h * 64 + rl;
        float4 S = make_float4(0.f, 0.f, 0.f, 0.f);
        while (scw[0] < 1u) __builtin_amdgcn_s_sleep(1);
        asm volatile("" ::: "memory");
        StepIn r[4];
        lds_load_step(r[0], (const float*)lds, c0, rl); lds_load_step(r[1], (const float*)lds + RSB_BLK, c0, rl); lds_load_step(r[2], (const float*)lds + 2 * RSB_BLK, c0, rl);
        for (int c = 0; c < NCH; ++c) {
            const float* bp = (const float*)(lds + (c % SC_NB) * SC_BUF); const float* bpn = (const float*)(lds + ((c + 1) % SC_NB) * SC_BUF);
            float ov = 0.f;
#pragma unroll
            for (int s = 0; s < SCH; ++s) {
                if (s == SCH - 3 && c + 1 < NCH) { while (scw[0] < (unsigned)(c + 2)) __builtin_amdgcn_s_sleep(1); asm volatile("" ::: "memory"); }
                lds_load_step(r[(s + 3) & 3], (s + 3 < SCH) ? bp + (s + 3) * RSB_BLK : bpn + (s + 3 - SCH) * RSB_BLK, c0, rl); __builtin_amdgcn_sched_barrier(0);
                const float o = scan_step_asm(S, r[s & 3]); __builtin_amdgcn_sched_barrier(0);
                ov = (cl == s) ? o : ov;
            }
            op[(size_t)cl * RW] = ov;
            op += (size_t)SCH * RW;
            if (lane == 0) scw[1 + wave] = (unsigned)(c + 1);
        }
        *(float4*)(P.out + OUT_WKV_P + ((size_t)(b * RH + h) * HD + rl) * HD + c0) = S;
    }
}

namespace sba {
typedef short bf16x8 __attribute__((ext_vector_type(8)));
typedef short s16x4 __attribute__((ext_vector_type(4)));
typedef float f32x16 __attribute__((ext_vector_type(16)));
typedef unsigned u32x4 __attribute__((ext_vector_type(4)));
typedef __attribute__((address_space(3))) const unsigned char* lds_cptr;
constexpr int SLOT = 16384;
#define SBA_MFMA(a, b, c) __builtin_amdgcn_mfma_f32_32x32x16_bf16(a, b, c, 0, 0, 0)
__device__ __forceinline__ unsigned cvtpk(float lo, float hi) { return pack2(lo, hi); }
__device__ __forceinline__ bf16x8 pack8(const f32x16& x, int base) {
    u32x4 w; w[0] = cvtpk(x[base], x[base + 1]); w[1] = cvtpk(x[base + 2], x[base + 3]); w[2] = cvtpk(x[base + 4], x[base + 5]); w[3] = cvtpk(x[base + 6], x[base + 7]);
    return __builtin_bit_cast(bf16x8, w);
}
__device__ __forceinline__ int crow(int r, int hi) { return (r & 3) + 8 * (r >> 2) + 4 * hi; }
__device__ __forceinline__ bf16x8 vfrag(lds_cptr p) {
    const s16x4 a = __builtin_bit_cast(s16x4, __builtin_amdgcn_ds_read_tr16_b64_v4i16((__attribute__((address_space(3))) s16x4*)p));
    const s16x4 b = __builtin_bit_cast(s16x4, __builtin_amdgcn_ds_read_tr16_b64_v4i16((__attribute__((address_space(3))) s16x4*)(p + 8 * 64)));
    bf16x8 r; r[0] = a[0]; r[1] = a[1]; r[2] = a[2]; r[3] = a[3]; r[4] = b[0]; r[5] = b[1]; r[6] = b[2]; r[7] = b[3]; return r;
}

template <bool MASK>
__device__ __forceinline__ void tile(lds_cptr kp0, lds_cptr vp0, const bf16x8 (&qr)[4], const f32x16& biasv, const bf16x8& ut0, const bf16x8& ut1, const bf16x8& uon,
                                     f32x16& o0, f32x16& o1, float& R, int kbase, int trel, int hi) {
    f32x16 p0 = biasv, p1 = biasv;
#pragma unroll
    for (int d0 = 0; d0 < 4; ++d0) {
        const bf16x8 ka = *(const __attribute__((address_space(3))) bf16x8*)(kp0 + d0 * 2048);
        const bf16x8 kb = *(const __attribute__((address_space(3))) bf16x8*)(kp0 + d0 * 2048 + 512);
        p0 = SBA_MFMA(ka, qr[d0], p0); p1 = SBA_MFMA(kb, qr[d0], p1);
    }
    f32x16 s0, s1;
#pragma unroll
    for (int r = 0; r < 16; ++r) {
        s0[r] = __builtin_amdgcn_logf(1.f + __builtin_amdgcn_exp2f(p0[r]));
        s1[r] = __builtin_amdgcn_logf(1.f + __builtin_amdgcn_exp2f(p1[r]));
        if (MASK) { const int k0 = kbase + crow(r, hi); if (k0 >= trel) s0[r] = 0.f; if (k0 + 32 >= trel) s1[r] = 0.f; }
    }
    const bf16x8 b00 = pack8(s0, 0), b01 = pack8(s0, 8), b10 = pack8(s1, 0), b11 = pack8(s1, 8);
    f32x16 c0, c1;
#pragma unroll
    for (int r = 0; r < 16; ++r) { c0[r] = p0[r] - R; c1[r] = p1[r] - R; }
    const float top = c0[0];
    c0 = SBA_MFMA(ut0, b00, c0); c0 = SBA_MFMA(ut1, b01, c0); c0 = SBA_MFMA(uon, b10, c0); c0 = SBA_MFMA(uon, b11, c0);
    c1 = SBA_MFMA(ut0, b10, c1); c1 = SBA_MFMA(ut1, b11, c1);
    const float tot_l = top - c0[0];
    const auto sw = __builtin_amdgcn_permlane32_swap(__float_as_uint(tot_l), __float_as_uint(tot_l), false, false);
    const float tot = __uint_as_float(sw[0]);
#pragma unroll
    for (int r = 0; r < 16; ++r) {
        c0[r] = __builtin_amdgcn_exp2f(c0[r]); c1[r] = __builtin_amdgcn_exp2f(c1[r]);
        if (MASK) { const int k0 = kbase + crow(r, hi); if (k0 >= trel) c0[r] = 0.f; if (k0 + 32 >= trel) c1[r] = 0.f; }
    }
    const bf16x8 a00 = pack8(c0, 0), a01 = pack8(c0, 8), a10 = pack8(c1, 0), a11 = pack8(c1, 8);
    o0 = SBA_MFMA(vfrag(vp0 + 0 * 1024), a00, o0); o1 = SBA_MFMA(vfrag(vp0 + 4096 + 0 * 1024), a00, o1);
    o0 = SBA_MFMA(vfrag(vp0 + 1 * 1024), a01, o0); o1 = SBA_MFMA(vfrag(vp0 + 4096 + 1 * 1024), a01, o1);
    o0 = SBA_MFMA(vfrag(vp0 + 2 * 1024), a10, o0); o1 = SBA_MFMA(vfrag(vp0 + 4096 + 2 * 1024), a10, o1);
    o0 = SBA_MFMA(vfrag(vp0 + 3 * 1024), a11, o0); o1 = SBA_MFMA(vfrag(vp0 + 4096 + 3 * 1024), a11, o1);
    R += tot;
}

__device__ __forceinline__ void unit(const Params& P, unsigned char* lds, int b, int h, int qb) {
    const int tid = threadIdx.x, lane = tid & 63, r32 = lane & 31, hi = lane >> 5; const int wid = __builtin_amdgcn_readfirstlane(tid >> 6);
    const bf16_t* Q = (const bf16_t*)(P.ws + WS_QB); const bf16_t* K = (const bf16_t*)(P.ws + WS_KB); const bf16_t* V = (const bf16_t*)(P.ws + WS_VB);
    const bf16_t* gate = (const bf16_t*)(P.ws + WS_GATE); bf16_t* O = (bf16_t*)(P.ws + WS_O);
    const size_t rowbase = (size_t)b * SEQ; const int q0 = qb * 256, NT = (q0 + 256) / 64;
    const int trel = wid * 32 + r32;
    const size_t qrow = rowbase + q0 + trel;
    bf16x8 qr[4];
#pragma unroll
    for (int d0 = 0; d0 < 4; ++d0) qr[d0] = *(const bf16x8*)(Q + qrow * SBW + h * 64 + d0 * 16 + hi * 8);
    const bf16_t* ksrc = K + (rowbase + lane) * SBW + h * 64 + wid * 8;
    const bf16_t* vsrc = V + (rowbase + 16 * (wid & 3) + (lane >> 2)) * SBW + h * 64 + (wid >> 2) * 32 + (lane & 3) * 8;
    LAS unsigned char* l3 = (LAS unsigned char*)lds;
#define SBA_DMA(t, slot) do { __builtin_amdgcn_global_load_lds((const unsigned*)(ksrc + (size_t)(t) * 64 * SBW), (LAS unsigned*)(l3 + (slot) + wid * 1024), 16, 0, 0); \
        __builtin_amdgcn_global_load_lds((const unsigned*)(vsrc + (size_t)(t) * 64 * SBW), (LAS unsigned*)(l3 + (slot) + 8192 + wid * 1024), 16, 0, 0); } while (0)
    const int koff = hi * 1024 + r32 * 16;
    const int voff = 8192 + ((lane >> 4) & 1) * 32 + (lane & 3) * 8 + (4 * hi + ((lane & 15) >> 2)) * 64;
    bf16x8 ut0, ut1, uon;
#pragma unroll
    for (int jj = 0; jj < 8; ++jj) { const int kj = 8 * (jj >> 2) + 4 * hi + (jj & 3);
        ut0[jj] = (kj >= r32) ? (short)0xBF80 : (short)0; ut1[jj] = (16 + kj >= r32) ? (short)0xBF80 : (short)0; uon[jj] = (short)0xBF80; }
    f32x16 biasv; { const float b2 = P.sb_bias[h] * LOG2E;
#pragma unroll
        for (int r = 0; r < 16; ++r) biasv[r] = b2; }
    f32x16 o0, o1;
#pragma unroll
    for (int r = 0; r < 16; ++r) { o0[r] = 0.f; o1[r] = 0.f; }
    float R = 0.f;
    __syncthreads();
    SBA_DMA(NT - 1, ((NT - 1) & 1) * SLOT);
    asm volatile("s_waitcnt vmcnt(0)" ::: "memory");
    __syncthreads();
    for (int t = NT - 1; t >= 0; --t) {
        const int slot = (t & 1) * SLOT;
        if (t > 0) SBA_DMA(t - 1, slot ^ SLOT);
        const int jb = t - (NT - 4);
        const lds_cptr kp0 = (lds_cptr)l3 + slot + koff, vp0 = (lds_cptr)l3 + slot + voff;
        if (jb < 0) tile<false>(kp0, vp0, qr, biasv, ut0, ut1, uon, o0, o1, R, 0, 0, hi);
        else if (64 * jb < wid * 32 + 31) {
            if (64 * jb + 63 >= wid * 32) tile<true>(kp0, vp0, qr, biasv, ut0, ut1, uon, o0, o1, R, 64 * jb, trel, hi);
            else tile<false>(kp0, vp0, qr, biasv, ut0, ut1, uon, o0, o1, R, 0, 0, hi);
        }
        asm volatile("s_waitcnt vmcnt(0)" ::: "memory");
        __syncthreads();
    }
#undef SBA_DMA
    const bf16_t* gr = gate + qrow * DM + 384 + h * 64; bf16_t* orow = O + qrow * DM + 384 + h * 64;
#pragma unroll
    for (int half = 0; half < 2; ++half)
#pragma unroll
        for (int g = 0; g < 4; ++g) { const int d = 32 * half + 8 * g + 4 * hi; const uint2 gt = *(const uint2*)(gr + d);
            const f32x16& o = half ? o1 : o0;
            uint2 w; w.x = cvtpk(o[4 * g] * __uint_as_float(gt.x << 16), o[4 * g + 1] * __uint_as_float(gt.x & 0xffff0000u));
            w.y = cvtpk(o[4 * g + 2] * __uint_as_float(gt.y << 16), o[4 * g + 3] * __uint_as_float(gt.y & 0xffff0000u));
            *(uint2*)(orow + d) = w; }
}
}

__device__ __forceinline__ void p2_xattn_prompt(const Params& P, unsigned char* lds) {
    using namespace sba;
    const int tid = threadIdx.x, lane = tid & 63, r32 = lane & 31, hi = lane >> 5; const int wid = __builtin_amdgcn_readfirstlane(tid >> 6);
    const bf16_t* xq = (const bf16_t*)(P.ws + WS_XQ); const bf16_t* gate = (const bf16_t*)(P.ws + WS_GATE); bf16_t* O = (bf16_t*)(P.ws + WS_O);
    const float* MK = P.out + OUT_MK_P; const float* MV = P.out + OUT_MV_P;
    for (int task = blockIdx.x; task < NB * XH * 16; task += gridDim.x) {
        const int qblk = task & 15, h = (task >> 4) & 3, b = task >> 6;
        __syncthreads();
        for (int it = tid; it < 2048; it += 512) {
            const int key = it & 255, ch = it >> 8;
            const float* s = MK + ((size_t)(b * NMEM + key)) * XW + h * 64 + ch * 8;
            const float4 a = *(const float4*)s, c = *(const float4*)(s + 4);
            *(uint4*)(lds + (key >> 6) * 8192 + ch * 1024 + (key & 63) * 16) = make_uint4(pack2(a.x, a.y), pack2(a.z, a.w), pack2(c.x, c.y), pack2(c.z, c.w));
        }
        for (int it = tid; it < 2048; it += 512) {
            const int pl = it & 3, key = (it >> 2) & 255, ph = it >> 10;
            const float* s = MV + ((size_t)(b * NMEM + key)) * XW + h * 64 + ph * 32 + pl * 8;
            const float4 a = *(const float4*)s, c = *(const float4*)(s + 4);
            *(uint4*)(lds + 32768 + (key >> 6) * 8192 + ph * 4096 + (key & 63) * 64 + pl * 16) = make_uint4(pack2(a.x, a.y), pack2(a.z, a.w), pack2(c.x, c.y), pack2(c.z, c.w));
        }
        __syncthreads();
        const size_t row = (size_t)b * SEQ + qblk * 256 + wid * 32 + r32;
        bf16x8 qr[4];
#pragma unroll
        for (int d0 = 0; d0 < 4; ++d0) qr[d0] = *(const bf16x8*)(xq + row * XW + h * 64 + d0 * 16 + hi * 8);
        f32x16 p[8];
#pragma unroll
        for (int i = 0; i < 8; ++i)
#pragma unroll
            for (int r = 0; r < 16; ++r) p[i][r] = 0.f;
        const lds_cptr kp = (lds_cptr)(LAS unsigned char*)lds + hi * 1024 + r32 * 16;
#pragma unroll
        for (int tl = 0; tl < 4; ++tl)
#pragma unroll
            for (int d0 = 0; d0 < 4; ++d0) {
                const bf16x8 ka = *(const __attribute__((address_space(3))) bf16x8*)(kp + tl * 8192 + d0 * 2048);
                const bf16x8 kb = *(const __attribute__((address_space(3))) bf16x8*)(kp + tl * 8192 + d0 * 2048 + 512);
                p[2 * tl] = SBA_MFMA(ka, qr[d0], p[2 * tl]); p[2 * tl + 1] = SBA_MFMA(kb, qr[d0], p[2 * tl + 1]);
            }
        float m = p[0][0];
#pragma unroll
        for (int i = 0; i < 8; ++i)
#pragma unroll
            for (int r = 0; r < 16; ++r) m = fmaxf(m, p[i][r]);
        { const auto sw = __builtin_amdgcn_permlane32_swap(__float_as_uint(m), __float_as_uint(m), false, false); m = fmaxf(__uint_as_float(sw[0]), __uint_as_float(sw[1])); }
        float l = 0.f;
#pragma unroll
        for (int i = 0; i < 8; ++i)
#pragma unroll
            for (int r = 0; r < 16; ++r) { p[i][r] = __builtin_amdgcn_exp2f(p[i][r] - m); l += p[i][r]; }
        { const auto sw = __builtin_amdgcn_permlane32_swap(__float_as_uint(l), __float_as_uint(l), false, false); l = __uint_as_float(sw[0]) + __uint_as_float(sw[1]); }
        f32x16 o0, o1;
#pragma unroll
        for (int r = 0; r < 16; ++r) { o0[r] = 0.f; o1[r] = 0.f; }
        const lds_cptr vp = (lds_cptr)(LAS unsigned char*)lds + 32768 + ((lane >> 4) & 1) * 32 + (lane & 3) * 8 + (4 * hi + ((lane & 15) >> 2)) * 64;
#pragma unroll
        for (int tl = 0; tl < 4; ++tl)
#pragma unroll
            for (int X = 0; X < 4; ++X) {
                const bf16x8 a = pack8(p[2 * tl + (X >> 1)], (X & 1) * 8);
                o0 = SBA_MFMA(vfrag(vp + tl * 8192 + X * 1024), a, o0); o1 = SBA_MFMA(vfrag(vp + tl * 8192 + 4096 + X * 1024), a, o1);
            }
        const float inv = 1.f / l;
        const bf16_t* gr = gate + row * DM + 768 + h * 64; bf16_t* orow = O + row * DM + 768 + h * 64;
#pragma unroll
        for (int half = 0; half < 2; ++half)
#pragma unroll
            for (int g = 0; g < 4; ++g) { const int d = 32 * half + 8 * g + 4 * hi; const uint2 gt = *(const uint2*)(gr + d);
                const f32x16& o = half ? o1 : o0;
                uint2 w; w.x = pack2(o[4 * g] * inv * __uint_as_float(gt.x << 16), o[4 * g + 1] * inv * __uint_as_float(gt.x & 0xffff0000u));
                w.y = pack2(o[4 * g + 2] * inv * __uint_as_float(gt.y << 16), o[4 * g + 3] * inv * __uint_as_float(gt.y & 0xffff0000u));
                *(uint2*)(orow + d) = w; }
    }
    __syncthreads();
}

__device__ __forceinline__ void p3_scan_and_sb(const Params& P, float* lds) {
    const int tid = threadIdx.x, lane = tid & 63, wave = tid >> 6;
    for (int task = blockIdx.x * 8 + wave; task < DB * RH * 16; task += gridDim.x * 8) {
        const int rg = task & 15, bh = task >> 4, b = bh / RH, h = bh % RH;
        scan_rows(P, NTOK + b, 1, h, rg * 4, P.state_wkv + (size_t)bh * HD * HD, P.out + OUT_WKV_S + (size_t)bh * HD * HD, lane);
    }
    if (blockIdx.x < 96) {
        const int bh = blockIdx.x >> 2, quarter = blockIdx.x & 3, b = bh / RH, h = bh % RH;
        volatile LAS unsigned* scw = (volatile LAS unsigned*)((LAS unsigned char*)lds + SC_CTL_OFF);
        if (tid < 5) scw[tid] = 0u;
        __syncthreads();
        scan_prompt_wave(P, (unsigned char*)lds, b, h, quarter);
        if (wave >= 5 + SC_FREE_WAVES) {
            constexpr unsigned NCHU = SEQ / SCH;
            while (scw[1] < NCHU || scw[2] < NCHU || scw[3] < NCHU || scw[4] < NCHU) __builtin_amdgcn_s_sleep(32);
        }
    } else {
        volatile LAS unsigned* qw = (volatile LAS unsigned*)((LAS unsigned char*)lds + LDS_CTL + 16);
        unsigned* qhead = (unsigned*)(P.ws + WS_BAR) + QW_SB;
        unsigned nxt = 0u;
        if (tid == 0) nxt = atomicAdd(qhead, 1u);
        for (;;) {
            if (tid == 0) qw[0] = nxt;
            __syncthreads();
            const unsigned u = qw[0];
            __syncthreads();
            if (u >= 384u) break;
            if (tid == 0) nxt = atomicAdd(qhead, 1u);
            const int qb = 15 - (int)(u / 24u), bh = (int)(u % 24u);
            sba::unit(P, (unsigned char*)lds, bh / SH, bh % SH, qb);
        }
    }
    sb_decode_wave_loop(P, lds);
    __syncthreads();
}

__device__ __forceinline__ void p4_combine(const Params& P, float* lds) {
    const int tid = threadIdx.x, lane = tid & 63, wave = tid >> 6;
    const float* oraw = (const float*)(P.ws + WS_ORAW); const float* RSB = (const float*)(P.ws + WS_RSB);
    const bf16_t* gate = (const bf16_t*)(P.ws + WS_GATE); bf16_t* O = (bf16_t*)(P.ws + WS_O);
    for (int it = blockIdx.x * 512 + tid; it < NTK * RH * 16; it += gridDim.x * 512) {
        const int c = it & 15, th = it >> 4, h = th % RH, tok = th / RH;
        const size_t o = (size_t)tok * RW + h * 64 + 4 * c;
        const float4 v = *(const float4*)(oraw + o);
        const float mean = sum16(v.x + v.y + v.z + v.w) * (1.f / 64.f);
        const float dx = v.x - mean, dy = v.y - mean, dz = v.z - mean, dw = v.w - mean;
        const float var = sum16(dx * dx + dy * dy + dz * dz + dw * dw) * (1.f / 64.f);
        const float rs = rsqrtf(var + GN_EPS);
        const float4 g = *(const float4*)(P.lnx_g + h * 64 + 4 * c), bb = *(const float4*)(P.lnx_b + h * 64 + 4 * c), vv = *(const float4*)(RSB + ((size_t)tok * RH + h) * RSB_BLK + 320 + 4 * c);
        const float rk = RSB[((size_t)tok * RH + h) * RSB_BLK + 386];
        const uint2 gt = *(const uint2*)(gate + (size_t)tok * DM + h * 64 + 4 * c);
        const float r0 = (dx * rs * g.x + bb.x + rk * vv.x) * __uint_as_float(gt.x << 16), r1 = (dy * rs * g.y + bb.y + rk * vv.y) * __uint_as_float(gt.x & 0xffff0000u);
        const float r2 = (dz * rs * g.z + bb.z + rk * vv.z) * __uint_as_float(gt.y << 16), r3 = (dw * rs * g.w + bb.w + rk * vv.w) * __uint_as_float(gt.y & 0xffff0000u);
        uint2 w; w.x = pack2(r0, r1); w.y = pack2(r2, r3);
        *(uint2*)(O + (size_t)tok * DM + h * 64 + 4 * c) = w;
    }
    const float* dpart = (const float*)(P.ws + WS_DPART); const float* dl = (const float*)(P.ws + WS_DL);
    float* coef = lds + wave * 128;
    for (int task = blockIdx.x * 8 + wave; task < DB * SH; task += gridDim.x * 8) {
        const int b = task / SH, h = task % SH;
        const float L0 = dl[(size_t)(b * NPAGES + 2 * lane) * SH + h], L1 = dl[(size_t)(b * NPAGES + 2 * lane + 1) * SH + h];
        float incl = L0 + L1;
#pragma unroll
        for (int off = 1; off < 64; off <<= 1) { const float t = __shfl_down(incl, off); if (lane + off < 64) incl += t; }
        const float excl = incl - (L0 + L1);
        coef[2 * lane] = exp2f(-(excl + L1)); coef[2 * lane + 1] = exp2f(-excl);
        asm volatile("s_waitcnt lgkmcnt(0)" ::: "memory");
        __builtin_amdgcn_wave_barrier();
        float o = 0.f;
#pragma unroll 16
        for (int j = 0; j < NPAGES; ++j) o += coef[j] * dpart[((size_t)(b * NPAGES + j) * SH + h) * HD + lane];
        const size_t row = NTOK + b;
        O[row * DM + 384 + h * 64 + lane] = f2bf(o * bf2f(gate[row * DM + 384 + h * 64 + lane]));
        __builtin_amdgcn_wave_barrier();
    }
    for (int i = blockIdx.x * 512 + tid; i < (ROWS_P - NTK) * DM / 4; i += gridDim.x * 512) *(uint2*)(O + (size_t)NTK * DM + (size_t)i * 4) = make_uint2(0u, 0u);
}

__device__ __forceinline__ void p5_sample_out(const Params& P) {
    const int tid = threadIdx.x, row = tid >> 4, kq = tid & 15;
    const bf16_t* O = (const bf16_t*)(P.ws + WS_O) + (size_t)(NTOK + row) * DM + kq * 64;
    const bf16_t* Bt2 = (const bf16_t*)(P.ws + WS_BT2);
    float* yun = (float*)(P.ws + WS_YUN);
    for (int cb = blockIdx.x; cb < DM / 4; cb += gridDim.x) {
        float acc[4] = {0.f, 0.f, 0.f, 0.f};
#pragma unroll
        for (int k8 = 0; k8 < 8; ++k8) {
            const uint4 ov = *(const uint4*)(O + k8 * 8); const unsigned oo[4] = {ov.x, ov.y, ov.z, ov.w};
#pragma unroll
            for (int c = 0; c < 4; ++c) { const uint4 wv = *(const uint4*)(Bt2 + (size_t)(cb * 4 + c) * DM + kq * 64 + k8 * 8); const unsigned ww[4] = {wv.x, wv.y, wv.z, wv.w};
#pragma unroll
                for (int j = 0; j < 4; ++j) acc[c] += __uint_as_float(oo[j] << 16) * __uint_as_float(ww[j] << 16) + __uint_as_float(oo[j] & 0xffff0000u) * __uint_as_float(ww[j] & 0xffff0000u); }
        }
#pragma unroll
        for (int c = 0; c < 4; ++c) acc[c] = sum16(acc[c]);
        if (kq == 0) { const size_t o = (size_t)(NTOK + row) * DM + cb * 4; const float4 xv = *(const float4*)(P.x_sample + (size_t)row * DM + cb * 4);
            *(float4*)(yun + o) = make_float4(xv.x + acc[0], xv.y + acc[1], xv.z + acc[2], xv.w + acc[3]); }
    }
}

__device__ __forceinline__ void p6_final_norm(const Params& P) {
    const int tid = threadIdx.x, lane = tid & 63, wave = tid >> 6;
    const float* yun = (const float*)(P.ws + WS_YUN);
    const int gw = blockIdx.x * 8 + wave, nw = gridDim.x * 8;
    for (int r0 = gw; r0 < NTK; r0 += 2 * nw) {
        float4 x[2][4]; float ss[2] = {0.f, 0.f}; bool live[2]; float* dsts[2];
#pragma unroll
        for (int q = 0; q < 2; ++q) { const int r = r0 + q * nw; live[q] = r < NTK; const int rr = live[q] ? r : 0;
            dsts[q] = rr < NTOK ? P.out + OUT_Y_P + (size_t)rr * DM : P.out + OUT_Y_S + (size_t)(rr - NTOK) * DM;
#pragma unroll
            for (int j = 0; j < 4; ++j) x[q][j] = *(const float4*)(yun + (size_t)rr * DM + 4 * lane + 256 * j); }
#pragma unroll
        for (int q = 0; q < 2; ++q) {
#pragma unroll
            for (int j = 0; j < 4; ++j) ss[q] += x[q][j].x * x[q][j].x + x[q][j].y * x[q][j].y + x[q][j].z * x[q][j].z + x[q][j].w * x[q][j].w;
            ss[q] = wave_sum_fast(ss[q]); }
#pragma unroll
        for (int q = 0; q < 2; ++q) { if (!live[q]) continue;
            const float rs = rsqrtf(ss[q] * (1.f / DM) + NORM_EPS);
#pragma unroll
            for (int j = 0; j < 4; ++j) { const float4 gg = *(const float4*)(P.final_norm_g + 4 * lane + 256 * j);
                *(float4*)(dsts[q] + 4 * lane + 256 * j) = make_float4(x[q][j].x * rs * gg.x, x[q][j].y * rs * gg.y, x[q][j].z * rs * gg.z, x[q][j].w * rs * gg.w); } }
    }
}

constexpr int NPHASE = 7;
__global__ void __launch_bounds__(512, 2) mk_fwd(Params P) {
    extern __shared__ __attribute__((aligned(16))) unsigned char lds[];
    volatile LAS unsigned* xbw = (volatile LAS unsigned*)((LAS unsigned char*)lds + LDS_CTL);
    if (threadIdx.x < 4) xbw[threadIdx.x] = 0u;
    __syncthreads();
    XcdBarrier bar; bar.bar = (unsigned*)(P.ws + WS_BAR); bar.x = 0; bar.st = xbw;
#if MK_N_LAUNCHES == 1
    bar = xcd_barrier_post((unsigned*)(P.ws + WS_BAR), xbw);
#endif
    const int lo = P.ph_lo, hi = P.ph_hi;
#define IN(k) (lo <= (k) && (k) < hi)
#define SEAM(k) do { if (IN(k) && IN((k) + 1)) xcd_barrier(bar); } while (0)
    float* ldsf = (float*)lds;
    if (IN(0)) { for (int rep = 0; rep < NREP(0); ++rep) p0_prologue(P, ldsf); }
    SEAM(0);
    if (IN(1)) {
        pg8::Gemm g{(const bf16_t*)(P.ws + WS_A1), (const bf16_t*)(P.ws + WS_BT1), MROWS1, NB1, DM};
        pg8::GridOrder S; S.init(65, 15, 8, 65, 15, 2, (int)gridDim.x, (int)((blockIdx.x % 8) * (gridDim.x / 8) + blockIdx.x / 8));
        EpiG1 E{(bf16_t*)(P.ws + WS_PRW), (bf16_t*)(P.ws + WS_QB), (bf16_t*)(P.ws + WS_KB), (bf16_t*)(P.ws + WS_VB), (bf16_t*)(P.ws + WS_XQ), (bf16_t*)(P.ws + WS_GATE), P.out};
        for (int rep = 0; rep < NREP(1); ++rep) pg8::gemm_phase<EpiG1, pg8::GridOrder>((PG8_LAS unsigned char*)lds, g, S, E);
    }
    SEAM(1);
    if (IN(2)) {
        for (int rep = 0; rep < NREP(20); ++rep) p2_rwkv_prep(P, ldsf);
        for (int rep = 0; rep < NREP(21); ++rep) p2_xattn_prompt(P, lds);
        for (int rep = 0; rep < NREP(22); ++rep) p2_xattn_sample(P, ldsf);
    }
    SEAM(2);
    if (IN(3)) { p3_scan_and_sb(P, ldsf); }
    SEAM(3);
    if (IN(4)) { for (int rep = 0; rep < NREP(4); ++rep) p4_combine(P, ldsf); }
    SEAM(4);
    if (IN(5)) {
        pg8::Gemm g{(const bf16_t*)(P.ws + WS_O), (const bf16_t*)(P.ws + WS_BT2), NTOK, DM, DM};
        pg8::GridOrder S; S.init(64, 4, 0, 0, 0, 1, (int)gridDim.x, (int)((blockIdx.x % 8) * (gridDim.x / 8) + blockIdx.x / 8));
        EpiG2 E{P.x_prompt, P.x_sample, (float*)(P.ws + WS_YUN)};
        for (int rep = 0; rep < NREP(5); ++rep) pg8::gemm_phase<EpiG2, pg8::GridOrder>((PG8_LAS unsigned char*)lds, g, S, E);
        p5_sample_out(P);
    }
    SEAM(5);
    if (IN(6)) { for (int rep = 0; rep < NREP(6); ++rep) p6_final_norm(P); }
#undef IN
#undef SEAM
}

extern "C" void kernel_launch(void* const* d_in, const int* in_sizes, int n_in, void* d_out, int out_size, void* d_ws, size_t ws_size, hipStream_t stream) {
    static int grid = 0;
    if (grid == 0) {
        if (n_in != 28 || (size_t)out_size != OUT_END || ws_size < WS_END) { fprintf(stderr, "kernel_launch: unexpected shapes: n_in %d out %d (want %zu) ws %zu (want %zu)\n", n_in, out_size, (size_t)OUT_END, ws_size, (size_t)WS_END); grid = -1; return; }
        int dev = 0, cus = 0, per_cu = 0;
        if (hipGetDevice(&dev) != hipSuccess || hipDeviceGetAttribute(&cus, hipDeviceAttributeMultiprocessorCount, dev) != hipSuccess) { grid = -1; return; }
        if (hipFuncSetAttribute((const void*)mk_fwd, hipFuncAttributeMaxDynamicSharedMemorySize, LDS_BYTES) != hipSuccess) { fprintf(stderr, "kernel_launch: hipFuncSetAttribute failed\n"); grid = -1; return; }
        if (hipOccupancyMaxActiveBlocksPerMultiprocessor(&per_cu, (const void*)mk_fwd, 512, LDS_BYTES) != hipSuccess || per_cu < 1) fprintf(stderr, "kernel_launch: occupancy query says %d\n", per_cu);
        (void)hipGetLastError();
        grid = cus;
        if (grid % 8 != 0) grid -= grid % 8;
    }
    if (grid < 0) return;
    (void)hipMemsetAsync((char*)d_ws + WS_BAR, 0, 16384, stream);
    Params P{};
    P.x_prompt = (const float*)d_in[0]; P.mem_prompt = (const float*)d_in[1]; P.x_sample = (const float*)d_in[2]; P.cache_k = (const float*)d_in[3]; P.cache_v = (const float*)d_in[4];
    P.page_table = (const int*)d_in[5]; P.state_wkv = (const float*)d_in[6]; P.state_shift = (const float*)d_in[7]; P.cmem_k = (const float*)d_in[8]; P.cmem_v = (const float*)d_in[9];
    P.norm_g = (const float*)d_in[10]; P.w_in = (const float*)d_in[11]; P.sb_bias = (const float*)d_in[12]; P.mu_shift = (const float*)d_in[13]; P.w0 = (const float*)d_in[14];
    P.w_lora_b = (const float*)d_in[15]; P.a0 = (const float*)d_in[16]; P.a_lora_b = (const float*)d_in[17]; P.k_k = (const float*)d_in[18]; P.k_a = (const float*)d_in[19]; P.r_k = (const float*)d_in[20];
    P.lnx_g = (const float*)d_in[21]; P.lnx_b = (const float*)d_in[22]; P.mem_norm_g = (const float*)d_in[23]; P.w_mem_k = (const float*)d_in[24]; P.w_mem_v = (const float*)d_in[25];
    P.w_out = (const float*)d_in[26]; P.final_norm_g = (const float*)d_in[27];
    P.out = (float*)d_out; P.ws = (unsigned char*)d_ws;
#if MK_N_LAUNCHES == 1
    P.ph_lo = 0; P.ph_hi = NPHASE;
    hipLaunchKernelGGL(mk_fwd, dim3(grid), dim3(512), LDS_BYTES, stream, P);
#else
    for (int ph = 0; ph < NPHASE; ++ph) { P.ph_lo = ph; P.ph_hi = ph + 1; hipLaunchKernelGGL(mk_fwd, dim3(grid), dim3(512), LDS_BYTES, stream, P); }
#endif
    const hipError_t le = hipPeekAtLastError();
    if (le != hipSuccess) fprintf(stderr, "kernel_launch: launch failed: %s\n", hipGetErrorName(le));
}
```

```cpp
#include <hip/hip_runtime.h>
#include <cstdio>
#include <cstdint>

#ifndef MK_REP
#define MK_REP -1
#endif
#define NREP(id) ((MK_REP) == (id) ? 2 : 1)
#ifndef MK_N_LAUNCHES
#define MK_N_LAUNCHES 1
#endif

constexpr int DM = 1024, NB = 4, SEQ = 4096, NTOK = NB * SEQ, DB = 32, NPAGES = 128, PAGE = 128;
constexpr int HD = 64, RH = 6, SH = 6, XH = 4, NMEM = 256;
constexpr int RW = 384, SBW = 384, XW = 256, RCOLS = 1280, DIN = 3712;
constexpr int NTK = NTOK + DB;
constexpr int ROWS_P = 16640;
constexpr int MEMROW0 = 16640;
constexpr int MROWS1 = 17664;
constexpr int NB1 = 4352;
constexpr float LOG2E = 1.4426950408889634f, QSCALE = 0.125f * 1.4426950408889634f;
constexpr float NORM_EPS = 1e-6f, GN_EPS = 64e-5f, DECAY_SCALE = 0.60653065971263342f;

constexpr size_t OUT_Y_P = 0;
constexpr size_t OUT_Y_S = OUT_Y_P + (size_t)NTOK * DM;
constexpr size_t OUT_SBK_P = OUT_Y_S + (size_t)DB * DM;
constexpr size_t OUT_SBV_P = OUT_SBK_P + (size_t)NTOK * SBW;
constexpr size_t OUT_WKV_P = OUT_SBV_P + (size_t)NTOK * SBW;
constexpr size_t OUT_SHIFT_P = OUT_WKV_P + (size_t)NB * RH * HD * HD;
constexpr size_t OUT_MK_P = OUT_SHIFT_P + (size_t)NB * RCOLS;
constexpr size_t OUT_MV_P = OUT_MK_P + (size_t)NB * NMEM * XW;
constexpr size_t OUT_SBK_S = OUT_MV_P + (size_t)NB * NMEM * XW;
constexpr size_t OUT_SBV_S = OUT_SBK_S + (size_t)DB * SBW;
constexpr size_t OUT_WKV_S = OUT_SBV_S + (size_t)DB * SBW;
constexpr size_t OUT_SHIFT_S = OUT_WKV_S + (size_t)DB * RH * HD * HD;
constexpr size_t OUT_END = OUT_SHIFT_S + (size_t)DB * RCOLS;

constexpr size_t al256(size_t x) { return (x + 255) & ~(size_t)255; }
constexpr int NPREP = 171, QW_PREP_W = 3904;
constexpr size_t WS_BAR = 0;
constexpr size_t WS_A1 = 16384;
constexpr size_t WS_BT1 = WS_A1 + al256((size_t)MROWS1 * DM * 2);
constexpr size_t WS_BT2 = WS_BT1 + al256((size_t)NB1 * DM * 2);
constexpr size_t WS_PRW = WS_BT2 + al256((size_t)DM * DM * 2);
constexpr size_t WS_QB = WS_PRW + al256((size_t)ROWS_P * RCOLS * 2);
constexpr size_t WS_KB = WS_QB + al256((size_t)ROWS_P * SBW * 2);
constexpr size_t WS_VB = WS_KB + al256((size_t)ROWS_P * SBW * 2);
constexpr size_t WS_XQ = WS_VB + al256((size_t)ROWS_P * SBW * 2);
constexpr size_t WS_GATE = WS_XQ + al256((size_t)ROWS_P * XW * 2);
constexpr int RSB_BLK = 388;
constexpr size_t WS_RSB = WS_GATE + al256((size_t)ROWS_P * DM * 2);
constexpr size_t WS_ORAW = WS_RSB + al256((size_t)NTK * RH * RSB_BLK * 4);
constexpr size_t WS_O = WS_ORAW + al256((size_t)NTK * RW * 4);
constexpr size_t WS_YUN = WS_O + al256((size_t)ROWS_P * DM * 2);
constexpr size_t WS_DPART = WS_YUN + al256((size_t)ROWS_P * DM * 4);
constexpr size_t WS_DL = WS_DPART + al256((size_t)DB * NPAGES * SH * HD * 4);
constexpr size_t WS_LFRAG = WS_DL + al256((size_t)DB * NPAGES * SH * 4);
constexpr size_t WS_END = WS_LFRAG + al256((size_t)2 * 2 * 6 * 4 * 2 * 64 * 16);

constexpr int LDS_STAGE = 131072;
constexpr int LDS_CTL = 155648;
constexpr int LDS_BYTES = LDS_CTL + 1024;

typedef unsigned short bf16_t;

#define XB_TMO      128
#define XB_XCNT(j)  (256  + 64 * (j))
#define XB_XSUB(j)  (1280 + 64 * (j))
#define XB_XGEN(j)  (2304 + 64 * (j))
#define XB_TOP      3328
#define XB_TOPGEN   3392
#define XCD_BAR_WORDS 3456
#define XB_SPIN_CAP (1u << 18)
#define LAS __attribute__((address_space(3)))

__device__ __forceinline__ unsigned xb_ld(unsigned* p)              { return __hip_atomic_load(p, __ATOMIC_RELAXED, __HIP_MEMORY_SCOPE_AGENT); }
__device__ __forceinline__ unsigned xb_add(unsigned* p, unsigned v) { return __hip_atomic_fetch_add(p, v, __ATOMIC_RELAXED, __HIP_MEMORY_SCOPE_AGENT); }
__device__ __forceinline__ unsigned xb_xcc_id() { return (unsigned)__builtin_amdgcn_s_getreg((3 << 11) | 20) & 0xFu; }
#define XB_SPIN(cond, bar) do { unsigned _sp = 0; while (cond) { __builtin_amdgcn_s_sleep(1); \
    if ((++_sp & 255u) == 0u) { if (xb_ld(&(bar)[XB_TMO])) break; if (_sp > XB_SPIN_CAP) { atomicAdd(&(bar)[XB_TMO], 1u); break; } } } } while (0)

struct XcdBarrier {
    unsigned* bar; unsigned x;
    volatile LAS unsigned* st;
};
__device__ __forceinline__ XcdBarrier xcd_barrier_post(unsigned* bar, volatile LAS unsigned* st) {
    XcdBarrier b; b.bar = bar; b.x = xb_xcc_id(); b.st = st;
    if (threadIdx.x == 0) (void)xb_add(&bar[XB_XCNT(b.x)], 1u);
    return b;
}
__device__ __forceinline__ void xcd_barrier_complete(unsigned* bar, unsigned x, unsigned& nloc, unsigned& nx) {
    const unsigned G = gridDim.x * gridDim.y * gridDim.z;
    unsigned sum, cnt, mine, sp = 0u;
    for (;;) {
        sum = 0u; cnt = 0u; mine = 0u;
#pragma unroll
        for (unsigned j = 0; j < 16; ++j) { const unsigned c = xb_ld(&bar[XB_XCNT(j)]); sum += c; cnt += (c > 0u) ? 1u : 0u; mine = (j == x) ? c : mine; }
        if (sum == G) break;
        __builtin_amdgcn_s_sleep(1);
        if ((++sp & 255u) == 0u) { if (xb_ld(&bar[XB_TMO])) break; if (sp > XB_SPIN_CAP) { atomicAdd(&bar[XB_TMO], 1u); break; } }
    }
    nloc = mine > 0u ? mine : 1u; nx = cnt > 0u ? cnt : 1u;
}
__device__ __forceinline__ void xcd_barrier(const XcdBarrier& b) {
    asm volatile("s_waitcnt vmcnt(0)" ::: "memory");
    __syncthreads();
    if (threadIdx.x == 0) {
        unsigned* bar = b.bar;
        __builtin_amdgcn_s_waitcnt(0);
        unsigned nloc = b.st[0], nx = b.st[1];
        if (nloc == 0u) { xcd_barrier_complete(bar, b.x, nloc, nx); b.st[0] = nloc; b.st[1] = nx; }
        const unsigned old = xb_add(&bar[XB_XSUB(b.x)], 1u);
        const unsigned gen = old / nloc;
        if (old + 1u == (gen + 1u) * nloc) {
            __builtin_amdgcn_fence(__ATOMIC_RELEASE, "agent");
            asm volatile("s_waitcnt vmcnt(0)" ::: "memory");
            const unsigned og = xb_add(&bar[XB_TOP], 1u);
            const unsigned tg = og / nx;
            if (og + 1u == (tg + 1u) * nx) xb_add(&bar[XB_TOPGEN], 1u);
            else XB_SPIN(xb_ld(&bar[XB_TOPGEN]) == tg, bar);
            __builtin_amdgcn_fence(__ATOMIC_ACQUIRE, "agent");
            xb_add(&bar[XB_XGEN(b.x)], 1u);
            asm volatile("s_waitcnt vmcnt(0)" ::: "memory");
        } else {
            XB_SPIN(xb_ld(&bar[XB_XGEN(b.x)]) == gen, bar);
            __builtin_amdgcn_fence(__ATOMIC_ACQUIRE, "agent");
            asm volatile("s_waitcnt vmcnt(0)" ::: "memory");
        }
    }
    __syncthreads();
}

namespace pg8 {
#define PG8_LAS __attribute__((address_space(3)))
typedef short bf16x8 __attribute__((ext_vector_type(8)));
typedef float f32x4 __attribute__((ext_vector_type(4)));
typedef unsigned u32x4 __attribute__((ext_vector_type(4)));
constexpr int BM = 256, BK = 64, HALF = 128, HTB = HALF * BK * 2, STAGE_BYTES = 8 * HTB, NXCD = 8, WGM = 8;

__host__ __device__ __forceinline__ int lds_byte(int r, int c) { const int st = (r >> 4) * 2 + (c >> 5), rr = r & 15, cc = c & 31, ob = rr * 64 + cc * 2; return st * 1024 + (ob ^ (((ob >> 9) & 1) << 5)); }
__host__ __device__ __forceinline__ void stage_rc(int b, int& R, int& C) { const int st = b / 1024, sb = b % 1024, swz = sb ^ (((sb >> 9) & 1) << 5); R = (st >> 1) * 16 + swz / 64; C = (st & 1) * 32 + (swz % 64) / 2; }
__host__ __device__ __forceinline__ int perm32(int rho) { const int n = rho >> 4, i = rho & 15; return 8 * (i >> 2) + 4 * n + (i & 3); }

struct Unit { int pm, pn; };
struct Gemm { const bf16_t* A; const bf16_t* Bt; int M, N, K; };

struct GridOrder {
    int nM, nN, nmain, nextra, xm0, xn0, xnn, G, c;
    __device__ void init(int nM_, int nN_, int nextra_, int xm0_, int xn0_, int xnn_, int G_, int c_) { nM = nM_; nN = nN_; nmain = nM_ * nN_; nextra = nextra_; xm0 = xm0_; xn0 = xn0_; xnn = xnn_; G = G_; c = c_; }
    __device__ bool next(int i, Unit& u) const {
        const int L = i * G + c; if (L >= nmain + nextra) return false;
        if (L >= nmain) { const int e = L - nmain; u.pm = xm0 + e / xnn; u.pn = xn0 + e % xnn; return true; }
        const int wgid = L;
        const int nig = WGM * nN, gid = wgid / nig, fm = gid * WGM, gsz = (nM - fm) < WGM ? (nM - fm) : WGM;
        u.pm = fm + ((wgid % nig) % gsz); u.pn = (wgid % nig) / gsz; return true;
    }
    __device__ __forceinline__ void a_ready(const Unit&) const {}
    __device__ __forceinline__ void done(const Unit&) const {}
};

template <class Epi, class Sched>
__device__ __forceinline__ void gemm_phase(PG8_LAS unsigned char* lds, const Gemm g, const Sched& S, const Epi& E) {
    const int tid = threadIdx.x, wid = __builtin_amdgcn_readfirstlane(tid >> 6), lane = tid & 63, wr = wid >> 2, wc = wid & 3, fr = lane & 15, fq = lane >> 4;
    const int K = g.K, nt = K / BK;
    unsigned voffA[2], voffB[2];
#pragma unroll
    for (int i = 0; i < 2; ++i) { int R, C; stage_rc(tid * 16 + i * 8192, R, C); const int Rb = Epi::PERM ? ((R & ~31) + perm32(R & 31)) : R;
        voffA[i] = (unsigned)(R * K + C) * 2u; voffB[i] = (unsigned)(Rb * K + C) * 2u; }
    const size_t kstep = (size_t)(BK * 2);
    const size_t hstep = (size_t)HALF * K * 2;
    const size_t tstep = 2 * hstep;
    const unsigned ldsw = (unsigned)wid * 1024u;
    const int aoff = lds_byte(wr * 64 + fr, fq * 8), boff = lds_byte(wc * 32 + fr, fq * 8);
#define PG8_SA(b, h) (((b) * 2 + (h)) * HTB)
#define PG8_SB(b, h) ((4 + (b) * 2 + (h)) * HTB)
#define PG8_STAGE(bufoff, gbase, voff) do { _Pragma("unroll") for (int _i = 0; _i < 2; ++_i) \
        __builtin_amdgcn_global_load_lds((const unsigned*)((const char*)(gbase) + (voff)[_i]), (PG8_LAS unsigned*)(lds + (bufoff) + ldsw + _i * 8192), 16, 0, 0); } while (0)
#define PG8_LDA(dst, b, h) do { _Pragma("unroll") for (int m = 0; m < 4; ++m) _Pragma("unroll") for (int k = 0; k < 2; ++k) dst[m][k] = *(const PG8_LAS bf16x8*)(lds + PG8_SA(b, h) + aoff + m * 2048 + k * 1024); } while (0)
#define PG8_LDB(dst, b, h) do { _Pragma("unroll") for (int n = 0; n < 2; ++n) _Pragma("unroll") for (int k = 0; k < 2; ++k) dst[n][k] = *(const PG8_LAS bf16x8*)(lds + PG8_SB(b, h) + boff + n * 2048 + k * 1024); } while (0)
#define PG8_MMA(ai, bj, At, Bt) do { __builtin_amdgcn_s_setprio(1); _Pragma("unroll") for (int m = 0; m < 4; ++m) _Pragma("unroll") for (int n = 0; n < 2; ++n) _Pragma("unroll") for (int k = 0; k < 2; ++k) \
        acc[ai][bj][m][n] = __builtin_amdgcn_mfma_f32_16x16x32_bf16(Bt[n][k], At[m][k], acc[ai][bj][m][n], 0, 0, 0); __builtin_amdgcn_s_setprio(0); } while (0)
#define PG8_WAIT_V(n) asm volatile("s_waitcnt vmcnt(" #n ")" ::: "memory")
#define PG8_WAIT_L(n) asm volatile("s_waitcnt lgkmcnt(" #n ")" ::: "memory")
#define PG8_BAR __builtin_amdgcn_s_barrier()
#define PG8_SCHED __builtin_amdgcn_sched_barrier(0)
    Unit cur, nxt; int ui = 0;
    if (!S.next(0, cur)) return;
    f32x4 acc[2][2][4][2];
#pragma unroll
    for (int a = 0; a < 2; ++a)
#pragma unroll
        for (int b = 0; b < 2; ++b)
#pragma unroll
            for (int m = 0; m < 4; ++m)
#pragma unroll
                for (int n = 0; n < 2; ++n) acc[a][b][m][n] = (f32x4){0.f, 0.f, 0.f, 0.f};
    bf16x8 At[4][2], B0[2][2], B1[2][2];
    const char* cA = (const char*)g.A + (size_t)cur.pm * tstep; const char* cB = (const char*)g.Bt + (size_t)cur.pn * tstep;
    S.a_ready(cur);
    PG8_STAGE(PG8_SB(0, 0), cB, voffB); PG8_STAGE(PG8_SA(0, 0), cA, voffA); PG8_STAGE(PG8_SB(0, 1), cB + hstep, voffB); PG8_STAGE(PG8_SA(0, 1), cA + hstep, voffA);
    if (wr == 1) PG8_BAR;
    PG8_WAIT_V(4); PG8_BAR;
    PG8_STAGE(PG8_SB(1, 0), cB + kstep, voffB); PG8_STAGE(PG8_SA(1, 0), cA + kstep, voffA); PG8_STAGE(PG8_SB(1, 1), cB + hstep + kstep, voffB);
    PG8_WAIT_V(6); PG8_BAR;
    for (;;) {
        const bool has_next = S.next(ui + 1, nxt);
        const char* nA = has_next ? (const char*)g.A + (size_t)nxt.pm * tstep : cA; const char* nB = has_next ? (const char*)g.Bt + (size_t)nxt.pn * tstep : cB;
        for (int t = 0; t < nt; t += 2) {
            const bool last = (t == nt - 2);
            const char* a1 = cA + (size_t)(t + 1) * kstep;
            const char* a2 = last ? nA : cA + (size_t)(t + 2) * kstep; const char* b2 = last ? nB : cB + (size_t)(t + 2) * kstep;
            const char* a3 = a2 + kstep; const char* b3 = b2 + kstep;
            if (last && has_next) S.a_ready(nxt);
            PG8_LDB(B0, 0, 0); PG8_SCHED; PG8_LDA(At, 0, 0); PG8_STAGE(PG8_SA(1, 1), a1 + hstep, voffA);
            PG8_WAIT_L(8); PG8_BAR; PG8_WAIT_L(0); PG8_MMA(0, 0, At, B0); PG8_BAR; PG8_SCHED;
            PG8_LDB(B1, 0, 1); PG8_STAGE(PG8_SB(0, 0), b2, voffB);
            PG8_BAR; PG8_WAIT_L(0); PG8_MMA(0, 1, At, B1); PG8_BAR;
            PG8_LDA(At, 0, 1); PG8_STAGE(PG8_SA(0, 0), a2, voffA);
            PG8_BAR; PG8_WAIT_L(0); PG8_MMA(1, 0, At, B0); PG8_BAR; PG8_SCHED;
            PG8_STAGE(PG8_SB(0, 1), b2 + hstep, voffB);
            PG8_WAIT_V(6); PG8_BAR; PG8_MMA(1, 1, At, B1); PG8_BAR;
            PG8_LDB(B0, 1, 0); PG8_SCHED; PG8_LDA(At, 1, 0); PG8_STAGE(PG8_SA(0, 1), a2 + hstep, voffA);
            PG8_WAIT_L(8); PG8_BAR; PG8_WAIT_L(0); PG8_MMA(0, 0, At, B0); PG8_BAR; PG8_SCHED;
            PG8_LDB(B1, 1, 1); PG8_STAGE(PG8_SB(1, 0), b3, voffB);
            PG8_BAR; PG8_WAIT_L(0); PG8_MMA(0, 1, At, B1); PG8_BAR;
            PG8_LDA(At, 1, 1); PG8_STAGE(PG8_SA(1, 0), a3, voffA);
            PG8_BAR; PG8_WAIT_L(0); PG8_MMA(1, 0, At, B0); PG8_BAR; PG8_SCHED;
            PG8_STAGE(PG8_SB(1, 1), b3 + hstep, voffB);
            PG8_WAIT_V(6); PG8_BAR; PG8_MMA(1, 1, At, B1); PG8_BAR;
        }
        E(acc, cur, wr, wc, fr, fq); S.done(cur);
        if (!has_next) break;
#pragma unroll
        for (int a = 0; a < 2; ++a)
#pragma unroll
            for (int b = 0; b < 2; ++b)
#pragma unroll
                for (int m = 0; m < 4; ++m)
#pragma unroll
                    for (int n = 0; n < 2; ++n) acc[a][b][m][n] = (f32x4){0.f, 0.f, 0.f, 0.f};
        cur = nxt; cA = nA; cB = nB; ++ui;
    }
    PG8_WAIT_V(0);
    if (wr == 0) PG8_BAR;
    PG8_BAR;
#undef PG8_SA
#undef PG8_SB
#undef PG8_STAGE
#undef PG8_LDA
#undef PG8_LDB
#undef PG8_MMA
#undef PG8_WAIT_V
#undef PG8_WAIT_L
#undef PG8_BAR
#undef PG8_SCHED
}
}

typedef float f32x4 __attribute__((ext_vector_type(4)));
__device__ __forceinline__ float bf2f(bf16_t b) { return __uint_as_float(((unsigned)b) << 16); }
__device__ __forceinline__ bf16_t f2bf(float f) { unsigned u = __float_as_uint(f); u += 0x7FFFu + ((u >> 16) & 1u); return (bf16_t)(u >> 16); }
typedef __bf16 bf16x2_t __attribute__((ext_vector_type(2)));
typedef float f32x2_t __attribute__((ext_vector_type(2)));
__device__ __forceinline__ unsigned pack2(float lo, float hi) { const f32x2_t v = {lo, hi}; return __builtin_bit_cast(unsigned, __builtin_convertvector(v, bf16x2_t)); }
__device__ __forceinline__ float wave_sum(float v) {
#pragma unroll
    for (int o = 32; o >= 1; o >>= 1) v += __shfl_xor(v, o);
    return v;
}
__device__ __forceinline__ float wave_max(float v) {
#pragma unroll
    for (int o = 32; o >= 1; o >>= 1) v = fmaxf(v, __shfl_xor(v, o));
    return v;
}
template <int CTRL> __device__ __forceinline__ float dpp_f(float x) { return __builtin_bit_cast(float, __builtin_amdgcn_update_dpp(0, __builtin_bit_cast(int, x), CTRL, 0xF, 0xF, true)); }
__device__ __forceinline__ float sum16(float v) {
    v += dpp_f<0xB1>(v);
    v += dpp_f<0x4E>(v);
    v += dpp_f<0x124>(v);
    v += dpp_f<0x128>(v);
    return v;
}
__device__ __forceinline__ float wave_sum_fast(float v) {
    v = sum16(v);
    { const auto s = __builtin_amdgcn_permlane16_swap(__float_as_uint(v), __float_as_uint(v), false, false); v = __uint_as_float(s[0]) + __uint_as_float(s[1]); }
    { const auto s = __builtin_amdgcn_permlane32_swap(__float_as_uint(v), __float_as_uint(v), false, false); v = __uint_as_float(s[0]) + __uint_as_float(s[1]); }
    return v;
}
__device__ __forceinline__ float sigmoidf_(float x) { return 1.f / (1.f + __expf(-x)); }
__device__ __forceinline__ float softplusf_(float z) { return fmaxf(z, 0.f) + log1pf(__expf(-fabsf(z))); }
__device__ __forceinline__ float softplus2_(float z2) { return fmaxf(z2, 0.f) + log1pf(exp2f(-fabsf(z2))) * LOG2E; }

struct Params {
    const float *x_prompt, *mem_prompt, *x_sample, *cache_k, *cache_v; const int* page_table;
    const float *state_wkv, *state_shift, *cmem_k, *cmem_v, *norm_g, *w_in, *sb_bias, *mu_shift, *w0, *w_lora_b, *a0, *a_lora_b, *k_k, *k_a, *r_k,
        *lnx_g, *lnx_b, *mem_norm_g, *w_mem_k, *w_mem_v, *w_out, *final_norm_g;
    float* out; unsigned char* ws;
    int ph_lo, ph_hi;
};

struct EpiG1 {
    static constexpr bool PERM = true;
    bf16_t* prw; bf16_t *qb, *kb, *vb, *xq, *gate; float* out;
    __device__ __forceinline__ void operator()(const pg8::f32x4 (&acc)[2][2][4][2], const pg8::Unit& u, int wr, int wc, int fr, int fq) const {
        if (u.pm >= 65) {
            float* dst = out + (u.pn == 15 ? OUT_MK_P : OUT_MV_P);
#pragma unroll
            for (int ai = 0; ai < 2; ++ai)
#pragma unroll
                for (int m = 0; m < 4; ++m) { const int row = (u.pm - 65) * 256 + ai * 128 + wr * 64 + m * 16 + fr;
#pragma unroll
                    for (int bj = 0; bj < 2; ++bj) { const int col = bj * 128 + wc * 32 + 8 * fq;
                        *(pg8::f32x4*)(dst + (size_t)row * 256 + col) = acc[ai][bj][m][0]; *(pg8::f32x4*)(dst + (size_t)row * 256 + col + 4) = acc[ai][bj][m][1]; } }
            return;
        }
#pragma unroll
        for (int bj = 0; bj < 2; ++bj) {
            const int cb = u.pn * 256 + bj * 128;
            if (cb >= DIN) continue;
#pragma unroll
            for (int ai = 0; ai < 2; ++ai)
#pragma unroll
                for (int m = 0; m < 4; ++m) { const int row = u.pm * 256 + ai * 128 + wr * 64 + m * 16 + fr;
                    if (row >= NTK) continue;
                    const int col = cb + wc * 32 + 8 * fq; const pg8::f32x4 v0 = acc[ai][bj][m][0], v1 = acc[ai][bj][m][1];
                    if (cb < 1280) {
                        *(uint4*)(prw + (size_t)row * RCOLS + col) = make_uint4(pack2(v0[0], v0[1]), pack2(v0[2], v0[3]), pack2(v1[0], v1[1]), pack2(v1[2], v1[3]));
                        if (row >= NTOK) { float* e = out + OUT_SHIFT_S + (size_t)(row - NTOK) * RCOLS + col; *(pg8::f32x4*)e = v0; *(pg8::f32x4*)(e + 4) = v1; }
                        else if ((row & (SEQ - 1)) == SEQ - 1) { float* e = out + OUT_SHIFT_P + (size_t)(row >> 12) * RCOLS + col; *(pg8::f32x4*)e = v0; *(pg8::f32x4*)(e + 4) = v1; }
                    } else if (cb < 1664) {
                        *(uint4*)(qb + (size_t)row * SBW + (col - 1280)) = make_uint4(pack2(v0[0] * QSCALE, v0[1] * QSCALE), pack2(v0[2] * QSCALE, v0[3] * QSCALE), pack2(v1[0] * QSCALE, v1[1] * QSCALE), pack2(v1[2] * QSCALE, v1[3] * QSCALE));
                    } else if (cb < 2048) {
                        const int c2 = col - 1664;
                        *(uint4*)(kb + (size_t)row * SBW + c2) = make_uint4(pack2(v0[0], v0[1]), pack2(v0[2], v0[3]), pack2(v1[0], v1[1]), pack2(v1[2], v1[3]));
                        float* e = row < NTOK ? out + OUT_SBK_P + (size_t)row * SBW + c2 : out + OUT_SBK_S + (size_t)(row - NTOK) * SBW + c2; *(pg8::f32x4*)e = v0; *(pg8::f32x4*)(e + 4) = v1;
                    } else if (cb < 2432) {
                        const int c2 = col - 2048;
                        *(uint4*)(vb + (size_t)row * SBW + c2) = make_uint4(pack2(v0[0], v0[1]), pack2(v0[2], v0[3]), pack2(v1[0], v1[1]), pack2(v1[2], v1[3]));
                        float* e = row < NTOK ? out + OUT_SBV_P + (size_t)row * SBW + c2 : out + OUT_SBV_S + (size_t)(row - NTOK) * SBW + c2; *(pg8::f32x4*)e = v0; *(pg8::f32x4*)(e + 4) = v1;
                    } else if (cb < 2688) {
                        *(uint4*)(xq + (size_t)row * XW + (col - 2432)) = make_uint4(pack2(v0[0] * QSCALE, v0[1] * QSCALE), pack2(v0[2] * QSCALE, v0[3] * QSCALE), pack2(v1[0] * QSCALE, v1[1] * QSCALE), pack2(v1[2] * QSCALE, v1[3] * QSCALE));
                    } else {
                        *(uint4*)(gate + (size_t)row * DM + (col - 2688)) = make_uint4(pack2(v0[0] * sigmoidf_(v0[0]), v0[1] * sigmoidf_(v0[1])), pack2(v0[2] * sigmoidf_(v0[2]), v0[3] * sigmoidf_(v0[3])),
                                                                                    pack2(v1[0] * sigmoidf_(v1[0]), v1[1] * sigmoidf_(v1[1])), pack2(v1[2] * sigmoidf_(v1[2]), v1[3] * sigmoidf_(v1[3])));
                    }
                }
        }
    }
};
constexpr int QW_PANEL = 3712, QW_SAMP = 3840;
struct EpiG2N {
    static constexpr bool PERM = true;
    const float* xp; float* yout; const float* g; unsigned* part; unsigned* ctl; float* lf;
    __device__ __forceinline__ void operator()(pg8::f32x4 (&acc)[2][2][4][2], const pg8::Unit& u, int wr, int wc, int fr, int fq) const {
        const int tid = threadIdx.x;
        pg8::f32x4 gg[2][2];
#pragma unroll
        for (int bj = 0; bj < 2; ++bj) { const int col = u.pn * 256 + bj * 128 + wc * 32 + 8 * fq; gg[bj][0] = *(const pg8::f32x4*)(g + col); gg[bj][1] = *(const pg8::f32x4*)(g + col + 4); }
        if (wr == 0) __builtin_amdgcn_s_barrier();
#pragma unroll
        for (int ai = 0; ai < 2; ++ai) {
            pg8::f32x4 xv[4][2][2];
#pragma unroll
            for (int m = 0; m < 4; ++m) { const size_t ro = (size_t)(u.pm * 256 + ai * 128 + wr * 64 + m * 16 + fr) * DM;
#pragma unroll
                for (int bj = 0; bj < 2; ++bj) { const int col = u.pn * 256 + bj * 128 + wc * 32 + 8 * fq;
                    xv[m][bj][0] = *(const pg8::f32x4*)(xp + ro + col); xv[m][bj][1] = *(const pg8::f32x4*)(xp + ro + col + 4); } }
#pragma unroll
            for (int m = 0; m < 4; ++m) { float s = 0.f;
#pragma unroll
                for (int bj = 0; bj < 2; ++bj)
#pragma unroll
                    for (int n = 0; n < 2; ++n) { acc[ai][bj][m][n] += xv[m][bj][n]; const pg8::f32x4 y = acc[ai][bj][m][n]; s += y[0] * y[0] + y[1] * y[1] + y[2] * y[2] + y[3] * y[3]; }
                { const auto t = __builtin_amdgcn_permlane16_swap(__float_as_uint(s), __float_as_uint(s), false, false); s = __uint_as_float(t[0]) + __uint_as_float(t[1]); }
                { const auto t = __builtin_amdgcn_permlane32_swap(__float_as_uint(s), __float_as_uint(s), false, false); s = __uint_as_float(t[0]) + __uint_as_float(t[1]); }
                if (fq == 0) lf[wc * 256 + ai * 128 + wr * 64 + m * 16 + fr] = s; }
        }
        __syncthreads();
        if (tid < 256) { const float p = (lf[tid] + lf[256 + tid]) + (lf[512 + tid] + lf[768 + tid]);
            __hip_atomic_store(part + (size_t)(u.pm * 4 + u.pn) * 256 + tid, __float_as_uint(p), __ATOMIC_RELAXED, __HIP_MEMORY_SCOPE_AGENT); }
        asm volatile("s_waitcnt vmcnt(0)" ::: "memory");
        __syncthreads();
        if (tid == 0) { (void)xb_add(ctl + QW_PANEL + u.pm, 1u); XB_SPIN(xb_ld(ctl + QW_PANEL + u.pm) < 4u, ctl); }
        __syncthreads();
        if (tid < 256) { float tot = 0.f;
#pragma unroll
            for (int pn = 0; pn < 4; ++pn) tot += __uint_as_float(__hip_atomic_load(part + (size_t)(u.pm * 4 + pn) * 256 + tid, __ATOMIC_RELAXED, __HIP_MEMORY_SCOPE_AGENT));
            lf[1024 + tid] = rsqrtf(tot * (1.f / DM) + NORM_EPS); }
        __syncthreads();
#pragma unroll
        for (int ai = 0; ai < 2; ++ai)
#pragma unroll
            for (int m = 0; m < 4; ++m) { const int rl = ai * 128 + wr * 64 + m * 16 + fr; const float rs = lf[1024 + rl]; const size_t ro = (size_t)(u.pm * 256 + rl) * DM;
#pragma unroll
                for (int bj = 0; bj < 2; ++bj) { const int col = u.pn * 256 + bj * 128 + wc * 32 + 8 * fq;
                    *(pg8::f32x4*)(yout + ro + col) = acc[ai][bj][m][0] * rs * gg[bj][0]; *(pg8::f32x4*)(yout + ro + col + 4) = acc[ai][bj][m][1] * rs * gg[bj][1]; } }
        if (wr == 1) __builtin_amdgcn_s_barrier();
    }
};


typedef short prep_bf16x8 __attribute__((ext_vector_type(8)));
typedef float prep_f32x4 __attribute__((ext_vector_type(4)));
__device__ __forceinline__ void split8(const float (&x)[8], prep_bf16x8& hi, prep_bf16x8& lo) {
    unsigned h[4], l[4];
#pragma unroll
    for (int q = 0; q < 4; ++q) { h[q] = pack2(x[2 * q], x[2 * q + 1]);
        const float r0 = x[2 * q] - __uint_as_float(h[q] << 16), r1 = x[2 * q + 1] - __uint_as_float(h[q] & 0xffff0000u); l[q] = pack2(r0, r1); }
    typedef unsigned u4 __attribute__((ext_vector_type(4)));
    const u4 hv = {h[0], h[1], h[2], h[3]}, lv = {l[0], l[1], l[2], l[3]};
    hi = __builtin_bit_cast(prep_bf16x8, hv); lo = __builtin_bit_cast(prep_bf16x8, lv);
}
__device__ __forceinline__ void p0_prologue(const Params& P, float* lds) {
    const int tid = threadIdx.x, lane = tid & 63, wave = tid >> 6;
    bf16_t* A1 = (bf16_t*)(P.ws + WS_A1); bf16_t* Bt1 = (bf16_t*)(P.ws + WS_BT1); bf16_t* Bt2 = (bf16_t*)(P.ws + WS_BT2);
    const int gw = blockIdx.x * 8 + wave, nw = gridDim.x * 8;
    for (int r0 = gw; r0 < MROWS1; r0 += 2 * nw) {
        const float* srcs[2]; const float* gs[2]; bf16_t* dsts[2]; bool live[2];
#pragma unroll
        for (int q = 0; q < 2; ++q) { const int r = r0 + q * nw; live[q] = r < MROWS1; const int rr = live[q] ? r : 0;
            dsts[q] = A1 + (size_t)rr * DM; srcs[q] = nullptr; gs[q] = P.norm_g;
            if (rr < NTOK) srcs[q] = P.x_prompt + (size_t)rr * DM;
            else if (rr < NTK) srcs[q] = P.x_sample + (size_t)(rr - NTOK) * DM;
            else if (rr >= MEMROW0) { srcs[q] = P.mem_prompt + (size_t)(rr - MEMROW0) * DM; gs[q] = P.mem_norm_g; } }
        float4 x[2][4]; float ss[2] = {0.f, 0.f};
#pragma unroll
        for (int q = 0; q < 2; ++q)
#pragma unroll
            for (int j = 0; j < 4; ++j) x[q][j] = (live[q] && srcs[q]) ? *(const float4*)(srcs[q] + 4 * lane + 256 * j) : make_float4(0.f, 0.f, 0.f, 0.f);
#pragma unroll
        for (int q = 0; q < 2; ++q) {
#pragma unroll
            for (int j = 0; j < 4; ++j) ss[q] += x[q][j].x * x[q][j].x + x[q][j].y * x[q][j].y + x[q][j].z * x[q][j].z + x[q][j].w * x[q][j].w;
            ss[q] = wave_sum_fast(ss[q]); }
#pragma unroll
        for (int q = 0; q < 2; ++q) { if (!live[q]) continue;
            const float rs = rsqrtf(ss[q] * (1.f / DM) + NORM_EPS);
#pragma unroll
            for (int j = 0; j < 4; ++j) { const float4 gg = *(const float4*)(gs[q] + 4 * lane + 256 * j);
                uint2 w; w.x = pack2(x[q][j].x * rs * gg.x, x[q][j].y * rs * gg.y); w.y = pack2(x[q][j].z * rs * gg.z, x[q][j].w * rs * gg.w);
                *(uint2*)(dsts[q] + 4 * lane + 256 * j) = w; } }
    }
    for (int i = blockIdx.x * 512 + tid; i < 128 * DM / 4; i += gridDim.x * 512) *(uint2*)(Bt1 + (size_t)DIN * DM + (size_t)i * 4) = make_uint2(0u, 0u);
    {
        float* tl = lds + wave * (64 * 65);
        for (int task = gw; task < 1312; task += nw) {
            const float* src; int ld; bf16_t* dst; int k0;
            if (task < 928) { const int kt = task / 58, nt = task % 58; src = P.w_in + (size_t)kt * 64 * DIN + nt * 64; ld = DIN; dst = Bt1 + (size_t)(nt * 64) * DM; k0 = kt * 64; }
            else if (task < 992) { const int e = task - 928, kt = e / 4, nt = e % 4; src = P.w_mem_k + (size_t)kt * 64 * XW + nt * 64; ld = XW; dst = Bt1 + (size_t)(3840 + nt * 64) * DM; k0 = kt * 64; }
            else if (task < 1056) { const int e = task - 992, kt = e / 4, nt = e % 4; src = P.w_mem_v + (size_t)kt * 64 * XW + nt * 64; ld = XW; dst = Bt1 + (size_t)(4096 + nt * 64) * DM; k0 = kt * 64; }
            else { const int e = task - 1056, kt = e / 16, nt = e % 16; src = P.w_out + (size_t)kt * 64 * DM + nt * 64; ld = DM; dst = Bt2 + (size_t)(nt * 64) * DM; k0 = kt * 64; }
            float v[64];
#pragma unroll
            for (int i = 0; i < 64; ++i) v[i] = src[(size_t)i * ld + lane];
#pragma unroll
            for (int i = 0; i < 64; ++i) tl[i * 65 + lane] = v[i];
            __builtin_amdgcn_wave_barrier();
#pragma unroll
            for (int q = 0; q < 8; ++q) { const int p = lane + 64 * q, jj = p >> 3, kc = p & 7;
                unsigned w[4];
#pragma unroll
                for (int t = 0; t < 4; ++t) w[t] = pack2(tl[(kc * 8 + 2 * t) * 65 + jj], tl[(kc * 8 + 2 * t + 1) * 65 + jj]);
                *(uint4*)(dst + (size_t)jj * DM + k0 + kc * 8) = make_uint4(w[0], w[1], w[2], w[3]); }
            __builtin_amdgcn_wave_barrier();
        }
    }
    for (int idx = blockIdx.x * 512 + tid; idx < 2 * 6 * 4 * 2 * 64; idx += gridDim.x * 512) {
        const int l = idx & 63, s = (idx >> 6) & 1, nt = (idx >> 7) & 3, w = (idx >> 9) % 6, mt = idx / (512 * 6);
        const float* W = mt ? P.a_lora_b : P.w_lora_b; float x[8];
#pragma unroll
        for (int j = 0; j < 8; ++j) x[j] = W[(size_t)(32 * s + 8 * (l >> 4) + j) * RW + 64 * w + 16 * nt + (l & 15)];
        prep_bf16x8 hi, lo; split8(x, hi, lo);
        prep_bf16x8* LF = (prep_bf16x8*)(P.ws + WS_LFRAG);
        LF[idx] = hi; LF[2 * 6 * 4 * 2 * 64 + idx] = lo;
    }
    __syncthreads();
}

__device__ __forceinline__ void prep_produce(const Params& P, const bf16_t* __restrict__ prw, int ch, float* buf, int j, float mux) {
    constexpr int CT = 8;
    const int tok0 = ch * CT;
    float pv = 0.f;
    if (tok0 < NTOK && (tok0 & (SEQ - 1))) pv = bf2f(prw[(size_t)(tok0 - 1) * RCOLS + 1152 + j]);
    float cur[CT];
#pragma unroll
    for (int tk = 0; tk < CT; ++tk) cur[tk] = bf2f(prw[(size_t)(tok0 + tk) * RCOLS + 1152 + j]);
#pragma unroll
    for (int tk = 0; tk < CT; ++tk) {
        const int tok = tok0 + tk;
        if (tok >= NTOK) pv = P.state_shift[(size_t)(tok - NTOK) * RCOLS + 1152 + j];
        float x = cur[tk] + (pv - cur[tk]) * mux;
        if (j < 64) x = tanhf(x);
        buf[tk * 128 + j] = x;
        pv = cur[tk];
    }
}
__device__ __forceinline__ void p2_rwkv_prep(const Params& P, float* lds) {
    const int tid = threadIdx.x, lane = tid & 63, wave = tid >> 6;
    const bf16_t* prw = (const bf16_t*)(P.ws + WS_PRW);
    float* RSB = (float*)(P.ws + WS_RSB);
    constexpr int CT = 8, NCHK = NTK / CT;
    float* xbuf = lds;
    float* yt = lds + 2 * CT * 128 + wave * (2 * CT * 64);
    float* ot = lds + 2 * CT * 128 + 8 * (2 * CT * 64) + wave * 768;
    prep_bf16x8 wbh[2][4][2], wbl[2][4][2];
    float w0c = 0.f, a0c = 0.f, kkc = 0.f, kac = 0.f, rkc = 0.f, mur = 0.f, muk = 0.f, muv = 0.f, mux = 0.f;
    if (tid < RW) {
        const prep_bf16x8* LF = (const prep_bf16x8*)(P.ws + WS_LFRAG);
#pragma unroll
        for (int mt = 0; mt < 2; ++mt)
#pragma unroll
            for (int nt = 0; nt < 4; ++nt)
#pragma unroll
                for (int s = 0; s < 2; ++s) { const int fi = (((mt * 6 + wave) * 4 + nt) * 2 + s) * 64 + lane; wbh[mt][nt][s] = LF[fi]; wbl[mt][nt][s] = LF[2 * 6 * 4 * 2 * 64 + fi]; }
        w0c = P.w0[tid]; a0c = P.a0[tid]; kkc = P.k_k[tid]; kac = P.k_a[tid]; rkc = P.r_k[tid];
        mur = P.mu_shift[tid]; muk = P.mu_shift[RW + tid]; muv = P.mu_shift[2 * RW + tid];
    } else {
#pragma unroll
        for (int mt = 0; mt < 2; ++mt)
#pragma unroll
            for (int nt = 0; nt < 4; ++nt)
#pragma unroll
                for (int s = 0; s < 2; ++s)
#pragma unroll
                    for (int j = 0; j < 8; ++j) { wbh[mt][nt][s][j] = 0; wbl[mt][nt][s][j] = 0; }
        mux = P.mu_shift[1152 + (tid - RW)];
    }
    int ch = blockIdx.x;
    if (tid >= RW && ch < NCHK) prep_produce(P, prw, ch, xbuf, tid - RW, mux);
    for (int it = 0; ch < NCHK; ch += NPREP, ++it) {
        const int tok0 = ch * CT;
        float* bufc = xbuf + (it & 1) * (CT * 128); float* bufn = xbuf + ((it + 1) & 1) * (CT * 128);
        float nr[4], nk[4], nv[4], qr = 0.f, qk = 0.f, qv = 0.f;
        if (tid < RW) {
#pragma unroll
            for (int q = 0; q < 4; ++q) { const bf16_t* p = prw + (size_t)(tok0 + q) * RCOLS + tid; nr[q] = bf2f(p[0]); nk[q] = bf2f(p[RW]); nv[q] = bf2f(p[2 * RW]); }
            if (tok0 < NTOK && (tok0 & (SEQ - 1))) { const bf16_t* p = prw + (size_t)(tok0 - 1) * RCOLS + tid; qr = bf2f(p[0]); qk = bf2f(p[RW]); qv = bf2f(p[2 * RW]); }
        }
        asm volatile("s_waitcnt lgkmcnt(0)" ::: "memory");
        __builtin_amdgcn_s_barrier(); asm volatile("" ::: "memory");
        if (tid >= RW) { if (ch + NPREP < NCHK) prep_produce(P, prw, ch + NPREP, bufn, tid - RW, mux); }
        else {
            const int c = tid, h = tid >> 6, cc = c & 63;
            {
                prep_bf16x8 ah[2][2], al_[2][2];
#pragma unroll
                for (int mt = 0; mt < 2; ++mt)
#pragma unroll
                    for (int s = 0; s < 2; ++s) { float x[8];
                        const float* xp = bufc + (lane & 7) * 128 + mt * 64 + 32 * s + 8 * (lane >> 4);
                        const float4 x0 = *(const float4*)xp, x1 = *(const float4*)(xp + 4);
                        const bool real = (lane & 15) < CT;
                        x[0] = real ? x0.x : 0.f; x[1] = real ? x0.y : 0.f; x[2] = real ? x0.z : 0.f; x[3] = real ? x0.w : 0.f;
                        x[4] = real ? x1.x : 0.f; x[5] = real ? x1.y : 0.f; x[6] = real ? x1.z : 0.f; x[7] = real ? x1.w : 0.f;
                        split8(x, ah[mt][s], al_[mt][s]); }
#pragma unroll
                for (int mt = 0; mt < 2; ++mt)
#pragma unroll
                    for (int nt = 0; nt < 4; ++nt) { prep_f32x4 acc = {0.f, 0.f, 0.f, 0.f};
#pragma unroll
                        for (int s = 0; s < 2; ++s) {
                            acc = __builtin_amdgcn_mfma_f32_16x16x32_bf16(al_[mt][s], wbh[mt][nt][s], acc, 0, 0, 0);
                            acc = __builtin_amdgcn_mfma_f32_16x16x32_bf16(ah[mt][s], wbl[mt][nt][s], acc, 0, 0, 0);
                            acc = __builtin_amdgcn_mfma_f32_16x16x32_bf16(ah[mt][s], wbh[mt][nt][s], acc, 0, 0, 0); }
                        if ((lane >> 4) < 2) {
#pragma unroll
                            for (int r = 0; r < 4; ++r) yt[(mt * CT + 4 * (lane >> 4) + r) * 64 + 16 * nt + (lane & 15)] = acc[r]; } }
                asm volatile("s_waitcnt lgkmcnt(0)" ::: "memory");
                __builtin_amdgcn_wave_barrier();
            }
#pragma unroll
            for (int tg = 0; tg < CT; tg += 4) {
            float ekk[4], ew[4], ebb[4], ekm[4], ewr[4], ev[4], ebr[4], ekr[4], erk[4];
#pragma unroll
            for (int tk = tg; tk < tg + 4; ++tk) {
                const int tok = tok0 + tk;
                if (tok >= NTOK) { const float* p = P.state_shift + (size_t)(tok - NTOK) * RCOLS + tid; qr = p[0]; qk = p[RW]; qv = p[2 * RW]; }
                const float cr = nr[tk & 3], ck = nk[tk & 3], cv = nv[tk & 3];
                if (tk + 4 < CT) { const bf16_t* p = prw + (size_t)(tok + 4) * RCOLS + tid; nr[tk & 3] = bf2f(p[0]); nk[tk & 3] = bf2f(p[RW]); nv[tk & 3] = bf2f(p[2 * RW]); }
                const float r = cr + (qr - cr) * mur, kraw = ck + (qk - ck) * muk, v = cv + (qv - cv) * muv;
                qr = cr; qk = ck; qv = cv;
                const float aw = w0c + yt[tk * 64 + cc], aa = a0c + yt[(CT + tk) * 64 + cc];
                const float w = __expf(-DECAY_SCALE * sigmoidf_(aw)), a = sigmoidf_(aa);
                const float kkv = kraw * kkc;
                const float n2 = wave_sum_fast(kkv * kkv);
                const float kk = kkv * rsqrtf(fmaxf(n2, 1e-12f));
                const float kmod = kraw * (1.f + (a - 1.f) * kac);
                const float bb = kk * a;
                const float br = wave_sum_fast(bb * r);
                ekk[tk - tg] = kk; ew[tk - tg] = w; ebb[tk - tg] = bb; ekm[tk - tg] = kmod; ewr[tk - tg] = w * r - kk * br; ev[tk - tg] = v;
                ebr[tk - tg] = br; ekr[tk - tg] = wave_sum_fast(kmod * r); erk[tk - tg] = wave_sum_fast(r * kmod * rkc);
            }
#pragma unroll
            for (int tk = tg; tk < tg + 4; ++tk) {
                float* blk = RSB + ((size_t)(tok0 + tk) * RH + h) * RSB_BLK;
                float* oq = ot + (tk & 1) * 384;
                oq[cc] = ekk[tk - tg]; oq[64 + cc] = ew[tk - tg]; oq[128 + cc] = ebb[tk - tg]; oq[192 + cc] = ekm[tk - tg]; oq[256 + cc] = ewr[tk - tg]; oq[320 + cc] = ev[tk - tg];
                __builtin_amdgcn_wave_barrier();
                *(float4*)(blk + 4 * lane) = *(const float4*)(oq + 4 * lane);
                if (lane < 32) *(float4*)(blk + 256 + 4 * lane) = *(const float4*)(oq + 256 + 4 * lane);
                if (lane == 0) *(float4*)(blk + 384) = make_float4(ebr[tk - tg], ekr[tk - tg], erk[tk - tg], 0.f);
                __builtin_amdgcn_wave_barrier();
            }
            }
            __builtin_amdgcn_wave_barrier();
        }
    }
    __syncthreads();
}

__device__ __forceinline__ void p2_xattn_sample(const Params& P, float* lds) {
    const int tid = threadIdx.x, lane = tid & 63, wave = tid >> 6;
    const bf16_t* xq = (const bf16_t*)(P.ws + WS_XQ); const bf16_t* gate = (const bf16_t*)(P.ws + WS_GATE); bf16_t* O = (bf16_t*)(P.ws + WS_O);
    float* zl = lds + wave * 64; float* part = lds + 512;
    const int c = lane & 15, g = lane >> 4;
    for (int task = (int)blockIdx.x - 128; task >= 0 && task < DB * XH; task += 128) {
        const int b = task >> 2, h = task & 3; const size_t row = NTOK + b;
        const bf16_t* qp = xq + row * XW + h * 64 + 4 * c;
        const float q0 = bf2f(qp[0]), q1 = bf2f(qp[1]), q2 = bf2f(qp[2]), q3 = bf2f(qp[3]);
        const float* Kp = P.cmem_k + (((size_t)b * NMEM + wave * 32) * XH + h) * HD + 4 * c; const float* Vp = P.cmem_v + (((size_t)b * NMEM + wave * 32) * XH + h) * HD + 4 * c;
        __syncthreads();
        float4 k4[8], v4[8];
#pragma unroll
        for (int i = 0; i < 8; ++i) { k4[i] = *(const float4*)(Kp + (size_t)(4 * i + g) * (XH * HD)); v4[i] = *(const float4*)(Vp + (size_t)(4 * i + g) * (XH * HD)); }
#pragma unroll
        for (int i = 0; i < 8; ++i) { float p = q0 * k4[i].x + q1 * k4[i].y + q2 * k4[i].z + q3 * k4[i].w; p = sum16(p); if (c == 0) zl[4 * i + g] = p; }
        asm volatile("s_waitcnt lgkmcnt(0)" ::: "memory");
        __builtin_amdgcn_wave_barrier();
        const float z = zl[lane & 31];
        const float mx = wave_max(z);
        const float p = (lane < 32) ? exp2f(z - mx) : 0.f;
        const float ls = wave_sum_fast(p);
        __builtin_amdgcn_wave_barrier();
        if (lane < 32) zl[lane] = p;
        asm volatile("s_waitcnt lgkmcnt(0)" ::: "memory");
        __builtin_amdgcn_wave_barrier();
        float4 o4 = make_float4(0.f, 0.f, 0.f, 0.f);
#pragma unroll
        for (int i = 0; i < 8; ++i) { const float w = zl[4 * i + g]; o4.x += w * v4[i].x; o4.y += w * v4[i].y; o4.z += w * v4[i].z; o4.w += w * v4[i].w; }
#pragma unroll
        for (int off = 16; off < 64; off <<= 1) { o4.x += __shfl_xor(o4.x, off); o4.y += __shfl_xor(o4.y, off); o4.z += __shfl_xor(o4.z, off); o4.w += __shfl_xor(o4.w, off); }
        if (g == 0) *(float4*)(part + wave * 68 + 4 * c) = o4;
        if (lane == 0) { part[wave * 68 + 64] = mx; part[wave * 68 + 65] = ls; }
        __syncthreads();
        if (wave == 0) {
            float M = part[64];
#pragma unroll
            for (int w = 1; w < 8; ++w) M = fmaxf(M, part[w * 68 + 64]);
            float L = 0.f, o = 0.f;
#pragma unroll
            for (int w = 0; w < 8; ++w) { const float sc = exp2f(part[w * 68 + 64] - M); L += part[w * 68 + 65] * sc; o += part[w * 68 + lane] * sc; }
            O[row * DM + 768 + h * 64 + lane] = f2bf(o / L * bf2f(gate[row * DM + 768 + h * 64 + lane]));
        }
    }
    __syncthreads();
}

constexpr int DEC_NTASK = DB * NPAGES * SH, DEC_LDS_OFF = 144384;
constexpr int QW_SB = 3584, QW_DEC = 3648;
constexpr int SC_CTL_OFF_FWD = 5 * 28672;
template <int NB>
__device__ __forceinline__ void sb_decode_task(const Params& P, float* lds, int task) {
    const int tid = threadIdx.x, lane = tid & 63, wave = tid >> 6;
    const bf16_t* qb = (const bf16_t*)(P.ws + WS_QB);
    float* dpart = (float*)(P.ws + WS_DPART); float* dl = (float*)(P.ws + WS_DL);
    float* zl = lds + DEC_LDS_OFF / 4 + wave * 256; float* wl = zl + 128;
    const int c = lane & 15, g = lane >> 4;
    constexpr int NBT = 32 / NB;
    const int h = task % SH, bj = task / SH, b = bj / NPAGES;
    const int page = P.page_table[bj];
    const float* Kp = P.cache_k + ((size_t)page * PAGE * SH + h) * HD + 4 * c;
    const float* Vp = P.cache_v + ((size_t)page * PAGE * SH + h) * HD + 4 * c;
    const bf16_t* qp = qb + (size_t)(NTOK + b) * SBW + h * 64 + 4 * c;
    const float q0 = bf2f(qp[0]), q1 = bf2f(qp[1]), q2 = bf2f(qp[2]), q3 = bf2f(qp[3]);
    const float bias = P.sb_bias[h] * LOG2E;
    float4 cur[NB], nx[NB];
#pragma unroll
    for (int i = 0; i < NB; ++i) cur[i] = *(const float4*)(Kp + (size_t)(4 * i + g) * (SH * HD));
#pragma unroll
    for (int kb = 0; kb < NBT; ++kb) {
        const float* np = (kb + 1 < NBT) ? Kp + (size_t)(4 * NB * (kb + 1)) * (SH * HD) : Vp;
#pragma unroll
        for (int i = 0; i < NB; ++i) nx[i] = *(const float4*)(np + (size_t)(4 * i + g) * (SH * HD));
#pragma unroll
        for (int i = 0; i < NB; ++i) { const int s = 4 * NB * kb + 4 * i + g;
            float part = q0 * cur[i].x + q1 * cur[i].y + q2 * cur[i].z + q3 * cur[i].w; part = sum16(part);
            if (c == 0) zl[s] = part + bias; }
#pragma unroll
        for (int i = 0; i < NB; ++i) cur[i] = nx[i];
    }
    asm volatile("s_waitcnt lgkmcnt(0)" ::: "memory");
    __builtin_amdgcn_wave_barrier();
    const float z0 = zl[2 * lane], z1 = zl[2 * lane + 1];
    const float sp0 = softplus2_(z0), sp1 = softplus2_(z1);
    float incl = sp0 + sp1;
#pragma unroll
    for (int off = 1; off < 64; off <<= 1) { const float t = __shfl_down(incl, off); if (lane + off < 64) incl += t; }
    const float excl = incl - (sp0 + sp1);
    wl[2 * lane] = exp2f(z0 - sp0 - (excl + sp1));
    wl[2 * lane + 1] = exp2f(z1 - sp1 - excl);
    const float Ltot = __shfl(incl, 0);
    asm volatile("s_waitcnt lgkmcnt(0)" ::: "memory");
    __builtin_amdgcn_wave_barrier();
    float4 o4 = make_float4(0.f, 0.f, 0.f, 0.f);
#pragma unroll
    for (int vb = 0; vb < NBT; ++vb) {
        if (vb + 1 < NBT) {
#pragma unroll
            for (int i = 0; i < NB; ++i) nx[i] = *(const float4*)(Vp + (size_t)(4 * NB * (vb + 1) + 4 * i + g) * (SH * HD)); }
#pragma unroll
        for (int i = 0; i < NB; ++i) { const float w = wl[4 * NB * vb + 4 * i + g]; o4.x += w * cur[i].x; o4.y += w * cur[i].y; o4.z += w * cur[i].z; o4.w += w * cur[i].w; }
#pragma unroll
        for (int i = 0; i < NB; ++i) cur[i] = nx[i];
    }
#pragma unroll
    for (int off = 16; off < 64; off <<= 1) { o4.x += __shfl_xor(o4.x, off); o4.y += __shfl_xor(o4.y, off); o4.z += __shfl_xor(o4.z, off); o4.w += __shfl_xor(o4.w, off); }
    if (g == 0) *(float4*)(dpart + (size_t)task * HD + 4 * c) = o4;
    if (lane == 0) dl[task] = Ltot;
    __builtin_amdgcn_wave_barrier();
}
#ifndef SC_THIN
#define SC_THIN 1
#endif
__device__ __forceinline__ void sb_decode_wave_loop(const Params& P, float* lds) {
    unsigned* qd = (unsigned*)(P.ws + WS_BAR) + QW_DEC;
    const int lane = threadIdx.x & 63;
    volatile LAS unsigned* scw = (volatile LAS unsigned*)((LAS unsigned char*)lds + SC_CTL_OFF_FWD);
    unsigned nxt = 0u;
    if (lane == 0) nxt = atomicAdd(qd, 2u);
    for (;;) {
        const int t = __builtin_amdgcn_readfirstlane((int)nxt);
        if (t >= DEC_NTASK) break;
        if (lane == 0) nxt = atomicAdd(qd, 2u);
        bool thin = false;
        bool scan_running = false;
        if (SC_THIN && blockIdx.x < 96) { constexpr unsigned NCHU = SEQ / 16; scan_running = scw[1] < NCHU || scw[2] < NCHU || scw[3] < NCHU || scw[4] < NCHU; thin = scan_running; }
        thin = true;
        if (blockIdx.x < 96 && scan_running) { sb_decode_task<4>(P, lds, t); sb_decode_task<4>(P, lds, t + 1); }
        else if (thin) { sb_decode_task<8>(P, lds, t); sb_decode_task<8>(P, lds, t + 1); }
        else { sb_decode_task<16>(P, lds, t); sb_decode_task<16>(P, lds, t + 1); }
    }
}

struct StepIn { float4 kk, w, b, k, wr; float v; float2 sc; };
__device__ __forceinline__ void load_step(StepIn& s, const float* __restrict__ p, int c0, int rl) {
    s.kk = *(const float4*)(p + c0); s.w = *(const float4*)(p + 64 + c0); s.b = *(const float4*)(p + 128 + c0); s.k = *(const float4*)(p + 192 + c0); s.wr = *(const float4*)(p + 256 + c0);
    s.v = p[320 + rl]; s.sc = *(const float2*)(p + 384);
}
__device__ __forceinline__ void scan_step(float4& S, const StepIn& s, float* __restrict__ op) {
    float d1 = S.x * s.kk.x + S.y * s.kk.y + S.z * s.kk.z + S.w * s.kk.w;
    float d2 = S.x * s.wr.x + S.y * s.wr.y + S.z * s.wr.z + S.w * s.wr.w;
    d1 = sum16(d1); d2 = sum16(d2);
    S.x = S.x * s.w.x - d1 * s.b.x + s.v * s.k.x; S.y = S.y * s.w.y - d1 * s.b.y + s.v * s.k.y; S.z = S.z * s.w.z - d1 * s.b.z + s.v * s.k.z; S.w = S.w * s.w.w - d1 * s.b.w + s.v * s.k.w;
    *op = d2 + s.v * s.sc.y;
}
__device__ __forceinline__ float scan_step_asm(float4& S, const StepIn& s) {
    float o, d1, d2, t;
    asm volatile(
        "v_mul_f32 %5, %0, %8\n\t"  "v_mul_f32 %6, %0, %12\n\t"
        "v_fmac_f32 %5, %1, %9\n\t" "v_fmac_f32 %6, %1, %13\n\t"
        "v_fmac_f32 %5, %2, %10\n\t" "v_fmac_f32 %6, %2, %14\n\t"
        "v_fmac_f32 %5, %3, %11\n\t" "v_fmac_f32 %6, %3, %15\n\t"
        "v_mul_f32 %0, %0, %16\n\t" "v_mul_f32 %1, %1, %17\n\t"
        "v_add_f32_dpp %5, %5, %5 quad_perm:[1,0,3,2] row_mask:0xf bank_mask:0xf\n\t"
        "v_add_f32_dpp %6, %6, %6 quad_perm:[1,0,3,2] row_mask:0xf bank_mask:0xf\n\t"
        "v_mul_f32 %2, %2, %18\n\t" "v_mul_f32 %3, %3, %19\n\t"
        "v_add_f32_dpp %5, %5, %5 quad_perm:[2,3,0,1] row_mask:0xf bank_mask:0xf\n\t"
        "v_add_f32_dpp %6, %6, %6 quad_perm:[2,3,0,1] row_mask:0xf bank_mask:0xf\n\t"
        "v_fmac_f32 %0, %28, %20\n\t" "v_fmac_f32 %1, %28, %21\n\t"
        "v_add_f32_dpp %5, %5, %5 row_ror:4 row_mask:0xf bank_mask:0xf\n\t"
        "v_add_f32_dpp %6, %6, %6 row_ror:4 row_mask:0xf bank_mask:0xf\n\t"
        "v_fmac_f32 %2, %28, %22\n\t" "v_fmac_f32 %3, %28, %23\n\t"
        "v_add_f32_dpp %5, %5, %5 row_ror:8 row_mask:0xf bank_mask:0xf\n\t"
        "v_add_f32_dpp %6, %6, %6 row_ror:8 row_mask:0xf bank_mask:0xf\n\t"
        "v_fma_f32 %4, %28, %30, %6\n\t"
        "v_fma_f32 %0, -%5, %24, %0\n\t" "v_fma_f32 %1, -%5, %25, %1\n\t" "v_fma_f32 %2, -%5, %26, %2\n\t" "v_fma_f32 %3, -%5, %27, %3\n\t"
        "s_nop 0"
        : "+v"(S.x), "+v"(S.y), "+v"(S.z), "+v"(S.w), "=&v"(o), "=&v"(d1), "=&v"(d2), "=&v"(t)
        : "v"(s.kk.x), "v"(s.kk.y), "v"(s.kk.z), "v"(s.kk.w), "v"(s.wr.x), "v"(s.wr.y), "v"(s.wr.z), "v"(s.wr.w),
          "v"(s.w.x), "v"(s.w.y), "v"(s.w.z), "v"(s.w.w), "v"(s.k.x), "v"(s.k.y), "v"(s.k.z), "v"(s.k.w),
          "v"(s.b.x), "v"(s.b.y), "v"(s.b.z), "v"(s.b.w), "v"(s.v), "v"(s.sc.x), "v"(s.sc.y));
    return o;
}
__device__ __forceinline__ void scan_rows(const Params& P, int tok0, int T, int h, int row0, const float* S0, float* Sout, int lane) {
    const int rl = row0 + (lane >> 4), c0 = (lane & 15) * 4;
    const float* p = (const float*)(P.ws + WS_RSB) + ((size_t)tok0 * RH + h) * RSB_BLK;
    float* op = (float*)(P.ws + WS_ORAW) + (size_t)tok0 * RW + h * 64 + rl;
    constexpr int PST = RH * RSB_BLK;
    float4 S = S0 ? *(const float4*)(S0 + rl * 64 + c0) : make_float4(0.f, 0.f, 0.f, 0.f);
    if (T >= 16) {
        StepIn ring[8];
#pragma unroll
        for (int j = 0; j < 8; ++j) load_step(ring[j], p + (size_t)j * PST, c0, rl);
        for (int t0 = 0; t0 < T - 8; t0 += 8) {
#pragma unroll
            for (int j = 0; j < 8; ++j) { scan_step(S, ring[j], op + (size_t)j * RW); load_step(ring[j], p + (size_t)(8 + j) * PST, c0, rl); }
            p += 8 * PST; op += 8 * RW;
        }
#pragma unroll
        for (int j = 0; j < 8; ++j) scan_step(S, ring[j], op + (size_t)j * RW);
    } else {
        for (int t = 0; t < T; ++t) { StepIn s; load_step(s, p + (size_t)t * PST, c0, rl); scan_step(S, s, op + (size_t)t * RW); }
    }
    *(float4*)(Sout + rl * 64 + c0) = S;
}

constexpr int SCH = 16, SC_NPIECE = SCH * 97, SC_NP64 = (SC_NPIECE + 63) / 64, SC_BUF = 28672, SC_NB = 5;
__device__ __forceinline__ void lds_load_step(StepIn& s, const float* p, int c0, int rl) {
    s.kk = *(const float4*)(p + c0); s.w = *(const float4*)(p + 64 + c0); s.b = *(const float4*)(p + 128 + c0); s.k = *(const float4*)(p + 192 + c0); s.wr = *(const float4*)(p + 256 + c0);
    s.v = p[320 + rl]; s.sc = *(const float2*)(p + 384);
}
#ifndef SC_FREE_WAVES
#define SC_FREE_WAVES 2
#endif
constexpr int SC_CTL_OFF = SC_NB * 28672; static_assert(SC_CTL_OFF == SC_CTL_OFF_FWD, "scan control words");
__device__ __forceinline__ void scan_prompt_wave(const Params& P, unsigned char* lds, int b, int h, int quarter) {
    const int tid = threadIdx.x, lane = tid & 63; const int wave = __builtin_amdgcn_readfirstlane(tid >> 6);
    constexpr int PST = RH * RSB_BLK, NCH = SEQ / SCH;
    volatile LAS unsigned* scw = (volatile LAS unsigned*)((LAS unsigned char*)lds + SC_CTL_OFF);
    if (wave == 4) {
        const float* g0 = (const float*)(P.ws + WS_RSB) + ((size_t)(b * SEQ) * RH + h) * RSB_BLK;
        LAS unsigned char* l3 = (LAS unsigned char*)lds;
        int soff[SC_NP64];
#pragma unroll
        for (int j = 0; j < SC_NP64; ++j) { const int i = j * 64 + lane; const int ii = i < SC_NPIECE ? i : SC_NPIECE - 1; soff[j] = (ii / 97) * PST + (ii % 97) * 4; }
        for (int c = 0; c < NCH; ++c) {
            if (c >= SC_NB) {
                for (;;) { const unsigned d0 = scw[1], d1 = scw[2], d2 = scw[3], d3 = scw[4]; const unsigned m01 = d0 < d1 ? d0 : d1, m23 = d2 < d3 ? d2 : d3;
                    if ((m01 < m23 ? m01 : m23) >= (unsigned)(c - SC_NB + 1)) break; __builtin_amdgcn_s_sleep(1); }
            }
            const float* g_ = g0 + (size_t)c * SCH * PST;
#pragma unroll
            for (int j = 0; j < SC_NP64; ++j) {
                if (j * 64 + lane < SC_NPIECE) __builtin_amdgcn_global_load_lds((const unsigned*)(g_ + soff[j]), (LAS unsigned*)(l3 + (c % SC_NB) * SC_BUF + j * 1024), 16, 0, 0);
            }
            if (c >= 1) { asm volatile("s_waitcnt vmcnt(25)" ::: "memory"); if (lane == 0) scw[0] = (unsigned)c; }
        }
        asm volatile("s_waitcnt vmcnt(0)" ::: "memory");
        if (lane == 0) scw[0] = (unsigned)NCH;
    } else if (wave < 4) {
        const int rl = quarter * 16 + wave * 4 + (lane >> 4), cl = lane & 15, c0 = cl * 4;
        float* op = (float*)(P.ws + WS_ORAW) + (size_t)(b * SEQ) * RW + h * 64 + rl;
        float4 S = make_float4(0.f, 0.f, 0.f, 0.f);
        while (scw[0] < 1u) __builtin_amdgcn_s_sleep(1);
        asm volatile("" ::: "memory");
        StepIn r[4];
        lds_load_step(r[0], (const float*)lds, c0, rl); lds_load_step(r[1], (const float*)lds + RSB_BLK, c0, rl); lds_load_step(r[2], (const float*)lds + 2 * RSB_BLK, c0, rl);
        for (int c = 0; c < NCH; ++c) {
            const float* bp = (const float*)(lds + (c % SC_NB) * SC_BUF); const float* bpn = (const float*)(lds + ((c + 1) % SC_NB) * SC_BUF);
            float ov = 0.f;
#pragma unroll
            for (int s = 0; s < SCH; ++s) {
                if (s == SCH - 3 && c + 1 < NCH) { while (scw[0] < (unsigned)(c + 2)) __builtin_amdgcn_s_sleep(1); asm volatile("" ::: "memory"); }
                lds_load_step(r[(s + 3) & 3], (s + 3 < SCH) ? bp + (s + 3) * RSB_BLK : bpn + (s + 3 - SCH) * RSB_BLK, c0, rl); __builtin_amdgcn_sched_barrier(0);
                const float o = scan_step_asm(S, r[s & 3]); __builtin_amdgcn_sched_barrier(0);
                ov = (cl == s) ? o : ov;
            }
            op[(size_t)cl * RW] = ov;
            op += (size_t)SCH * RW;
            if (lane == 0) scw[1 + wave] = (unsigned)(c + 1);
        }
        *(float4*)(P.out + OUT_WKV_P + ((size_t)(b * RH + h) * HD + rl) * HD + c0) = S;
    }
}

namespace sba {
typedef short bf16x8 __attribute__((ext_vector_type(8)));
typedef short s16x4 __attribute__((ext_vector_type(4)));
typedef float f32x16 __attribute__((ext_vector_type(16)));
typedef unsigned u32x4 __attribute__((ext_vector_type(4)));
typedef __attribute__((address_space(3))) const unsigned char* lds_cptr;
constexpr int SLOT = 16384;
#define SBA_MFMA(a, b, c) __builtin_amdgcn_mfma_f32_32x32x16_bf16(a, b, c, 0, 0, 0)
__device__ __forceinline__ unsigned cvtpk(float lo, float hi) { return pack2(lo, hi); }
__device__ __forceinline__ bf16x8 pack8(const f32x16& x, int base) {
    u32x4 w; w[0] = cvtpk(x[base], x[base + 1]); w[1] = cvtpk(x[base + 2], x[base + 3]); w[2] = cvtpk(x[base + 4], x[base + 5]); w[3] = cvtpk(x[base + 6], x[base + 7]);
    return __builtin_bit_cast(bf16x8, w);
}
__device__ __forceinline__ int crow(int r, int hi) { return (r & 3) + 8 * (r >> 2) + 4 * hi; }
__device__ __forceinline__ bf16x8 vfrag(lds_cptr p) {
    const s16x4 a = __builtin_bit_cast(s16x4, __builtin_amdgcn_ds_read_tr16_b64_v4i16((__attribute__((address_space(3))) s16x4*)p));
    const s16x4 b = __builtin_bit_cast(s16x4, __builtin_amdgcn_ds_read_tr16_b64_v4i16((__attribute__((address_space(3))) s16x4*)(p + 8 * 64)));
    bf16x8 r; r[0] = a[0]; r[1] = a[1]; r[2] = a[2]; r[3] = a[3]; r[4] = b[0]; r[5] = b[1]; r[6] = b[2]; r[7] = b[3]; return r;
}

template <bool MASK>
__device__ __forceinline__ void tile(lds_cptr kp0, lds_cptr vp0, const bf16x8 (&qr)[4], const f32x16& biasv, const bf16x8& ut0, const bf16x8& ut1, const bf16x8& uon,
                                     f32x16& o0, f32x16& o1, float& R, int kbase, int trel, int hi) {
    f32x16 p0 = biasv, p1 = biasv;
#pragma unroll
    for (int d0 = 0; d0 < 4; ++d0) {
        const bf16x8 ka = *(const __attribute__((address_space(3))) bf16x8*)(kp0 + d0 * 2048);
        const bf16x8 kb = *(const __attribute__((address_space(3))) bf16x8*)(kp0 + d0 * 2048 + 512);
        p0 = SBA_MFMA(ka, qr[d0], p0); p1 = SBA_MFMA(kb, qr[d0], p1);
    }
    f32x16 s0, s1;
#pragma unroll
    for (int r = 0; r < 16; ++r) {
        s0[r] = __builtin_amdgcn_logf(1.f + __builtin_amdgcn_exp2f(p0[r]));
        s1[r] = __builtin_amdgcn_logf(1.f + __builtin_amdgcn_exp2f(p1[r]));
        if (MASK) { const int k0 = kbase + crow(r, hi); if (k0 >= trel) s0[r] = 0.f; if (k0 + 32 >= trel) s1[r] = 0.f; }
    }
    const bf16x8 b00 = pack8(s0, 0), b01 = pack8(s0, 8), b10 = pack8(s1, 0), b11 = pack8(s1, 8);
    f32x16 c0, c1;
#pragma unroll
    for (int r = 0; r < 16; ++r) { c0[r] = p0[r] - R; c1[r] = p1[r] - R; }
    const float top = c0[0];
    c0 = SBA_MFMA(ut0, b00, c0); c0 = SBA_MFMA(ut1, b01, c0); c0 = SBA_MFMA(uon, b10, c0); c0 = SBA_MFMA(uon, b11, c0);
    c1 = SBA_MFMA(ut0, b10, c1); c1 = SBA_MFMA(ut1, b11, c1);
    const float tot_l = top - c0[0];
    const auto sw = __builtin_amdgcn_permlane32_swap(__float_as_uint(tot_l), __float_as_uint(tot_l), false, false);
    const float tot = __uint_as_float(sw[0]);
#pragma unroll
    for (int r = 0; r < 16; ++r) {
        c0[r] = __builtin_amdgcn_exp2f(c0[r]); c1[r] = __builtin_amdgcn_exp2f(c1[r]);
        if (MASK) { const int k0 = kbase + crow(r, hi); if (k0 >= trel) c0[r] = 0.f; if (k0 + 32 >= trel) c1[r] = 0.f; }
    }
    const bf16x8 a00 = pack8(c0, 0), a01 = pack8(c0, 8), a10 = pack8(c1, 0), a11 = pack8(c1, 8);
    o0 = SBA_MFMA(vfrag(vp0 + 0 * 1024), a00, o0); o1 = SBA_MFMA(vfrag(vp0 + 4096 + 0 * 1024), a00, o1);
    o0 = SBA_MFMA(vfrag(vp0 + 1 * 1024), a01, o0); o1 = SBA_MFMA(vfrag(vp0 + 4096 + 1 * 1024), a01, o1);
    o0 = SBA_MFMA(vfrag(vp0 + 2 * 1024), a10, o0); o1 = SBA_MFMA(vfrag(vp0 + 4096 + 2 * 1024), a10, o1);
    o0 = SBA_MFMA(vfrag(vp0 + 3 * 1024), a11, o0); o1 = SBA_MFMA(vfrag(vp0 + 4096 + 3 * 1024), a11, o1);
    R += tot;
}

__device__ __forceinline__ void unit(const Params& P, unsigned char* lds, int b, int h, int qb) {
    const int tid = threadIdx.x, lane = tid & 63, r32 = lane & 31, hi = lane >> 5; const int wid = __builtin_amdgcn_readfirstlane(tid >> 6);
    const bf16_t* Q = (const bf16_t*)(P.ws + WS_QB); const bf16_t* K = (const bf16_t*)(P.ws + WS_KB); const bf16_t* V = (const bf16_t*)(P.ws + WS_VB);
    const bf16_t* gate = (const bf16_t*)(P.ws + WS_GATE); bf16_t* O = (bf16_t*)(P.ws + WS_O);
    const size_t rowbase = (size_t)b * SEQ; const int q0 = qb * 256, NT = (q0 + 256) / 64;
    const int trel = wid * 32 + r32;
    const size_t qrow = rowbase + q0 + trel;
    bf16x8 qr[4];
#pragma unroll
    for (int d0 = 0; d0 < 4; ++d0) qr[d0] = *(const bf16x8*)(Q + qrow * SBW + h * 64 + d0 * 16 + hi * 8);
    const bf16_t* ksrc = K + (rowbase + lane) * SBW + h * 64 + wid * 8;
    const bf16_t* vsrc = V + (rowbase + 16 * (wid & 3) + (lane >> 2)) * SBW + h * 64 + (wid >> 2) * 32 + (lane & 3) * 8;
    LAS unsigned char* l3 = (LAS unsigned char*)lds;
#define SBA_DMA(t, slot) do { __builtin_amdgcn_global_load_lds((const unsigned*)(ksrc + (size_t)(t) * 64 * SBW), (LAS unsigned*)(l3 + (slot) + wid * 1024), 16, 0, 0); \
        __builtin_amdgcn_global_load_lds((const unsigned*)(vsrc + (size_t)(t) * 64 * SBW), (LAS unsigned*)(l3 + (slot) + 8192 + wid * 1024), 16, 0, 0); } while (0)
    const int koff = hi * 1024 + r32 * 16;
    const int voff = 8192 + ((lane >> 4) & 1) * 32 + (lane & 3) * 8 + (4 * hi + ((lane & 15) >> 2)) * 64;
    bf16x8 ut0, ut1, uon;
#pragma unroll
    for (int jj = 0; jj < 8; ++jj) { const int kj = 8 * (jj >> 2) + 4 * hi + (jj & 3);
        ut0[jj] = (kj >= r32) ? (short)0xBF80 : (short)0; ut1[jj] = (16 + kj >= r32) ? (short)0xBF80 : (short)0; uon[jj] = (short)0xBF80; }
    f32x16 biasv; { const float b2 = P.sb_bias[h] * LOG2E;
#pragma unroll
        for (int r = 0; r < 16; ++r) biasv[r] = b2; }
    f32x16 o0, o1;
#pragma unroll
    for (int r = 0; r < 16; ++r) { o0[r] = 0.f; o1[r] = 0.f; }
    float R = 0.f;
    __syncthreads();
    SBA_DMA(NT - 1, ((NT - 1) & 1) * SLOT);
    asm volatile("s_waitcnt vmcnt(0)" ::: "memory");
    __syncthreads();
    for (int t = NT - 1; t >= 0; --t) {
        const int slot = (t & 1) * SLOT;
        if (t > 0) SBA_DMA(t - 1, slot ^ SLOT);
        const int jb = t - (NT - 4);
        const lds_cptr kp0 = (lds_cptr)l3 + slot + koff, vp0 = (lds_cptr)l3 + slot + voff;
        if (jb < 0) tile<false>(kp0, vp0, qr, biasv, ut0, ut1, uon, o0, o1, R, 0, 0, hi);
        else if (64 * jb < wid * 32 + 31) {
            if (64 * jb + 63 >= wid * 32) tile<true>(kp0, vp0, qr, biasv, ut0, ut1, uon, o0, o1, R, 64 * jb, trel, hi);
            else tile<false>(kp0, vp0, qr, biasv, ut0, ut1, uon, o0, o1, R, 0, 0, hi);
        }
        asm volatile("s_waitcnt vmcnt(0)" ::: "memory");
        __syncthreads();
    }
#undef SBA_DMA
    const bf16_t* gr = gate + qrow * DM + 384 + h * 64; bf16_t* orow = O + qrow * DM + 384 + h * 64;
#pragma unroll
    for (int half = 0; half < 2; ++half)
#pragma unroll
        for (int g = 0; g < 4; ++g) { const int d = 32 * half + 8 * g + 4 * hi; const uint2 gt = *(const uint2*)(gr + d);
            const f32x16& o = half ? o1 : o0;
            uint2 w; w.x = cvtpk(o[4 * g] * __uint_as_float(gt.x << 16), o[4 * g + 1] * __uint_as_float(gt.x & 0xffff0000u));
            w.y = cvtpk(o[4 * g + 2] * __uint_as_float(gt.y << 16), o[4 * g + 3] * __uint_as_float(gt.y & 0xffff0000u));
            *(uint2*)(orow + d) = w; }
}
struct Grp4 { volatile LAS unsigned* ctr; unsigned gen; };
__device__ __forceinline__ void bar4(Grp4& G, int lane) {
    asm volatile("s_waitcnt lgkmcnt(0)" ::: "memory");
    G.gen += 4u;
    if (lane == 0) (void)__hip_atomic_fetch_add((LAS unsigned*)G.ctr, 1u, __ATOMIC_RELAXED, __HIP_MEMORY_SCOPE_WORKGROUP);
    unsigned spins = 0u;
    while (*G.ctr < G.gen) { __builtin_amdgcn_s_sleep(0); if (++spins > (1u << 22)) break; }
    asm volatile("" ::: "memory");
}
__device__ __forceinline__ void unit4(const Params& P, unsigned char* lds, int b, int h, int qb, int gw, Grp4& G) {
    const int lane = threadIdx.x & 63, r32 = lane & 31, hi = lane >> 5;
    const bf16_t* Q = (const bf16_t*)(P.ws + WS_QB); const bf16_t* K = (const bf16_t*)(P.ws + WS_KB); const bf16_t* V = (const bf16_t*)(P.ws + WS_VB);
    const bf16_t* gate = (const bf16_t*)(P.ws + WS_GATE); bf16_t* O = (bf16_t*)(P.ws + WS_O);
    const size_t rowbase = (size_t)b * SEQ; const int q0 = qb * 128, NT = (q0 + 128) / 64;
    const int trel = gw * 32 + r32;
    const size_t qrow = rowbase + q0 + trel;
    bf16x8 qr[4];
#pragma unroll
    for (int d0 = 0; d0 < 4; ++d0) qr[d0] = *(const bf16x8*)(Q + qrow * SBW + h * 64 + d0 * 16 + hi * 8);
    const bf16_t* ksrc0 = K + (rowbase + lane) * SBW + h * 64 + gw * 8;
    const bf16_t* vsrc0 = V + (rowbase + 16 * gw + (lane >> 2)) * SBW + h * 64 + (lane & 3) * 8;
    LAS unsigned char* l3 = (LAS unsigned char*)lds;
#define SBA_DMA4(t, slot) do { const size_t to_ = (size_t)(t) * 64 * SBW; \
        __builtin_amdgcn_global_load_lds((const unsigned*)(ksrc0 + to_), (LAS unsigned*)(l3 + (slot) + gw * 1024), 16, 0, 0); \
        __builtin_amdgcn_global_load_lds((const unsigned*)(ksrc0 + to_ + 32), (LAS unsigned*)(l3 + (slot) + (gw + 4) * 1024), 16, 0, 0); \
        __builtin_amdgcn_global_load_lds((const unsigned*)(vsrc0 + to_), (LAS unsigned*)(l3 + (slot) + 8192 + gw * 1024), 16, 0, 0); \
        __builtin_amdgcn_global_load_lds((const unsigned*)(vsrc0 + to_ + 32), (LAS unsigned*)(l3 + (slot) + 8192 + (gw + 4) * 1024), 16, 0, 0); } while (0)
    const int koff = hi * 1024 + r32 * 16;
    const int voff = 8192 + ((lane >> 4) & 1) * 32 + (lane & 3) * 8 + (4 * hi + ((lane & 15) >> 2)) * 64;
    bf16x8 ut0, ut1, uon;
#pragma unroll
    for (int jj = 0; jj < 8; ++jj) { const int kj = 8 * (jj >> 2) + 4 * hi + (jj & 3);
        ut0[jj] = (kj >= r32) ? (short)0xBF80 : (short)0; ut1[jj] = (16 + kj >= r32) ? (short)0xBF80 : (short)0; uon[jj] = (short)0xBF80; }
    f32x16 biasv; { const float b2 = P.sb_bias[h] * LOG2E;
#pragma unroll
        for (int r = 0; r < 16; ++r) biasv[r] = b2; }
    f32x16 o0, o1;
#pragma unroll
    for (int r = 0; r < 16; ++r) { o0[r] = 0.f; o1[r] = 0.f; }
    float R = 0.f;
    bar4(G, lane);
    SBA_DMA4(NT - 1, ((NT - 1) & 3) * SLOT);
    if (NT >= 2) SBA_DMA4(NT - 2, ((NT - 2) & 3) * SLOT);
    if (NT >= 3) SBA_DMA4(NT - 3, ((NT - 3) & 3) * SLOT);
    if (NT >= 3) asm volatile("s_waitcnt vmcnt(8)" ::: "memory"); else if (NT >= 2) asm volatile("s_waitcnt vmcnt(4)" ::: "memory"); else asm volatile("s_waitcnt vmcnt(0)" ::: "memory");
    bar4(G, lane);
    for (int t = NT - 1; t >= 0; --t) {
        const int slot = (t & 3) * SLOT;
        if (t >= 3) SBA_DMA4(t - 3, ((t - 3) & 3) * SLOT);
        const int jb = t - (NT - 2);
        const lds_cptr kp0 = (lds_cptr)l3 + slot + koff, vp0 = (lds_cptr)l3 + slot + voff;
        if (jb < 0) tile<false>(kp0, vp0, qr, biasv, ut0, ut1, uon, o0, o1, R, 0, 0, hi);
        else if (64 * jb < gw * 32 + 31) {
            if (64 * jb + 63 >= gw * 32) tile<true>(kp0, vp0, qr, biasv, ut0, ut1, uon, o0, o1, R, 64 * jb, trel, hi);
            else tile<false>(kp0, vp0, qr, biasv, ut0, ut1, uon, o0, o1, R, 0, 0, hi);
        }
        if (t >= 3) asm volatile("s_waitcnt vmcnt(8)" ::: "memory"); else if (t == 2) asm volatile("s_waitcnt vmcnt(4)" ::: "memory"); else asm volatile("s_waitcnt vmcnt(0)" ::: "memory");
        bar4(G, lane);
    }
#undef SBA_DMA4
    const bf16_t* gr = gate + qrow * DM + 384 + h * 64; bf16_t* orow = O + qrow * DM + 384 + h * 64;
#pragma unroll
    for (int half = 0; half < 2; ++half)
#pragma unroll
        for (int g = 0; g < 4; ++g) { const int d = 32 * half + 8 * g + 4 * hi; const uint2 gt = *(const uint2*)(gr + d);
            const f32x16& o = half ? o1 : o0;
            uint2 w; w.x = cvtpk(o[4 * g] * __uint_as_float(gt.x << 16), o[4 * g + 1] * __uint_as_float(gt.x & 0xffff0000u));
            w.y = cvtpk(o[4 * g + 2] * __uint_as_float(gt.y << 16), o[4 * g + 3] * __uint_as_float(gt.y & 0xffff0000u));
            *(uint2*)(orow + d) = w; }
}
}

__device__ __forceinline__ void p2_xattn_prompt(const Params& P, unsigned char* lds) {
    using namespace sba;
    const int tid = threadIdx.x, lane = tid & 63, r32 = lane & 31, hi = lane >> 5; const int wid = __builtin_amdgcn_readfirstlane(tid >> 6);
    const bf16_t* xq = (const bf16_t*)(P.ws + WS_XQ); const bf16_t* gate = (const bf16_t*)(P.ws + WS_GATE); bf16_t* O = (bf16_t*)(P.ws + WS_O);
    const float* MK = P.out + OUT_MK_P; const float* MV = P.out + OUT_MV_P;
    for (int task = blockIdx.x; task < NB * XH * 16; task += gridDim.x) {
        const int qblk = task & 15, h = (task >> 4) & 3, b = task >> 6;
        __syncthreads();
        for (int it = tid; it < 2048; it += 512) {
            const int key = it & 255, ch = it >> 8;
            const float* s = MK + ((size_t)(b * NMEM + key)) * XW + h * 64 + ch * 8;
            const float4 a = *(const float4*)s, c = *(const float4*)(s + 4);
            *(uint4*)(lds + (key >> 6) * 8192 + ch * 1024 + (key & 63) * 16) = make_uint4(pack2(a.x, a.y), pack2(a.z, a.w), pack2(c.x, c.y), pack2(c.z, c.w));
        }
        for (int it = tid; it < 2048; it += 512) {
            const int pl = it & 3, key = (it >> 2) & 255, ph = it >> 10;
            const float* s = MV + ((size_t)(b * NMEM + key)) * XW + h * 64 + ph * 32 + pl * 8;
            const float4 a = *(const float4*)s, c = *(const float4*)(s + 4);
            *(uint4*)(lds + 32768 + (key >> 6) * 8192 + ph * 4096 + (key & 63) * 64 + pl * 16) = make_uint4(pack2(a.x, a.y), pack2(a.z, a.w), pack2(c.x, c.y), pack2(c.z, c.w));
        }
        __syncthreads();
        const size_t row = (size_t)b * SEQ + qblk * 256 + wid * 32 + r32;
        bf16x8 qr[4];
#pragma unroll
        for (int d0 = 0; d0 < 4; ++d0) qr[d0] = *(const bf16x8*)(xq + row * XW + h * 64 + d0 * 16 + hi * 8);
        f32x16 p[8];
#pragma unroll
        for (int i = 0; i < 8; ++i)
#pragma unroll
            for (int r = 0; r < 16; ++r) p[i][r] = 0.f;
        const lds_cptr kp = (lds_cptr)(LAS unsigned char*)lds + hi * 1024 + r32 * 16;
#pragma unroll
        for (int tl = 0; tl < 4; ++tl)
#pragma unroll
            for (int d0 = 0; d0 < 4; ++d0) {
                const bf16x8 ka = *(const __attribute__((address_space(3))) bf16x8*)(kp + tl * 8192 + d0 * 2048);
                const bf16x8 kb = *(const __attribute__((address_space(3))) bf16x8*)(kp + tl * 8192 + d0 * 2048 + 512);
                p[2 * tl] = SBA_MFMA(ka, qr[d0], p[2 * tl]); p[2 * tl + 1] = SBA_MFMA(kb, qr[d0], p[2 * tl + 1]);
            }
        float m = p[0][0];
#pragma unroll
        for (int i = 0; i < 8; ++i)
#pragma unroll
            for (int r = 0; r < 16; ++r) m = fmaxf(m, p[i][r]);
        { const auto sw = __builtin_amdgcn_permlane32_swap(__float_as_uint(m), __float_as_uint(m), false, false); m = fmaxf(__uint_as_float(sw[0]), __uint_as_float(sw[1])); }
        float l = 0.f;
#pragma unroll
        for (int i = 0; i < 8; ++i)
#pragma unroll
            for (int r = 0; r < 16; ++r) { p[i][r] = __builtin_amdgcn_exp2f(p[i][r] - m); l += p[i][r]; }
        { const auto sw = __builtin_amdgcn_permlane32_swap(__float_as_uint(l), __float_as_uint(l), false, false); l = __uint_as_float(sw[0]) + __uint_as_float(sw[1]); }
        f32x16 o0, o1;
#pragma unroll
        for (int r = 0; r < 16; ++r) { o0[r] = 0.f; o1[r] = 0.f; }
        const lds_cptr vp = (lds_cptr)(LAS unsigned char*)lds + 32768 + ((lane >> 4) & 1) * 32 + (lane & 3) * 8 + (4 * hi + ((lane & 15) >> 2)) * 64;
#pragma unroll
        for (int tl = 0; tl < 4; ++tl)
#pragma unroll
            for (int X = 0; X < 4; ++X) {
                const bf16x8 a = pack8(p[2 * tl + (X >> 1)], (X & 1) * 8);
                o0 = SBA_MFMA(vfrag(vp + tl * 8192 + X * 1024), a, o0); o1 = SBA_MFMA(vfrag(vp + tl * 8192 + 4096 + X * 1024), a, o1);
            }
        const float inv = 1.f / l;
        const bf16_t* gr = gate + row * DM + 768 + h * 64; bf16_t* orow = O + row * DM + 768 + h * 64;
#pragma unroll
        for (int half = 0; half < 2; ++half)
#pragma unroll
            for (int g = 0; g < 4; ++g) { const int d = 32 * half + 8 * g + 4 * hi; const uint2 gt = *(const uint2*)(gr + d);
                const f32x16& o = half ? o1 : o0;
                uint2 w; w.x = pack2(o[4 * g] * inv * __uint_as_float(gt.x << 16), o[4 * g + 1] * inv * __uint_as_float(gt.x & 0xffff0000u));
                w.y = pack2(o[4 * g + 2] * inv * __uint_as_float(gt.y << 16), o[4 * g + 3] * inv * __uint_as_float(gt.y & 0xffff0000u));
                *(uint2*)(orow + d) = w; }
    }
    __syncthreads();
}

__device__ __forceinline__ void p3_scan_and_sb(const Params& P, float* lds) {
    const int tid = threadIdx.x, lane = tid & 63, wave = tid >> 6;
    unsigned* ctl = (unsigned*)(P.ws + WS_BAR);
    __syncthreads();
    if (blockIdx.x < 96) {
        const int bh = blockIdx.x >> 2, quarter = blockIdx.x & 3, b = bh / RH, h = bh % RH;
        volatile LAS unsigned* scw = (volatile LAS unsigned*)((LAS unsigned char*)lds + SC_CTL_OFF);
        if (tid < 5) scw[tid] = 0u;
        if (tid == 0) { XB_SPIN(xb_ld(ctl + QW_PREP_W) < (unsigned)NPREP, ctl); __builtin_amdgcn_fence(__ATOMIC_ACQUIRE, "agent"); asm volatile("s_waitcnt vmcnt(0)" ::: "memory"); }
        __syncthreads();
        scan_prompt_wave(P, (unsigned char*)lds, b, h, quarter);
        if (wave >= 5 + SC_FREE_WAVES) {
            constexpr unsigned NCHU = SEQ / SCH;
            while (scw[1] < NCHU || scw[2] < NCHU || scw[3] < NCHU || scw[4] < NCHU) __builtin_amdgcn_s_sleep(32);
        }
    } else {
        const int grp = wave >> 2, gw = wave & 3;
        volatile LAS unsigned* gctl = (volatile LAS unsigned*)((LAS unsigned char*)lds + LDS_CTL + 32);
        if (tid < 8) gctl[tid] = 0u;
        __syncthreads();
        sba::Grp4 G; G.ctr = gctl + grp; G.gen = 0u;
        if (grp == 1) sb_decode_wave_loop(P, lds);
        {
            volatile LAS unsigned* qw = gctl + 4 + grp;
            unsigned* qhead = (unsigned*)(P.ws + WS_BAR) + QW_SB;
            const bool popper = (gw == 0 && lane == 0);
            unsigned nxt = 0u;
            if (popper) nxt = atomicAdd(qhead, 1u);
            for (;;) {
                if (popper) qw[0] = nxt;
                sba::bar4(G, lane);
                const unsigned u = qw[0];
                sba::bar4(G, lane);
                if (u >= 768u) break;
                if (popper) nxt = atomicAdd(qhead, 1u);
                const int qb = 31 - (int)(u / 24u), bh = (int)(u % 24u);
                sba::unit4(P, (unsigned char*)lds + grp * 4 * sba::SLOT, bh / SH, bh % SH, qb, gw, G);
            }
        }
    }
    sb_decode_wave_loop(P, lds);
    if (lane == 0) XB_SPIN(xb_ld(ctl + QW_PREP_W) < (unsigned)NPREP, ctl);
    __builtin_amdgcn_fence(__ATOMIC_ACQUIRE, "agent");
    for (int task = blockIdx.x * 8 + wave; task < DB * RH * 16; task += gridDim.x * 8) {
        const int rg = task & 15, bh = task >> 4, b = bh / RH, h = bh % RH;
        scan_rows(P, NTOK + b, 1, h, rg * 4, P.state_wkv + (size_t)bh * HD * HD, P.out + OUT_WKV_S + (size_t)bh * HD * HD, lane);
    }
    __syncthreads();
}

__device__ __forceinline__ void p4_combine(const Params& P, float* lds) {
    const int tid = threadIdx.x, lane = tid & 63, wave = tid >> 6;
    const float* oraw = (const float*)(P.ws + WS_ORAW); const float* RSB = (const float*)(P.ws + WS_RSB);
    const bf16_t* gate = (const bf16_t*)(P.ws + WS_GATE); bf16_t* O = (bf16_t*)(P.ws + WS_O);
    for (int it = blockIdx.x * 512 + tid; it < NTK * RH * 16; it += gridDim.x * 512) {
        const int c = it & 15, th = it >> 4, h = th % RH, tok = th / RH;
        const size_t o = (size_t)tok * RW + h * 64 + 4 * c;
        const float4 v = *(const float4*)(oraw + o);
        const float mean = sum16(v.x + v.y + v.z + v.w) * (1.f / 64.f);
        const float dx = v.x - mean, dy = v.y - mean, dz = v.z - mean, dw = v.w - mean;
        const float var = sum16(dx * dx + dy * dy + dz * dz + dw * dw) * (1.f / 64.f);
        const float rs = rsqrtf(var + GN_EPS);
        const float4 g = *(const float4*)(P.lnx_g + h * 64 + 4 * c), bb = *(const float4*)(P.lnx_b + h * 64 + 4 * c), vv = *(const float4*)(RSB + ((size_t)tok * RH + h) * RSB_BLK + 320 + 4 * c);
        const float rk = RSB[((size_t)tok * RH + h) * RSB_BLK + 386];
        const uint2 gt = *(const uint2*)(gate + (size_t)tok * DM + h * 64 + 4 * c);
        const float r0 = (dx * rs * g.x + bb.x + rk * vv.x) * __uint_as_float(gt.x << 16), r1 = (dy * rs * g.y + bb.y + rk * vv.y) * __uint_as_float(gt.x & 0xffff0000u);
        const float r2 = (dz * rs * g.z + bb.z + rk * vv.z) * __uint_as_float(gt.y << 16), r3 = (dw * rs * g.w + bb.w + rk * vv.w) * __uint_as_float(gt.y & 0xffff0000u);
        uint2 w; w.x = pack2(r0, r1); w.y = pack2(r2, r3);
        *(uint2*)(O + (size_t)tok * DM + h * 64 + 4 * c) = w;
    }
    const float* dpart = (const float*)(P.ws + WS_DPART); const float* dl = (const float*)(P.ws + WS_DL);
    float* coef = lds + wave * 128;
    for (int task = blockIdx.x * 8 + wave; task < DB * SH; task += gridDim.x * 8) {
        const int b = task / SH, h = task % SH;
        const float L0 = dl[(size_t)(b * NPAGES + 2 * lane) * SH + h], L1 = dl[(size_t)(b * NPAGES + 2 * lane + 1) * SH + h];
        float incl = L0 + L1;
#pragma unroll
        for (int off = 1; off < 64; off <<= 1) { const float t = __shfl_down(incl, off); if (lane + off < 64) incl += t; }
        const float excl = incl - (L0 + L1);
        coef[2 * lane] = exp2f(-(excl + L1)); coef[2 * lane + 1] = exp2f(-excl);
        asm volatile("s_waitcnt lgkmcnt(0)" ::: "memory");
        __builtin_amdgcn_wave_barrier();
        float o = 0.f;
#pragma unroll 16
        for (int j = 0; j < NPAGES; ++j) o += coef[j] * dpart[((size_t)(b * NPAGES + j) * SH + h) * HD + lane];
        const size_t row = NTOK + b;
        O[row * DM + 384 + h * 64 + lane] = f2bf(o * bf2f(gate[row * DM + 384 + h * 64 + lane]));
        __builtin_amdgcn_wave_barrier();
    }
    for (int i = blockIdx.x * 512 + tid; i < (ROWS_P - NTK) * DM / 4; i += gridDim.x * 512) *(uint2*)(O + (size_t)NTK * DM + (size_t)i * 4) = make_uint2(0u, 0u);
}

__device__ __forceinline__ void p5_sample_out(const Params& P, volatile unsigned* tk) {
    const int tid = threadIdx.x, row = tid >> 4, kq = tid & 15;
    const bf16_t* O = (const bf16_t*)(P.ws + WS_O) + (size_t)(NTOK + row) * DM + kq * 64;
    const bf16_t* Bt2 = (const bf16_t*)(P.ws + WS_BT2);
    float* yun = (float*)(P.ws + WS_YUN);
    for (int cb = blockIdx.x; cb < DM / 4; cb += gridDim.x) {
        float acc[4] = {0.f, 0.f, 0.f, 0.f};
#pragma unroll
        for (int k8 = 0; k8 < 8; ++k8) {
            const uint4 ov = *(const uint4*)(O + k8 * 8); const unsigned oo[4] = {ov.x, ov.y, ov.z, ov.w};
#pragma unroll
            for (int c = 0; c < 4; ++c) { const uint4 wv = *(const uint4*)(Bt2 + (size_t)(cb * 4 + c) * DM + kq * 64 + k8 * 8); const unsigned ww[4] = {wv.x, wv.y, wv.z, wv.w};
#pragma unroll
                for (int j = 0; j < 4; ++j) acc[c] += __uint_as_float(oo[j] << 16) * __uint_as_float(ww[j] << 16) + __uint_as_float(oo[j] & 0xffff0000u) * __uint_as_float(ww[j] & 0xffff0000u); }
        }
#pragma unroll
        for (int c = 0; c < 4; ++c) acc[c] = sum16(acc[c]);
        if (kq == 0) { const size_t o = (size_t)(NTOK + row) * DM + cb * 4; const float4 xv = *(const float4*)(P.x_sample + (size_t)row * DM + cb * 4);
            const float yv[4] = {xv.x + acc[0], xv.y + acc[1], xv.z + acc[2], xv.w + acc[3]};
#pragma unroll
            for (int c = 0; c < 4; ++c) __hip_atomic_store((unsigned*)(yun + o + c), __float_as_uint(yv[c]), __ATOMIC_RELAXED, __HIP_MEMORY_SCOPE_AGENT); }
    }
    unsigned* ctl = (unsigned*)(P.ws + WS_BAR);
    asm volatile("s_waitcnt vmcnt(0)" ::: "memory");
    __syncthreads();
    if (tid == 0) tk[0] = xb_add(ctl + QW_SAMP, 1u);
    __syncthreads();
    const int lane = tid & 63, wave = tid >> 6;
    if (tk[0] == gridDim.x - 1u) for (int r = wave; r < DB; r += 8) {
        float v[16]; float ss = 0.f;
#pragma unroll
        for (int j = 0; j < 16; ++j) { v[j] = __uint_as_float(__hip_atomic_load((unsigned*)(yun + (size_t)(NTOK + r) * DM + lane + 64 * j), __ATOMIC_RELAXED, __HIP_MEMORY_SCOPE_AGENT)); ss += v[j] * v[j]; }
        ss = wave_sum_fast(ss);
        const float rs = rsqrtf(ss * (1.f / DM) + NORM_EPS);
#pragma unroll
        for (int j = 0; j < 16; ++j) P.out[OUT_Y_S + (size_t)r * DM + lane + 64 * j] = v[j] * rs * P.final_norm_g[lane + 64 * j];
    }
}

constexpr int NPHASE = 7;
__global__ void __launch_bounds__(512, 2) mk_fwd(Params P) {
    extern __shared__ __attribute__((aligned(16))) unsigned char lds[];
    volatile LAS unsigned* xbw = (volatile LAS unsigned*)((LAS unsigned char*)lds + LDS_CTL);
    if (threadIdx.x < 4) xbw[threadIdx.x] = 0u;
    __syncthreads();
    XcdBarrier bar; bar.bar = (unsigned*)(P.ws + WS_BAR); bar.x = 0; bar.st = xbw;
#if MK_N_LAUNCHES == 1
    bar = xcd_barrier_post((unsigned*)(P.ws + WS_BAR), xbw);
#endif
    const int lo = P.ph_lo, hi = P.ph_hi;
#define IN(k) (lo <= (k) && (k) < hi)
#define SEAM(k) do { if (IN(k) && IN((k) + 1)) xcd_barrier(bar); } while (0)
    float* ldsf = (float*)lds;
    if (IN(0)) { for (int rep = 0; rep < NREP(0); ++rep) p0_prologue(P, ldsf); }
    SEAM(0);
    if (IN(1)) {
        pg8::Gemm g{(const bf16_t*)(P.ws + WS_A1), (const bf16_t*)(P.ws + WS_BT1), MROWS1, NB1, DM};
        pg8::GridOrder S; S.init(65, 15, 8, 65, 15, 2, (int)gridDim.x, (int)((blockIdx.x % 8) * (gridDim.x / 8) + blockIdx.x / 8));
        EpiG1 E{(bf16_t*)(P.ws + WS_PRW), (bf16_t*)(P.ws + WS_QB), (bf16_t*)(P.ws + WS_KB), (bf16_t*)(P.ws + WS_VB), (bf16_t*)(P.ws + WS_XQ), (bf16_t*)(P.ws + WS_GATE), P.out};
        for (int rep = 0; rep < NREP(1); ++rep) pg8::gemm_phase<EpiG1, pg8::GridOrder>((PG8_LAS unsigned char*)lds, g, S, E);
    }
    SEAM(1);
    if (IN(2)) {
        if (blockIdx.x < NPREP) {
            p2_rwkv_prep(P, ldsf);
            asm volatile("s_waitcnt vmcnt(0)" ::: "memory");
            __syncthreads();
            if (threadIdx.x == 0) { __builtin_amdgcn_fence(__ATOMIC_RELEASE, "agent"); asm volatile("s_waitcnt vmcnt(0)" ::: "memory"); (void)xb_add((unsigned*)(P.ws + WS_BAR) + QW_PREP_W, 1u); }
        }
        p2_xattn_prompt(P, lds);
        p2_xattn_sample(P, ldsf);
    }
    if (IN(3)) { p3_scan_and_sb(P, ldsf); }
    SEAM(3);
    if (IN(4)) { for (int rep = 0; rep < NREP(4); ++rep) p4_combine(P, ldsf); }
    SEAM(4);
    if (IN(5)) {
        pg8::Gemm g{(const bf16_t*)(P.ws + WS_O), (const bf16_t*)(P.ws + WS_BT2), NTOK, DM, DM};
        pg8::GridOrder S; S.init(64, 4, 0, 0, 0, 1, (int)gridDim.x, (int)((blockIdx.x % 8) * (gridDim.x / 8) + blockIdx.x / 8));
        EpiG2N E{P.x_prompt, P.out + OUT_Y_P, P.final_norm_g, (unsigned*)(P.ws + WS_YUN), (unsigned*)(P.ws + WS_BAR), (float*)(lds + LDS_STAGE)};
        p5_sample_out(P, (volatile unsigned*)(lds + LDS_STAGE + 8192));
        pg8::gemm_phase<EpiG2N, pg8::GridOrder>((PG8_LAS unsigned char*)lds, g, S, E);
    }
#undef IN
#undef SEAM
}

extern "C" void kernel_launch(void* const* d_in, const int* in_sizes, int n_in, void* d_out, int out_size, void* d_ws, size_t ws_size, hipStream_t stream) {
    static int grid = 0;
    if (grid == 0) {
        if (n_in != 28 || (size_t)out_size != OUT_END || ws_size < WS_END) { fprintf(stderr, "kernel_launch: unexpected shapes: n_in %d out %d (want %zu) ws %zu (want %zu)\n", n_in, out_size, (size_t)OUT_END, ws_size, (size_t)WS_END); grid = -1; return; }
        int dev = 0, cus = 0, per_cu = 0;
        if (hipGetDevice(&dev) != hipSuccess || hipDeviceGetAttribute(&cus, hipDeviceAttributeMultiprocessorCount, dev) != hipSuccess) { grid = -1; return; }
        if (hipFuncSetAttribute((const void*)mk_fwd, hipFuncAttributeMaxDynamicSharedMemorySize, LDS_BYTES) != hipSuccess) { fprintf(stderr, "kernel_launch: hipFuncSetAttribute failed\n"); grid = -1; return; }
        if (hipOccupancyMaxActiveBlocksPerMultiprocessor(&per_cu, (const void*)mk_fwd, 512, LDS_BYTES) != hipSuccess || per_cu < 1) fprintf(stderr, "kernel_launch: occupancy query says %d\n", per_cu);
        (void)hipGetLastError();
        grid = cus;
        if (grid % 8 != 0) grid -= grid % 8;
    }
    if (grid < 0) return;
    (void)hipMemsetAsync((char*)d_ws + WS_BAR, 0, 16384, stream);
    Params P{};
    P.x_prompt = (const float*)d_in[0]; P.mem_prompt = (const float*)d_in[1]; P.x_sample = (const float*)d_in[2]; P.cache_k = (const float*)d_in[3]; P.cache_v = (const float*)d_in[4];
    P.page_table = (const int*)d_in[5]; P.state_wkv = (const float*)d_in[6]; P.state_shift = (const float*)d_in[7]; P.cmem_k = (const float*)d_in[8]; P.cmem_v = (const float*)d_in[9];
    P.norm_g = (const float*)d_in[10]; P.w_in = (const float*)d_in[11]; P.sb_bias = (const float*)d_in[12]; P.mu_shift = (const float*)d_in[13]; P.w0 = (const float*)d_in[14];
    P.w_lora_b = (const float*)d_in[15]; P.a0 = (const float*)d_in[16]; P.a_lora_b = (const float*)d_in[17]; P.k_k = (const float*)d_in[18]; P.k_a = (const float*)d_in[19]; P.r_k = (const float*)d_in[20];
    P.lnx_g = (const float*)d_in[21]; P.lnx_b = (const float*)d_in[22]; P.mem_norm_g = (const float*)d_in[23]; P.w_mem_k = (const float*)d_in[24]; P.w_mem_v = (const float*)d_in[25];
    P.w_out = (const float*)d_in[26]; P.final_norm_g = (const float*)d_in[27];
    P.out = (float*)d_out; P.ws = (unsigned char*)d_ws;
#if MK_N_LAUNCHES == 1
    P.ph_lo = 0; P.ph_hi = NPHASE;
    hipLaunchKernelGGL(mk_fwd, dim3(grid), dim3(512), LDS_BYTES, stream, P);
#else
    for (int ph = 0; ph < NPHASE; ++ph) { P.ph_lo = ph; P.ph_hi = ph + 1; hipLaunchKernelGGL(mk_fwd, dim3(grid), dim3(512), LDS_BYTES, stream, P); }
#endif
    const hipError_t le = hipPeekAtLastError();
    if (le != hipSuccess) fprintf(stderr, "kernel_launch: launch failed: %s\n", hipGetErrorName(le));
}
```
